# Optimizing an MI355X kernel written in HIP

```python
import jax, jax.numpy as jnp
from jax import lax
import numpy as np

D_MODEL = 1024
BATCH = 16
SEQ = 2048
DEPTH = 4

NORM_EPS = 1e-6
ROPE_THETA = 10000.0
Q_BLOCK = 128

A_HEADS = 8
A_HEAD_DIM = 64
IDX_HEADS = 8
IDX_DIM = 64
DSA_TOPK_MAX = 256

B_HEADS = 8
B_HEAD_DIM = 64
MOBA_BLOCK = 256
MOBA_TOPK = 3
MOBA_Q_CHUNK = 16

EVEN_COLS = (A_HEADS * A_HEAD_DIM,
             A_HEAD_DIM,
             A_HEAD_DIM,
             IDX_HEADS * IDX_DIM,
             IDX_DIM,
             IDX_HEADS,
             B_HEADS * B_HEAD_DIM,
             B_HEADS * B_HEAD_DIM,
             B_HEADS * B_HEAD_DIM)
EVEN_IN_COLS = int(sum(EVEN_COLS))
EVEN_SPLITS = tuple(int(c) for c in np.cumsum(EVEN_COLS)[:-1])
EVEN_OUT_COLS = A_HEADS * A_HEAD_DIM + B_HEADS * B_HEAD_DIM

C_HEADS = 16
C_NOPE = 64
C_ROPE = 32
C_V = 64
C_Q_RANK = 768
C_KV_RANK = 256
C_IN_COLS = C_Q_RANK + C_KV_RANK + C_ROPE

PEER_HEADS = 8
PEER_NKEYS = 128
PEER_N_EXPERTS = PEER_NKEYS * PEER_NKEYS
PEER_QDIM = 256
PEER_TOPK_HALF = 16
PEER_TOPK = 16
PEER_CHUNK = 128

N_EVEN = (DEPTH + 1) // 2
N_ODD = DEPTH // 2

kernel_name = 'hybrid_dsa_moba_mla_peer'


def rms_norm(x, g):
    xf = x.astype(jnp.float32)
    y = xf * lax.rsqrt(jnp.mean(xf * xf, axis=-1, keepdims=True) + NORM_EPS)
    return (y * g.astype(jnp.float32)).astype(x.dtype)


def rope_tables(positions, dim):
    inv = 1.0 / (ROPE_THETA ** (jnp.arange(0, dim, 2, dtype=jnp.float32) / dim))
    ang = positions.astype(jnp.float32)[..., None] * inv
    return jnp.cos(ang)[:, :, None, :], jnp.sin(ang)[:, :, None, :]


def apply_rope(x, cos, sin):
    x1, x2 = jnp.split(x, 2, axis=-1)
    c = cos.astype(x.dtype)
    s = sin.astype(x.dtype)
    return jnp.concatenate([x1 * c - x2 * s, x1 * s + x2 * c], axis=-1)


def to_blocks(a, blk):
    b, s = a.shape[:2]
    return jnp.moveaxis(a.reshape((b, s // blk, blk) + a.shape[2:]), 1, 0)


def from_blocks(a):
    a = jnp.moveaxis(a, 0, 1)
    return a.reshape((a.shape[0], a.shape[1] * a.shape[2]) + a.shape[3:])


def dsa_attention(q, k, v, iq, ik, iw):
    b, s = q.shape[:2]
    n_sel = min(DSA_TOPK_MAX, s // 4)
    key_pos = jnp.arange(s)
    w_scale = (IDX_HEADS ** -0.5) * (IDX_DIM ** -0.5)
    a_scale = A_HEAD_DIM ** -0.5
    gather = jax.vmap(lambda t, i: t[i])

    def one_block(args):
        blk, qb, iqb, iwb = args
        q_pos = blk * Q_BLOCK + jnp.arange(Q_BLOCK)
        causal = key_pos[None, :] <= q_pos[:, None]
        logits = jnp.einsum('bqhd,bsd->bqhs', iqb, ik).astype(jnp.float32)
        score = jnp.einsum('bqhs,bqh->bqs', jax.nn.relu(logits), iwb.astype(jnp.float32)) * w_scale
        score = jnp.where(causal[None], score, -jnp.inf)
        _, sel = lax.top_k(score, n_sel)
        k_sel = gather(k, sel)
        v_sel = gather(v, sel)
        valid = sel <= q_pos[None, :, None]
        sc = jnp.einsum('bqhd,bqnd->bqhn', qb, k_sel).astype(jnp.float32) * a_scale
        sc = jnp.where(valid[:, :, None, :], sc, -jnp.inf)
        p = jax.nn.softmax(sc, axis=-1).astype(v.dtype)
        return jnp.einsum('bqhn,bqnd->bqhd', p, v_sel)

    nblk = s // Q_BLOCK
    out = lax.map(one_block, (jnp.arange(nblk), to_blocks(q, Q_BLOCK),
                              to_blocks(iq, Q_BLOCK), to_blocks(iw, Q_BLOCK)))
    return from_blocks(out)


def moba_attention(q, k, v):
    b, s, h, d = q.shape
    nb = -(-s // MOBA_BLOCK)
    pad = nb * MOBA_BLOCK - s

    def blocks(a):
        a = jnp.pad(a, ((0, 0), (0, pad), (0, 0), (0, 0)))
        return a.reshape(b, nb, MOBA_BLOCK, h, d).transpose(0, 3, 1, 2, 4)

    kb = blocks(k)
    vb = blocks(v)
    k_mean = jnp.mean(kb.astype(jnp.float32), axis=3).astype(k.dtype)
    n_top = min(MOBA_TOPK, nb - 1)
    scale = d ** -0.5
    blk_ids = jnp.arange(nb)
    key_in_blk = jnp.arange(MOBA_BLOCK)
    gather = jax.vmap(jax.vmap(lambda t, i: t[i]))

    def one_chunk(args):
        c, qc = args
        q_pos = c * MOBA_Q_CHUNK + jnp.arange(MOBA_Q_CHUNK)
        own = (c * MOBA_Q_CHUNK) // MOBA_BLOCK
        k_own = lax.dynamic_index_in_dim(kb, own, axis=2, keepdims=False)
        v_own = lax.dynamic_index_in_dim(vb, own, axis=2, keepdims=False)
        s_own = jnp.einsum('bqhd,bhkd->bhqk', qc, k_own).astype(jnp.float32) * scale
        s_own = jnp.where((own * MOBA_BLOCK + key_in_blk)[None, :] <= q_pos[:, None], s_own, -jnp.inf)
        if n_top == 0:
            p = jax.nn.softmax(s_own, axis=-1).astype(v.dtype)
            return jnp.einsum('bhqk,bhkd->bqhd', p, v_own)
        gate = jnp.einsum('bqhd,bhnd->bhqn', qc, k_mean).astype(jnp.float32)
        gate = jnp.where(blk_ids < own, gate, -jnp.inf)
        _, sel = lax.top_k(gate, n_top)
        k_sel = gather(kb, sel)
        v_sel = gather(vb, sel)
        s_past = jnp.einsum('bqhd,bhqnkd->bhqnk', qc, k_sel).astype(jnp.float32) * scale
        s_past = jnp.where((sel < own)[..., None], s_past, -jnp.inf)
        s_past = s_past.reshape(b, h, MOBA_Q_CHUNK, n_top * MOBA_BLOCK)
        p = jax.nn.softmax(jnp.concatenate([s_past, s_own], axis=-1), axis=-1).astype(v.dtype)
        p_past = p[..., :n_top * MOBA_BLOCK].reshape(b, h, MOBA_Q_CHUNK, n_top, MOBA_BLOCK)
        p_own = p[..., n_top * MOBA_BLOCK:]
        return (jnp.einsum('bhqnk,bhqnkd->bqhd', p_past, v_sel)
                + jnp.einsum('bhqk,bhkd->bqhd', p_own, v_own))

    nchunk = s // MOBA_Q_CHUNK
    out = lax.map(one_chunk, (jnp.arange(nchunk), to_blocks(q, MOBA_Q_CHUNK)))
    return from_blocks(out)


def even_mixer(h, cos64, sin64, w_in, w_out):
    b, s, _ = h.shape
    qa, ka, va, iq, ik, iw, qb, kb, vb = jnp.split(h @ w_in, EVEN_SPLITS, axis=-1)
    qa = apply_rope(qa.reshape(b, s, A_HEADS, A_HEAD_DIM), cos64, sin64)
    ka = apply_rope(ka[:, :, None, :], cos64, sin64)[:, :, 0]
    iq = apply_rope(iq.reshape(b, s, IDX_HEADS, IDX_DIM), cos64, sin64)
    ik = apply_rope(ik[:, :, None, :], cos64, sin64)[:, :, 0]
    out_a = dsa_attention(qa, ka, va, iq, ik, iw)
    qb = apply_rope(qb.reshape(b, s, B_HEADS, B_HEAD_DIM), cos64, sin64)
    kb = apply_rope(kb.reshape(b, s, B_HEADS, B_HEAD_DIM), cos64, sin64)
    vb = vb.reshape(b, s, B_HEADS, B_HEAD_DIM)
    out_b = moba_attention(qb, kb, vb)
    o = jnp.concatenate([out_a.reshape(b, s, A_HEADS * A_HEAD_DIM),
                         out_b.reshape(b, s, B_HEADS * B_HEAD_DIM)], axis=-1)
    return o @ w_out


def mla_attention(q_nope, q_rope, k_nope, k_rope, v):
    s = q_nope.shape[1]
    key_pos = jnp.arange(s)
    scale = (C_NOPE + C_ROPE) ** -0.5

    def one_block(args):
        blk, qn, qr = args
        q_pos = blk * Q_BLOCK + jnp.arange(Q_BLOCK)
        sc = (jnp.einsum('bqhd,bshd->bhqs', qn, k_nope)
              + jnp.einsum('bqhd,bsd->bhqs', qr, k_rope)).astype(jnp.float32) * scale
        sc = jnp.where(key_pos[None, :] <= q_pos[:, None], sc, -jnp.inf)
        p = jax.nn.softmax(sc, axis=-1).astype(v.dtype)
        return jnp.einsum('bhqs,bshd->bqhd', p, v)

    nblk = s // Q_BLOCK
    out = lax.map(one_block, (jnp.arange(nblk), to_blocks(q_nope, Q_BLOCK), to_blocks(q_rope, Q_BLOCK)))
    return from_blocks(out)


def mla_mixer(h, cos32, sin32, w_in, q_norm, kv_norm, w_uq, w_ukv, w_out):
    b, s, _ = h.shape
    cq, ckv, kr = jnp.split(h @ w_in, [C_Q_RANK, C_Q_RANK + C_KV_RANK], axis=-1)
    q = (rms_norm(cq, q_norm) @ w_uq).reshape(b, s, C_HEADS, C_NOPE + C_ROPE)
    q_nope, q_rope = jnp.split(q, [C_NOPE], axis=-1)
    q_rope = apply_rope(q_rope, cos32, sin32)
    kv = (rms_norm(ckv, kv_norm) @ w_ukv).reshape(b, s, C_HEADS, C_NOPE + C_V)
    k_nope, v = jnp.split(kv, [C_NOPE], axis=-1)
    k_rope = apply_rope(kr[:, :, None, :], cos32, sin32)[:, :, 0]
    o = mla_attention(q_nope, q_rope, k_nope, k_rope, v)
    return o.reshape(b, s, C_HEADS * C_V) @ w_out


def peer_ffn(h, w_q, sub_keys, u_tab, v_tab):
    b, s, d = h.shape
    tokens = h.reshape(b * s // PEER_CHUNK, PEER_CHUNK, d)

    def one_chunk(xc):
        t = xc.shape[0]
        q = (xc @ w_q).reshape(t, PEER_HEADS, 2, PEER_QDIM // 2)
        sc = jnp.einsum('thpc,hpnc->thpn', q, sub_keys).astype(jnp.float32)
        v_half, i_half = lax.top_k(sc, PEER_TOPK_HALF)
        cand = (v_half[:, :, 0, :, None] + v_half[:, :, 1, None, :]).reshape(t, PEER_HEADS, -1)
        cand_idx = (i_half[:, :, 0, :, None] * PEER_NKEYS + i_half[:, :, 1, None, :]).reshape(t, PEER_HEADS, -1)
        top_s, pos = lax.top_k(cand, PEER_TOPK)
        expert = jnp.take_along_axis(cand_idx, pos, axis=-1)
        g = jax.nn.softmax(top_s, axis=-1)
        u = u_tab[expert]
        act = jax.nn.gelu(jnp.einsum('thkd,td->thk', u, xc).astype(jnp.float32), approximate=False)
        w = (g * act).astype(xc.dtype)
        return jnp.einsum('thk,thkd->td', w, v_tab[expert])

    return lax.map(one_chunk, tokens).reshape(b, s, d)


def setup_inputs(seed: int = 0) -> dict:
    key = jax.random.key(seed)
    ks = jax.random.split(key, 20)
    f32 = jnp.float32

    def nrm(k, shape, scale):
        return jax.random.normal(k, shape, f32) * scale

    def gain(k, shape):
        return 1.0 + 0.02 * jax.random.normal(k, shape, f32)

    return {
        'x': jax.random.normal(ks[0], (BATCH, SEQ, D_MODEL), f32),
        'positions': jnp.broadcast_to(jnp.arange(SEQ, dtype=jnp.int32)[None, :], (BATCH, SEQ)),
        'attn_norm': gain(ks[1], (DEPTH, D_MODEL)),
        'ffn_norm': gain(ks[2], (DEPTH, D_MODEL)),
        'final_norm': gain(ks[3], (D_MODEL,)),
        'hyb_w_in': nrm(ks[4], (N_EVEN, D_MODEL, EVEN_IN_COLS), D_MODEL ** -0.5),
        'hyb_w_out': nrm(ks[5], (N_EVEN, EVEN_OUT_COLS, D_MODEL), EVEN_OUT_COLS ** -0.5),
        'mla_w_in': nrm(ks[6], (N_ODD, D_MODEL, C_IN_COLS), D_MODEL ** -0.5),
        'mla_q_norm': gain(ks[7], (N_ODD, C_Q_RANK)),
        'mla_kv_norm': gain(ks[8], (N_ODD, C_KV_RANK)),
        'mla_w_uq': nrm(ks[9], (N_ODD, C_Q_RANK, C_HEADS * (C_NOPE + C_ROPE)), C_Q_RANK ** -0.5),
        'mla_w_ukv': nrm(ks[10], (N_ODD, C_KV_RANK, C_HEADS * (C_NOPE + C_V)), C_KV_RANK ** -0.5),
        'mla_w_out': nrm(ks[11], (N_ODD, C_HEADS * C_V, D_MODEL), (C_HEADS * C_V) ** -0.5),
        'peer_w_q': nrm(ks[12], (DEPTH, D_MODEL, PEER_HEADS * PEER_QDIM), D_MODEL ** -0.5),
        'peer_sub_keys': nrm(ks[13], (DEPTH, PEER_HEADS, 2, PEER_NKEYS, PEER_QDIM // 2), (PEER_QDIM // 2) ** -0.5),
        'peer_u': nrm(ks[14], (DEPTH, PEER_N_EXPERTS, D_MODEL), D_MODEL ** -0.5),
        'peer_v': nrm(ks[15], (DEPTH, PEER_N_EXPERTS, D_MODEL), D_MODEL ** -0.5),
    }


def reference(x, positions, attn_norm, ffn_norm, final_norm, hyb_w_in, hyb_w_out,
              mla_w_in, mla_q_norm, mla_kv_norm, mla_w_uq, mla_w_ukv, mla_w_out,
              peer_w_q, peer_sub_keys, peer_u, peer_v):
    cos64, sin64 = rope_tables(positions, A_HEAD_DIM)
    cos32, sin32 = rope_tables(positions, C_ROPE)
    for i in range(DEPTH):
        h = rms_norm(x, attn_norm[i])
        j = i // 2
        if i % 2 == 0:
            x = x + even_mixer(h, cos64, sin64, hyb_w_in[j], hyb_w_out[j])
        else:
            x = x + mla_mixer(h, cos32, sin32, mla_w_in[j], mla_q_norm[j], mla_kv_norm[j],
                              mla_w_uq[j], mla_w_ukv[j], mla_w_out[j])
        h = rms_norm(x, ffn_norm[i])
        x = x + peer_ffn(h, peer_w_q[i], peer_sub_keys[i], peer_u[i], peer_v[i])
    return rms_norm(x, final_norm)
```

```cpp
#include <hip/hip_runtime.h>
#include <stdint.h>
#include <stdio.h>
#include <cmath>

#define DI __device__ __forceinline__
#ifndef DBG_REP
#define DBG_REP 0
#endif
#ifndef DBG_SKIP
#define DBG_SKIP 0
#endif
#define LAS __attribute__((address_space(3)))
typedef unsigned short bf16_t;
typedef short bf16x8 __attribute__((ext_vector_type(8)));
typedef short s16x4 __attribute__((ext_vector_type(4)));
typedef float f32x2 __attribute__((ext_vector_type(2)));
typedef float f32x4 __attribute__((ext_vector_type(4)));
typedef float f32x16 __attribute__((ext_vector_type(16)));
typedef unsigned u32x2 __attribute__((ext_vector_type(2)));
typedef unsigned u32x4 __attribute__((ext_vector_type(4)));
typedef __bf16 bf2_t __attribute__((ext_vector_type(2)));

constexpr int T_ = 32768, D_ = 1024, S_ = 2048, NB_ = 16, DEPTH_ = 4;
constexpr int NE_IN = 2816;
constexpr int NM_IN = 1280;
constexpr int NEXP = 16384;
constexpr int NTHR = 512;
constexpr int LDS_BYTES = 163840;
constexpr float LOG2E = 1.4426950408889634f;
constexpr float NEG_INF = -__builtin_inff();
constexpr float TAB_SCALE = 64.0f;

constexpr int C_QA = 0, C_KA = 512, C_VA = 576, C_IQ = 640, C_IK = 1152, C_QB = 1216, C_KB = 1728, C_VB = 2240, C_IW = 2752;

constexpr size_t MiB = 1024 * 1024;
constexpr size_t WS_BAR = 0;
constexpr size_t WS_COS64 = 64 * 1024;
constexpr size_t WS_SIN64 = WS_COS64 + 4 * MiB;
constexpr size_t WS_COS32 = WS_SIN64 + 4 * MiB;
constexpr size_t WS_SIN32 = WS_COS32 + 2 * MiB;
constexpr size_t WS_WEIN = WS_SIN32 + 2 * MiB;
constexpr size_t SZ_WEIN = (size_t)NE_IN * 1024 * 2;
constexpr size_t WS_WEOUT = WS_WEIN + 2 * SZ_WEIN;
constexpr size_t SZ_WSQ = (size_t)1024 * 1024 * 2;
constexpr size_t WS_WMIN = WS_WEOUT + 2 * SZ_WSQ;
constexpr size_t SZ_WMIN = (size_t)NM_IN * 1024 * 2;
constexpr size_t WS_WUQ = WS_WMIN + 2 * SZ_WMIN;
constexpr size_t SZ_WUQ = (size_t)1536 * 768 * 2;
constexpr size_t WS_WUKV = WS_WUQ + 2 * SZ_WUQ;
constexpr size_t SZ_WUKV = (size_t)2048 * 256 * 2;
constexpr size_t WS_WMOUT = WS_WUKV + 2 * SZ_WUKV;
constexpr size_t WS_WPQ = WS_WMOUT + 2 * SZ_WSQ;
constexpr size_t SZ_WPQ = (size_t)2048 * 1024 * 2;
constexpr size_t WS_SUBK = WS_WPQ + 4 * SZ_WPQ;
constexpr size_t SZ_SUBK = (size_t)16 * 128 * 128 * 2;
constexpr size_t WS_U16 = WS_SUBK + 4 * SZ_SUBK;
constexpr size_t SZ_TAB = (size_t)NEXP * 1024;
constexpr size_t WS_V16 = WS_U16 + 4 * SZ_TAB;
constexpr size_t WS_X = WS_V16 + 4 * SZ_TAB;
constexpr size_t WS_H = WS_X + 128 * MiB;
constexpr size_t WS_O = WS_H + 64 * MiB;
constexpr size_t WS_P = WS_O + 64 * MiB;
constexpr size_t WS_P_CIN = WS_P;
constexpr size_t WS_P_QM = WS_P + 80 * MiB;
constexpr size_t WS_P_KN = WS_P + 176 * MiB;
constexpr size_t WS_VT = WS_P + 240 * MiB;
constexpr size_t WS_MASK = WS_VT + 64 * MiB;
constexpr size_t WS_IW = WS_MASK + 8 * MiB;
constexpr size_t WS_RSTD = WS_IW + 1 * MiB;
constexpr size_t WS_RE = WS_RSTD + 1 * MiB;
constexpr size_t WS_RG = WS_RE + 16 * MiB;
constexpr size_t WS_PSF = WS_RG + 16 * MiB;
constexpr size_t WS_END = WS_PSF + 2 * MiB;

struct Params {
    const float* x; const int* pos; const float* attn_norm; const float* ffn_norm; const float* final_norm;
    const float* hyb_w_in; const float* hyb_w_out; const float* mla_w_in; const float* mla_q_norm; const float* mla_kv_norm;
    const float* mla_w_uq; const float* mla_w_ukv; const float* mla_w_out; const float* peer_w_q; const float* peer_sub_keys;
    const float* peer_u; const float* peer_v;
    float* out; unsigned char* ws;
    int ph_lo, ph_hi;
};

DI unsigned pk_bf16(float lo, float hi) { f32x2 v = {lo, hi}; bf2_t b = __builtin_convertvector(v, bf2_t); return __builtin_bit_cast(unsigned, b); }
DI bf16_t f2bf(float x) { return (bf16_t)(pk_bf16(x, 0.f) & 0xffffu); }
DI float bf_lo(unsigned u) { return __uint_as_float(u << 16); }
DI float bf_hi(unsigned u) { return __uint_as_float(u & 0xffff0000u); }
DI float wave_sum(float v) {
#pragma unroll
    for (int o = 32; o > 0; o >>= 1) v += __shfl_xor(v, o, 64);
    return v;
}
DI f32x16 mfma32(bf16x8 a, bf16x8 b, f32x16 c) { return __builtin_amdgcn_mfma_f32_32x32x16_bf16(a, b, c, 0, 0, 0); }
DI f32x16 zero16() { f32x16 z;
#pragma unroll
    for (int i = 0; i < 16; ++i) z[i] = 0.f; return z; }

#define XB_TMO      128
#define XB_XCNT(j)  (256  + 64 * (j))
#define XB_XSUB(j)  (1280 + 64 * (j))
#define XB_XGEN(j)  (2304 + 64 * (j))
#define XB_TOP      3328
#define XB_TOPGEN   3392
#define XCD_BAR_WORDS 3456
#define XB_SPIN_CAP (1u << 25)

DI unsigned xb_ld(unsigned* p)              { return __hip_atomic_load(p, __ATOMIC_RELAXED, __HIP_MEMORY_SCOPE_AGENT); }
DI unsigned xb_add(unsigned* p, unsigned v) { return __hip_atomic_fetch_add(p, v, __ATOMIC_RELAXED, __HIP_MEMORY_SCOPE_AGENT); }
DI unsigned xb_xcc_id() { return (unsigned)__builtin_amdgcn_s_getreg((3 << 11) | 20) & 0xFu; }
#define XB_SPIN(cond, bar) do { unsigned _sp = 0; while (cond) { __builtin_amdgcn_s_sleep(1); \
    if ((++_sp & 255u) == 0u) { if (xb_ld(&(bar)[XB_TMO])) break; if (_sp > XB_SPIN_CAP) { atomicAdd(&(bar)[XB_TMO], 1u); break; } } } } while (0)

struct XcdBarrier { unsigned* bar; unsigned x; volatile LAS unsigned* st; };

DI XcdBarrier xcd_barrier_post(unsigned* bar, volatile LAS unsigned* st) {
    XcdBarrier b; b.bar = bar; b.x = xb_xcc_id(); b.st = st;
    if (threadIdx.x == 0) (void)xb_add(&bar[XB_XCNT(b.x)], 1u);
    return b;
}
DI void xcd_barrier_complete(unsigned* bar, unsigned x, unsigned& nloc, unsigned& nx) {
    const unsigned G = gridDim.x * gridDim.y * gridDim.z;
    unsigned sum, cnt, mine, sp = 0u;
    for (;;) {
        sum = 0u; cnt = 0u; mine = 0u;
#pragma unroll
        for (unsigned j = 0; j < 16; ++j) { const unsigned c = xb_ld(&bar[XB_XCNT(j)]); sum += c; cnt += (c > 0u) ? 1u : 0u; mine = (j == x) ? c : mine; }
        if (sum == G) break;
        __builtin_amdgcn_s_sleep(1);
        if ((++sp & 255u) == 0u) { if (xb_ld(&bar[XB_TMO])) break; if (sp > XB_SPIN_CAP) { atomicAdd(&bar[XB_TMO], 1u); break; } }
    }
    nloc = mine > 0u ? mine : 1u; nx = cnt > 0u ? cnt : 1u;
}
DI void xcd_barrier(const XcdBarrier& b) {
    asm volatile("s_waitcnt vmcnt(0)" ::: "memory");
    __syncthreads();
    if (threadIdx.x == 0) {
        unsigned* bar = b.bar;
        __builtin_amdgcn_s_waitcnt(0);
        unsigned nloc = b.st[0], nx = b.st[1];
        if (nloc == 0u) { xcd_barrier_complete(bar, b.x, nloc, nx); b.st[0] = nloc; b.st[1] = nx; }
        const unsigned old = xb_add(&bar[XB_XSUB(b.x)], 1u);
        const unsigned gen = old / nloc;
        if (old + 1u == (gen + 1u) * nloc) {
            __builtin_amdgcn_fence(__ATOMIC_RELEASE, "agent");
            asm volatile("s_waitcnt vmcnt(0)" ::: "memory");
            const unsigned og = xb_add(&bar[XB_TOP], 1u);
            const unsigned tg = og / nx;
            if (og + 1u == (tg + 1u) * nx) xb_add(&bar[XB_TOPGEN], 1u);
            else XB_SPIN(xb_ld(&bar[XB_TOPGEN]) == tg, bar);
            __builtin_amdgcn_fence(__ATOMIC_ACQUIRE, "agent");
            xb_add(&bar[XB_XGEN(b.x)], 1u);
            asm volatile("s_waitcnt vmcnt(0)" ::: "memory");
        } else {
            XB_SPIN(xb_ld(&bar[XB_XGEN(b.x)]) == gen, bar);
            __builtin_amdgcn_fence(__ATOMIC_ACQUIRE, "agent");
            asm volatile("s_waitcnt vmcnt(0)" ::: "memory");
        }
    }
    __syncthreads();
}

DI int perm32(int rho) { return 8 * ((rho & 15) >> 2) + 4 * (rho >> 4) + (rho & 3); }
template <int MODE> DI int src_col(int np, int N) {
    if (MODE == 0) return np < N ? np : -1;
    if (MODE == 2) { const int c = (np & ~31) + perm32(np & 31); return c < N ? c : -1; }
    if (MODE == 3) { const int c = (np < 1024) ? (np & ~31) + perm32(np & 31) : np; return c < N ? c : -1; }
    if (MODE == 4) { const int c = (((np >> 5) % 3) == 2) ? np : (np & ~31) + perm32(np & 31); return c < N ? c : -1; }
    if (MODE == 5) { const int c = ((np >> 6) & 1) ? np : (np & ~31) + perm32(np & 31); return c < N ? c : -1; }
    const int tile = np >> 8, loc = np & 255, bj = loc >> 7, wc = (loc >> 5) & 3, n = (loc >> 4) & 1, ip = loc & 15;
    const int nat = tile * 256 + wc * 64 + bj * 32 + 8 * (ip >> 2) + 4 * n + (ip & 3);
    if (nat < 1216) return nat;
    if (nat < 2752) return nat + 8;
    if (nat < 2760) return nat - 2752 + 1216;
    return -1;
}
template <int MODE> DI void prep_wt(const float* W, int K, int N, bf16_t* WT, int Npad, const float* kscale, int& toff, int bid, int nblk, int tid) {
    const int tx = tid & 63, w = __builtin_amdgcn_readfirstlane(tid >> 6);
    const int ntn = Npad / 256, ntk = K / 16, nw = nblk * 8;
    int t = (bid * 8 + w - toff) % nw; if (t < 0) t += nw;
    toff = (toff + ntn * ntk) % nw;
    for (; t < ntn * ntk; t += nw) {
        const int n0 = (t % ntn) * 256 + 4 * tx, k0 = (t / ntn) * 16;
        const int sn = src_col<MODE>(n0, N);
        const float keep = (sn >= 0) ? 1.f : 0.f;
        const float* src = W + (size_t)k0 * N + (sn >= 0 ? sn : 0);
        f32x4 v[16];
#pragma unroll
        for (int kk = 0; kk < 16; ++kk) v[kk] = *(const f32x4*)(src + (size_t)kk * N);
#pragma unroll
        for (int kk = 0; kk < 16; ++kk) v[kk] *= (kscale ? kscale[k0 + kk] : 1.f) * keep;
#pragma unroll
        for (int r = 0; r < 4; ++r) {
            bf16_t* dst = WT + (size_t)(n0 + r) * K + k0;
#pragma unroll
            for (int h = 0; h < 2; ++h) {
                u32x4 o;
#pragma unroll
                for (int q = 0; q < 4; ++q) o[q] = pk_bf16(v[8 * h + 2 * q][r], v[8 * h + 2 * q + 1][r]);
                *(u32x4*)(dst + 8 * h) = o;
            }
        }
    }
}
DI void cvt_bf16(const float* src, bf16_t* dst, size_t n, int bid, int nblk, int tid) {
    const size_t n8 = n / 8;
    for (size_t i = (size_t)bid * NTHR + tid; i < n8; i += (size_t)nblk * NTHR) {
        const f32x4 a = *(const f32x4*)(src + i * 8), b = *(const f32x4*)(src + i * 8 + 4);
        u32x4 o; o[0] = pk_bf16(a[0], a[1]); o[1] = pk_bf16(a[2], a[3]); o[2] = pk_bf16(b[0], b[1]); o[3] = pk_bf16(b[2], b[3]);
        *(u32x4*)(dst + i * 8) = o;
    }
}
DI void cvt_fp8(const float* src, unsigned char* dst, size_t n, float scale, const float* colscale  , int bid, int nblk, int tid) {
    const size_t n16 = n / 16;
    for (size_t i = (size_t)bid * NTHR + tid; i < n16; i += (size_t)nblk * NTHR) {
        u32x4 o;
#pragma unroll
        for (int q = 0; q < 4; ++q) {
            f32x4 a = *(const f32x4*)(src + i * 16 + q * 4) * scale;
            if (colscale) a *= *(const f32x4*)(colscale + (i / ((size_t)NEXP * 64)) * 1024 + (i & 63) * 16 + q * 4);
            int w = 0;
            w = __builtin_amdgcn_cvt_pk_fp8_f32(a[0], a[1], w, false);
            w = __builtin_amdgcn_cvt_pk_fp8_f32(a[2], a[3], w, true);
            o[q] = (unsigned)w;
        }
        const size_t lay = i / ((size_t)NEXP * 64), rem = i % ((size_t)NEXP * 64), e = rem >> 6, ch = rem & 63;
        *(u32x4*)(dst + lay * ((size_t)NEXP * 1024) + (ch >> 3) * ((size_t)NEXP * 128) + e * 128 + (ch & 7) * 16) = o;
    }
}
DI void rope_tables(const int* pos, float* c64, float* s64, float* c32, float* s32, int bid, int nblk, int tid) {
    for (int i = bid * NTHR + tid; i < T_ * 48; i += nblk * NTHR) {
        const int t = i / 48, j = i % 48;
        const float p = (float)pos[t];
        const int k = (j < 32) ? j : j - 32;
        const float inv = exp2f(-(float)(2 * k) * ((j < 32) ? (13.287712379549449f / 64.0f) : (13.287712379549449f / 32.0f)));
        float sv, cv; sincosf(p * inv, &sv, &cv);
        if (j < 32) { c64[t * 32 + k] = cv; s64[t * 32 + k] = sv; } else { c32[t * 16 + k] = cv; s32[t * 16 + k] = sv; }
    }
}

DI void rmsnorm_rows(const float* x, const float* g, bf16_t* outb, float* outf, int bid, int nblk, int tid) {
    const int lane = tid & 63, w = tid >> 6;
    f32x4 gv[4];
#pragma unroll
    for (int i = 0; i < 4; ++i) gv[i] = *(const f32x4*)(g + i * 256 + lane * 4);
    for (int row = bid * 8 + w; row < T_; row += nblk * 8) {
        const float* xr = x + (size_t)row * 1024;
        f32x4 v[4]; float ss = 0.f;
#pragma unroll
        for (int i = 0; i < 4; ++i) { v[i] = *(const f32x4*)(xr + i * 256 + lane * 4); ss += v[i][0] * v[i][0] + v[i][1] * v[i][1] + v[i][2] * v[i][2] + v[i][3] * v[i][3]; }
        ss = wave_sum(ss);
        const float rs = 1.0f / sqrtf(ss * (1.0f / 1024.0f) + 1e-6f);
#pragma unroll
        for (int i = 0; i < 4; ++i) {
            const f32x4 y = v[i] * rs * gv[i];
            if (outb) { u32x2 o; o[0] = pk_bf16(y[0], y[1]); o[1] = pk_bf16(y[2], y[3]); *(u32x2*)(outb + (size_t)row * 1024 + i * 256 + lane * 4) = o; }
            else *(f32x4*)(outf + (size_t)row * 1024 + i * 256 + lane * 4) = y;
        }
    }
}
DI void x_to_stream(const float* x, bf16_t* xb, float* psa, int bid, int nblk, int tid) {
    const int lane = tid & 63, w = tid >> 6;
    for (int row = bid * 8 + w; row < T_; row += nblk * 8) {
        const float* xr = x + (size_t)row * 1024 + lane * 16;
        f32x4 v[4]; float ss = 0.f;
#pragma unroll
        for (int i = 0; i < 4; ++i) { v[i] = *(const f32x4*)(xr + i * 4); ss += (v[i][0] * v[i][0] + v[i][1] * v[i][1]) + (v[i][2] * v[i][2] + v[i][3] * v[i][3]); }
        ss += __shfl_xor(ss, 1, 64); ss += __shfl_xor(ss, 2, 64); ss += __shfl_xor(ss, 4, 64);
        u32x4 o0, o1;
        o0[0] = pk_bf16(v[0][0], v[0][1]); o0[1] = pk_bf16(v[0][2], v[0][3]); o0[2] = pk_bf16(v[1][0], v[1][1]); o0[3] = pk_bf16(v[1][2], v[1][3]);
        o1[0] = pk_bf16(v[2][0], v[2][1]); o1[1] = pk_bf16(v[2][2], v[2][3]); o1[2] = pk_bf16(v[3][0], v[3][1]); o1[3] = pk_bf16(v[3][2], v[3][3]);
        bf16_t* dst = xb + (size_t)row * 1024 + lane * 16;
        *(u32x4*)dst = o0; *(u32x4*)(dst + 8) = o1;
        if ((lane & 7) == 0) psa[(size_t)row * 8 + (lane >> 3)] = ss;
    }
}
DI void final_norm_rows(const bf16_t* xb, const float* g, float* out, int bid, int nblk, int tid) {
    const int lane = tid & 63, w = tid >> 6;
    f32x4 gv[4];
#pragma unroll
    for (int i = 0; i < 4; ++i) gv[i] = *(const f32x4*)(g + lane * 16 + i * 4);
    for (int row = bid * 8 + w; row < T_; row += nblk * 8) {
        const bf16_t* xr = xb + (size_t)row * 1024 + lane * 16;
        const u32x4 a = *(const u32x4*)xr, b = *(const u32x4*)(xr + 8);
        f32x4 v[4];
#pragma unroll
        for (int q = 0; q < 2; ++q) { v[0][2 * q] = bf_lo(a[q]); v[0][2 * q + 1] = bf_hi(a[q]); v[1][2 * q] = bf_lo(a[2 + q]); v[1][2 * q + 1] = bf_hi(a[2 + q]);
                                      v[2][2 * q] = bf_lo(b[q]); v[2][2 * q + 1] = bf_hi(b[q]); v[3][2 * q] = bf_lo(b[2 + q]); v[3][2 * q + 1] = bf_hi(b[2 + q]); }
        float ss = 0.f;
#pragma unroll
        for (int i = 0; i < 4; ++i) ss += (v[i][0] * v[i][0] + v[i][1] * v[i][1]) + (v[i][2] * v[i][2] + v[i][3] * v[i][3]);
        ss = wave_sum(ss);
        const float rs = 1.0f / sqrtf(ss * (1.0f / 1024.0f) + 1e-6f);
#pragma unroll
        for (int i = 0; i < 4; ++i) *(f32x4*)(out + (size_t)row * 1024 + lane * 16 + i * 4) = v[i] * rs * gv[i];
    }
}
DI void mla_stats(const bf16_t* cin, float* rstd, int bid, int nblk, int tid) {
    const int lane = tid & 63, w = tid >> 6;
    for (int row = bid * 8 + w; row < T_; row += nblk * 8) {
        const bf16_t* r = cin + (size_t)row * NM_IN;
        const u32x4 a = *(const u32x4*)(r + lane * 8), b = *(const u32x4*)(r + 512 + lane * 8);
        float sa = 0.f, sb = 0.f;
#pragma unroll
        for (int i = 0; i < 4; ++i) { float lo = bf_lo(a[i]), hi = bf_hi(a[i]); sa += lo * lo + hi * hi; lo = bf_lo(b[i]); hi = bf_hi(b[i]); sb += lo * lo + hi * hi; }
        float sq = sa + (lane < 32 ? sb : 0.f), skv = (lane < 32 ? 0.f : sb);
        sq = wave_sum(sq); skv = wave_sum(skv);
        if (lane == 0) { rstd[row * 2] = 1.0f / sqrtf(sq * (1.0f / 768.0f) + 1e-6f); rstd[row * 2 + 1] = 1.0f / sqrtf(skv * (1.0f / 256.0f) + 1e-6f); }
    }
}

DI void gm_st_bf4(bf16_t* p, f32x4 v) { u32x2 o; o[0] = pk_bf16(v[0], v[1]); o[1] = pk_bf16(v[2], v[3]); *(u32x2*)p = o; }
DI void mla_krope_units(const bf16_t* xb, const bf16_t* wkr  , const float* psa, const float* c32, const float* s32, bf16_t* cin, int bid, int nblk, int tid) {
    const int w = __builtin_amdgcn_readfirstlane(tid >> 6), lane = tid & 63, r = lane & 31, hf = lane >> 5;
    for (int u = bid + w * nblk; u < T_ / 32; u += 8 * nblk) {
        const int t = u * 32 + r;
        const bf16_t* xp = xb + (size_t)t * 1024 + hf * 8;
        const bf16_t* wp = wkr + (size_t)r * 1024 + hf * 8;
        f32x16 acc = zero16(), acc2 = zero16();
#pragma unroll 1
        for (int k8 = 0; k8 < 8; ++k8) {
            bf16x8 xa[8], wa[8];
#pragma unroll
            for (int ks = 0; ks < 8; ++ks) { xa[ks] = *(const bf16x8*)(xp + (k8 * 8 + ks) * 16); wa[ks] = *(const bf16x8*)(wp + (k8 * 8 + ks) * 16); }
#pragma unroll
            for (int ks = 0; ks < 8; ++ks) { if (ks & 1) acc2 = mfma32(wa[ks], xa[ks], acc2); else acc = mfma32(wa[ks], xa[ks], acc); }
        }
        const f32x4 p0 = *(const f32x4*)(psa + (size_t)t * 8), p1 = *(const f32x4*)(psa + (size_t)t * 8 + 4);
        const float rs = 1.0f / sqrtf((((p0[0] + p0[1]) + (p0[2] + p0[3])) + ((p1[0] + p1[1]) + (p1[2] + p1[3]))) * (1.0f / 1024.0f) + 1e-6f);
#pragma unroll
        for (int q = 0; q < 2; ++q) {
            const int c0 = 8 * q + 4 * hf;
            const f32x4 cs = *(const f32x4*)(c32 + (size_t)t * 16 + c0), sn = *(const f32x4*)(s32 + (size_t)t * 16 + c0);
            f32x4 a, b;
#pragma unroll
            for (int jj = 0; jj < 4; ++jj) { a[jj] = (acc[4 * q + jj] + acc2[4 * q + jj]) * rs; b[jj] = (acc[8 + 4 * q + jj] + acc2[8 + 4 * q + jj]) * rs; }
            bf16_t* dst = cin + (size_t)t * NM_IN + 1024 + c0;
            gm_st_bf4(dst, a * cs - b * sn); gm_st_bf4(dst + 16, a * sn + b * cs);
        }
    }
}

namespace gm {
constexpr int BM = 256, BK = 64, HALF = 128, NXCD = 8, WGM = 4, HT = HALF * BK;
DI int lds_byte(int r, int c) { int st = (r >> 4) * 2 + (c >> 5), rr = r & 15, cc = c & 31, ob = rr * 64 + cc * 2; return st * 1024 + (ob ^ (((ob >> 9) & 1) << 5)); }
DI void stage_rc(int b, int& R, int& C) { int st = b / 1024, sb = b % 1024, swz = sb ^ (((sb >> 9) & 1) << 5); R = (st >> 1) * 16 + swz / 64; C = (st & 1) * 32 + (swz % 64) / 2; }

template <class Epi>
DI void gemm_phase(const bf16_t* A, int lda, const bf16_t* Bt, int M, int N, int K, const Epi& epi, unsigned char* ldsraw, int bid, int nblk) {
    bf16_t* shm = (bf16_t*)ldsraw;
#define SA(b, h) (shm + ((b) * 2 + (h)) * HT)
#define SB(b, h) (shm + (4 + (b) * 2 + (h)) * HT)
#define STAGE_X(T, P, BASE, LD, br, kt) do { long _g = (long)(br) * (LD) + (long)(kt) * BK; \
    for (int _i = 0; _i < 2; ++_i) { int _b = (T) * 16 + _i * 8192; int _r, _c; stage_rc(_b, _r, _c); \
      __builtin_amdgcn_global_load_lds((const unsigned*)((BASE) + _g + (long)_r * (LD) + _c), \
        (unsigned*)((char*)(P) + _b), 16, 0, 0); } } while (0)
#define STAGE_A(P, br, kt) STAGE_X(tv, P, A, lda, br, kt)
#define STAGE_B(P, br, kt) STAGE_X(tv, P, Bt, K, br, kt)
#define LDA(dst, b, h) for (int m = 0; m < 4; ++m) for (int k = 0; k < 2; ++k) \
    dst[m][k] = *reinterpret_cast<const bf16x8*>((char*)SA(b, h) + lds_byte(wr * 64 + m * 16 + fr, k * 32 + fq * 8))
#define LDB(dst, b, h) for (int n = 0; n < 2; ++n) for (int k = 0; k < 2; ++k) \
    dst[n][k] = *reinterpret_cast<const bf16x8*>((char*)SB(b, h) + lds_byte(wc * 32 + n * 16 + fr, k * 32 + fq * 8))
#define MMA(ai, bj, At_, Bt_) do { __builtin_amdgcn_s_setprio(1); \
    for (int m = 0; m < 4; ++m) for (int n = 0; n < 2; ++n) for (int k = 0; k < 2; ++k) \
      acc[ai][bj][m][n] = __builtin_amdgcn_mfma_f32_16x16x32_bf16(Bt_[n][k], At_[m][k], acc[ai][bj][m][n], 0, 0, 0); \
    __builtin_amdgcn_s_setprio(0); } while (0)
#define WAIT_V(n) asm volatile("s_waitcnt vmcnt(" #n ")" ::: "memory")
#define WAIT_L(n) asm volatile("s_waitcnt lgkmcnt(" #n ")" ::: "memory")
#define BAR __builtin_amdgcn_s_barrier()
#define SCHED __builtin_amdgcn_sched_barrier(0)
    const int nM = M / BM, nN = N / BM, nwg = nM * nN, nt = K / BK;
    for (int it = 0;; ++it) {
        const long L = (long)it * nblk + bid;
        if (L >= nwg) break;
        int wgid = (int)L;
        { int q = nwg / NXCD, r = nwg % NXCD, xcd = wgid % NXCD, off = wgid / NXCD; wgid = (xcd < r ? xcd * (q + 1) : r * (q + 1) + (xcd - r) * q) + off; }
        const int nig = WGM * nN, gid = wgid / nig, fm = gid * WGM, gsz = min(nM - fm, WGM);
        const int pm = fm + ((wgid % nig) % gsz), pn = (wgid % nig) / gsz, brow = pm * BM, bcol = pn * BM;
        int tv = threadIdx.x; asm volatile("" : "+v"(tv));
        int wid = tv >> 6, lane = tv & 63, wr = wid >> 2, wc = wid & 3, fr = lane & 15, fq = lane >> 4;
        f32x4 acc[2][2][4][2] = {};
        bf16x8 At[4][2], B0[2][2], B1[2][2];
        f32x4 q0 = {0.f, 0.f, 0.f, 0.f}, q1 = {0.f, 0.f, 0.f, 0.f};
        if (epi.psa && tv < 256) {
            const float* pp = epi.psa + ((size_t)brow + tv) * Epi::PS_STRIDE + Epi::PS_FIRST;
            q0 = *(const f32x4*)pp;
            if (Epi::PS_COUNT >= 8) q1 = *(const f32x4*)(pp + 4);
            if (Epi::PS_COUNT >= 12) q0 += *(const f32x4*)(pp + 8);
            if (Epi::PS_COUNT >= 16) q1 += *(const f32x4*)(pp + 12);
        }
        STAGE_B(SB(0, 0), bcol, 0); STAGE_A(SA(0, 0), brow, 0);
        STAGE_B(SB(0, 1), bcol + HALF, 0); STAGE_A(SA(0, 1), brow + HALF, 0);
        if (wr == 1) BAR;
        WAIT_V(4); BAR;
        STAGE_B(SB(1, 0), bcol, 1); STAGE_A(SA(1, 0), brow, 1); STAGE_B(SB(1, 1), bcol + HALF, 1);
        WAIT_V(6); BAR;
        if (epi.psa && tv < 256)
            *(LAS float*)((LAS unsigned char*)ldsraw + 131072 + (it & 1) * 1024 + tv * 4) = 1.0f / sqrtf((((q0[0] + q0[1]) + (q0[2] + q0[3])) + ((q1[0] + q1[1]) + (q1[2] + q1[3]))) * (1.0f / (float)Epi::PS_DIV) + 1e-6f);
        for (int t = 0; t < nt - 2; t += 2) {
            LDB(B0, 0, 0); SCHED; LDA(At, 0, 0); STAGE_A(SA(1, 1), brow + HALF, t + 1);
            WAIT_L(8); BAR; WAIT_L(0); MMA(0, 0, At, B0); BAR; SCHED;
            LDB(B1, 0, 1); STAGE_B(SB(0, 0), bcol, t + 2);
            BAR; WAIT_L(0); MMA(0, 1, At, B1); BAR;
            LDA(At, 0, 1); STAGE_A(SA(0, 0), brow, t + 2);
            BAR; WAIT_L(0); MMA(1, 0, At, B0); BAR; SCHED;
            STAGE_B(SB(0, 1), bcol + HALF, t + 2);
            WAIT_V(6); BAR; MMA(1, 1, At, B1); BAR;
            LDB(B0, 1, 0); SCHED; LDA(At, 1, 0); STAGE_A(SA(0, 1), brow + HALF, t + 2);
            WAIT_L(8); BAR; WAIT_L(0); MMA(0, 0, At, B0); BAR; SCHED;
            LDB(B1, 1, 1); STAGE_B(SB(1, 0), bcol, t + 3);
            BAR; WAIT_L(0); MMA(0, 1, At, B1); BAR;
            LDA(At, 1, 1); STAGE_A(SA(1, 0), brow, t + 3);
            BAR; WAIT_L(0); MMA(1, 0, At, B0); BAR; SCHED;
            STAGE_B(SB(1, 1), bcol + HALF, t + 3);
            WAIT_V(6); BAR; MMA(1, 1, At, B1); BAR;
        }
        int tz = threadIdx.x; asm volatile("" : "+v"(tz)); wid = tz >> 6; lane = tz & 63; wr = wid >> 2; wc = wid & 3; fr = lane & 15; fq = lane >> 4;
        { LDB(B0, 0, 0); WAIT_V(0); LDA(At, 0, 0); STAGE_X(tz, SA(1, 1), A, lda, brow + HALF, nt - 1);
          BAR; WAIT_L(0); MMA(0, 0, At, B0); BAR;
          LDB(B1, 0, 1); BAR; WAIT_L(0); MMA(0, 1, At, B1); BAR;
          LDA(At, 0, 1); WAIT_V(4); BAR; WAIT_L(0); MMA(1, 0, At, B0); MMA(1, 1, At, B1); BAR; }
        { LDB(B0, 1, 0); LDA(At, 1, 0); WAIT_V(2); BAR; WAIT_L(0); MMA(0, 0, At, B0); BAR;
          LDB(B1, 1, 1); WAIT_V(0); BAR; WAIT_L(0); MMA(0, 1, At, B1); BAR;
          LDA(At, 1, 1); BAR; WAIT_L(0); MMA(1, 0, At, B0); MMA(1, 1, At, B1); BAR; }
        if (wr == 0) BAR;
        { int ty = threadIdx.x; asm volatile("" : "+v"(ty)); const int wid2 = ty >> 6, lane2 = ty & 63;
          if (epi.psa) {
#pragma unroll
              for (int ai = 0; ai < 2; ++ai)
#pragma unroll
                  for (int m = 0; m < 4; ++m) {
                      const float rs = *(const LAS float*)((LAS unsigned char*)ldsraw + 131072 + (it & 1) * 1024 + (ai * 128 + (wid2 >> 2) * 64 + m * 16 + (lane2 & 15)) * 4);
#pragma unroll
                      for (int bj = 0; bj < 2; ++bj)
#pragma unroll
                          for (int n = 0; n < 2; ++n) acc[ai][bj][m][n] *= rs;
                  }
          }
          epi(acc, pm, pn, wid2 >> 2, wid2 & 3, lane2 & 15, lane2 >> 4); }
    }
#undef SA
#undef SB
#undef STAGE_X
#undef STAGE_A
#undef STAGE_B
#undef LDA
#undef LDB
#undef MMA
#undef WAIT_V
#undef WAIT_L
#undef BAR
#undef SCHED
}

DI void st_bf4(bf16_t* p, f32x4 v) { u32x2 o; o[0] = pk_bf16(v[0], v[1]); o[1] = pk_bf16(v[2], v[3]); *(u32x2*)p = o; }
DI void st_bf8(bf16_t* p, f32x4 a, f32x4 b) { u32x4 o; o[0] = pk_bf16(a[0], a[1]); o[1] = pk_bf16(a[2], a[3]); o[2] = pk_bf16(b[0], b[1]); o[3] = pk_bf16(b[2], b[3]); *(u32x4*)p = o; }

struct EpiEvenIn {
    static constexpr int PS_STRIDE = 8, PS_FIRST = 0, PS_COUNT = 8, PS_DIV = 1024;
    bf16_t* proj; bf16_t* vaT; bf16_t* vbT; float* iw; const float* c64; const float* s64; const float* psa;
    DI void operator()(const f32x4 (&acc)[2][2][4][2], int pm, int pn, int wr, int wc, int fr, int fq) const {
        const float qscale = 0.125f * LOG2E;
        const int g = pn * 4 + wc, d0 = 8 * fq;
        const int kind = (g < 8 || (g >= 19 && g < 27)) ? 0 : (g == 9) ? 2 : (g >= 35 && g < 43) ? 3 : (g == 43) ? 4 : (g > 43) ? 5 : 1;
#pragma unroll
        for (int ai = 0; ai < 2; ++ai)
#pragma unroll
            for (int m = 0; m < 4; ++m) {
                const int t = pm * 256 + ai * 128 + wr * 64 + m * 16 + fr;
                if (kind <= 1) {
                    f32x4 y0[2], y1[2];
#pragma unroll
                    for (int n = 0; n < 2; ++n) {
                        const f32x4 c = *(const f32x4*)(c64 + (size_t)t * 32 + d0 + 4 * n), sn = *(const f32x4*)(s64 + (size_t)t * 32 + d0 + 4 * n);
                        const f32x4 v0 = acc[ai][0][m][n], v1 = acc[ai][1][m][n];
                        y0[n] = v0 * c - v1 * sn; y1[n] = v0 * sn + v1 * c;
                        if (kind == 0) { y0[n] *= qscale; y1[n] *= qscale; }
                    }
                    bf16_t* dst = proj + (size_t)t * NE_IN + g * 64 + d0;
                    st_bf8(dst, y0[0], y0[1]); st_bf8(dst + 32, y1[0], y1[1]);
                } else if (kind == 2 || kind == 3) {
                    bf16_t* dst = proj + (size_t)t * NE_IN + g * 64 + d0;
                    st_bf8(dst, acc[ai][0][m][0], acc[ai][0][m][1]); st_bf8(dst + 32, acc[ai][1][m][0], acc[ai][1][m][1]);
                } else if (kind == 4) {
                    if (fq == 0) { *(f32x4*)(iw + (size_t)t * 8) = acc[ai][0][m][0]; *(f32x4*)(iw + (size_t)t * 8 + 4) = acc[ai][0][m][1]; }
                }
            }
    }
};
struct EpiMlaIn {
    static constexpr int PS_STRIDE = 8, PS_FIRST = 0, PS_COUNT = 8, PS_DIV = 1024;
    bf16_t* cin; const float* c32; const float* s32; float* ps; const float* psa;
    DI void operator()(const f32x4 (&acc)[2][2][4][2], int pm, int pn, int wr, int wc, int fr, int fq) const {
        if (pn < 4) {
#pragma unroll
            for (int ai = 0; ai < 2; ++ai)
#pragma unroll
                for (int m = 0; m < 4; ++m) {
                    float ss = 0.f;
#pragma unroll
                    for (int bj = 0; bj < 2; ++bj)
#pragma unroll
                        for (int n = 0; n < 2; ++n) { const f32x4 a = acc[ai][bj][m][n]; ss += a[0] * a[0] + a[1] * a[1] + a[2] * a[2] + a[3] * a[3]; }
                    ss += __shfl_xor(ss, 16, 64); ss += __shfl_xor(ss, 32, 64);
                    const int t = pm * 256 + ai * 128 + wr * 64 + m * 16 + fr;
                    if (fq == 0) ps[(size_t)t * 16 + pn * 4 + wc] = ss;
                }
        }
#pragma unroll
        for (int bj = 0; bj < 2; ++bj) {
            const int colbase = pn * 256 + bj * 128 + wc * 32;
            if (colbase > 1024) continue;
#pragma unroll
            for (int ai = 0; ai < 2; ++ai)
#pragma unroll
                for (int m = 0; m < 4; ++m) {
                    const int t = pm * 256 + ai * 128 + wr * 64 + m * 16 + fr;
                    if (colbase == 1024) {
                        const f32x4 c = *(const f32x4*)(c32 + (size_t)t * 16 + 4 * fq), sn = *(const f32x4*)(s32 + (size_t)t * 16 + 4 * fq);
                        const f32x4 a = acc[ai][bj][m][0], b = acc[ai][bj][m][1];
                        bf16_t* dst = cin + (size_t)t * NM_IN + colbase + 4 * fq;
                        st_bf4(dst, a * c - b * sn); st_bf4(dst + 16, a * sn + b * c);
                    } else st_bf8(cin + (size_t)t * NM_IN + colbase + 8 * fq, acc[ai][bj][m][0], acc[ai][bj][m][1]);
                }
        }
    }
};
struct EpiQup {
    static constexpr int PS_STRIDE = 16, PS_FIRST = 0, PS_COUNT = 12, PS_DIV = 768;
    bf16_t* qm; const float* rstd; const float* c32; const float* s32; const float* psa;
    DI void operator()(const f32x4 (&acc)[2][2][4][2], int pm, int pn, int wr, int wc, int fr, int fq) const {
        const float qscale = 0.10206207261596575f * LOG2E;
#pragma unroll
        for (int bj = 0; bj < 2; ++bj) {
            const int colbase = pn * 256 + bj * 128 + wc * 32;
            const bool rope = ((colbase >> 5) % 3) == 2;
#pragma unroll
            for (int ai = 0; ai < 2; ++ai)
#pragma unroll
                for (int m = 0; m < 4; ++m) {
                    const int t = pm * 256 + ai * 128 + wr * 64 + m * 16 + fr;
                    const float rs = qscale;
                    const f32x4 a = acc[ai][bj][m][0] * rs, b = acc[ai][bj][m][1] * rs;
                    if (rope) {
                        const f32x4 c = *(const f32x4*)(c32 + (size_t)t * 16 + 4 * fq), sn = *(const f32x4*)(s32 + (size_t)t * 16 + 4 * fq);
                        bf16_t* dst = qm + (size_t)t * 1536 + colbase + 4 * fq;
                        st_bf4(dst, a * c - b * sn); st_bf4(dst + 16, a * sn + b * c);
                    } else st_bf8(qm + (size_t)t * 1536 + colbase + 8 * fq, a, b);
                }
        }
    }
};
struct EpiKVup {
    static constexpr int PS_STRIDE = 16, PS_FIRST = 12, PS_COUNT = 4, PS_DIV = 256;
    bf16_t* kn; bf16_t* vn; const float* rstd; const float* psa;
    DI void operator()(const f32x4 (&acc)[2][2][4][2], int pm, int pn, int wr, int wc, int fr, int fq) const {
#pragma unroll
        for (int bj = 0; bj < 2; ++bj) {
            const int colbase = pn * 256 + bj * 128 + wc * 32;
            const int g = colbase >> 6, h = g >> 1, within = colbase & 63;
            const long dv = vn - kn;
            bf16_t* const dstb = kn + ((g & 1) ? dv : 0L) + h * 64 + within + 8 * fq;
#pragma unroll
            for (int ai = 0; ai < 2; ++ai)
#pragma unroll
                for (int m = 0; m < 4; ++m) {
                    const int t = pm * 256 + ai * 128 + wr * 64 + m * 16 + fr;
                    st_bf8(dstb + (size_t)t * 1024, acc[ai][bj][m][0], acc[ai][bj][m][1]);
                }
        }
    }
};
struct EpiResid {
    static constexpr int PS_STRIDE = 8, PS_FIRST = 0, PS_COUNT = 8, PS_DIV = 1024;
    bf16_t* xb; float* ps; const float* psa;
    DI void operator()(const f32x4 (&acc)[2][2][4][2], int pm, int pn, int wr, int wc, int fr, int fq) const {
#pragma unroll
        for (int ai = 0; ai < 2; ++ai)
#pragma unroll
            for (int m = 0; m < 4; ++m) {
                const size_t t = pm * 256 + ai * 128 + wr * 64 + m * 16 + fr;
                float ss = 0.f;
#pragma unroll
                for (int bj = 0; bj < 2; ++bj) {
                    bf16_t* px = xb + t * 1024 + pn * 256 + bj * 128 + wc * 32 + 8 * fq;
                    const u32x4 xo = *(const u32x4*)px;
                    const f32x4 a0 = acc[ai][bj][m][0], a1 = acc[ai][bj][m][1];
                    const f32x4 y0 = {bf_lo(xo[0]) + a0[0], bf_hi(xo[0]) + a0[1], bf_lo(xo[1]) + a0[2], bf_hi(xo[1]) + a0[3]};
                    const f32x4 y1 = {bf_lo(xo[2]) + a1[0], bf_hi(xo[2]) + a1[1], bf_lo(xo[3]) + a1[2], bf_hi(xo[3]) + a1[3]};
                    st_bf8(px, y0, y1);
                    ss += (y0[0] * y0[0] + y0[1] * y0[1]) + (y0[2] * y0[2] + y0[3] * y0[3]) + (y1[0] * y1[0] + y1[1] * y1[1]) + (y1[2] * y1[2] + y1[3] * y1[3]);
                }
                ss += __shfl_xor(ss, 16, 64); ss += __shfl_xor(ss, 32, 64);
                if (fq == 0) ps[t * 16 + pn * 4 + wc] = ss;
            }
    }
};
struct EpiBf16 {
    static constexpr int PS_STRIDE = 16, PS_FIRST = 0, PS_COUNT = 16, PS_DIV = 1024;
    bf16_t* out; int ld; const float* psa;
    DI void operator()(const f32x4 (&acc)[2][2][4][2], int pm, int pn, int wr, int wc, int fr, int fq) const {
#pragma unroll
        for (int ai = 0; ai < 2; ++ai)
#pragma unroll
            for (int m = 0; m < 4; ++m) {
                const size_t t = pm * 256 + ai * 128 + wr * 64 + m * 16 + fr;
#pragma unroll
                for (int bj = 0; bj < 2; ++bj) st_bf8(out + t * ld + pn * 256 + bj * 128 + wc * 32 + 8 * fq, acc[ai][bj][m][0], acc[ai][bj][m][1]);
            }
    }
};
}

namespace at {
constexpr int KT = 128, VROW = KT * 2 + 16;
template <int MODE> struct Cfg { static constexpr int DQK = (MODE == 0) ? 96 : 64, NKS = DQK / 16, KROW = DQK * 2 + 16, NCH = DQK / 8, NKL = KT * NCH / 512, KBYTES = KT * KROW, BUFSZ = KBYTES + 64 * VROW; };
struct Args { const bf16_t* q; const bf16_t* k; const bf16_t* k2; const bf16_t* vT; const unsigned* mask; bf16_t* o; };

template <int MODE>
DI void attn_unit(const Args& a, int b, int h, int qt, unsigned char* lds, int tid) {
    constexpr int DQK = Cfg<MODE>::DQK, NKS = Cfg<MODE>::NKS, KROW = Cfg<MODE>::KROW, NCH = Cfg<MODE>::NCH, NKL = Cfg<MODE>::NKL, KBYTES = Cfg<MODE>::KBYTES, BUFSZ = Cfg<MODE>::BUFSZ;
    const int w = __builtin_amdgcn_readfirstlane(tid >> 6), lane = tid & 63, r = lane & 31, hf = lane >> 5;
    int tq, qpos, wmin, wlast, nt;
    const bf16_t* qptr; bf16_t* optr;
    if (MODE == 2) {
        const int qloc = w * 4 + (r >> 3), head = r & 7;
        qpos = qt * 32 + qloc; tq = b * S_ + qpos; wmin = qt * 32 + w * 4; wlast = (qt * 32 + w * 4 + 3) >> 7; nt = ((qt * 32 + 31) >> 7) + 1;
        qptr = a.q + (size_t)tq * NE_IN + C_QA + head * 64; optr = a.o + (size_t)tq * 1024 + head * 64;
    } else {
        qpos = qt * 256 + w * 32 + r; tq = b * S_ + qpos; wmin = qt * 256 + w * 32; wlast = 2 * qt + (w >> 2); nt = 2 * (qt + 1);
        if (MODE == 0) { qptr = a.q + (size_t)tq * 1536 + h * 96; optr = a.o + (size_t)tq * 1024 + h * 64; }
        else { qptr = a.q + (size_t)tq * NE_IN + C_QB + h * 64; optr = a.o + (size_t)tq * 1024 + 512 + h * 64; }
    }
    bf16x8 qf[NKS];
#pragma unroll
    for (int ks = 0; ks < NKS; ++ks) qf[ks] = *(const bf16x8*)(qptr + ks * 16 + hf * 8);

    const bf16_t* kp[NKL]; size_t kstep[NKL]; int kdst[NKL];
#pragma unroll
    for (int j = 0; j < NKL; ++j) {
        const int idx = tid + 512 * j, kr = idx / NCH, kc = idx % NCH;
        kdst[j] = kr * KROW + kc * 16;
        if (MODE == 0) {
            if (kc < 8) { kp[j] = a.k + (size_t)(b * S_ + kr) * 1024 + h * 64 + kc * 8; kstep[j] = (size_t)KT * 1024; }
            else { kp[j] = a.k2 + (size_t)(b * S_ + kr) * NM_IN + 1024 + (kc - 8) * 8; kstep[j] = (size_t)KT * NM_IN; }
        } else { kp[j] = a.k + (size_t)(b * S_ + kr) * NE_IN + (MODE == 1 ? C_KB + h * 64 : C_KA) + kc * 8; kstep[j] = (size_t)KT * NE_IN; }
    }
    const bf16_t* vp[2]; int vdst[2];
#pragma unroll
    for (int j = 0; j < 2; ++j) {
        const int idx = tid + 512 * j, vd = idx >> 4, vc = idx & 15;
        vp[j] = a.vT + ((size_t)((MODE == 0) ? (b * 16 + h) : (MODE == 1) ? (b * 8 + h) : b) * 64 + vd) * S_ + vc * 8;
        vdst[j] = KBYTES + vd * VROW + (vc >> 1) * 32 + (vc & 1) * 8;
    }
    const unsigned* mp = (MODE == 2) ? a.mask + (size_t)tq * 64 : nullptr;

    unsigned blkmask = 0xffu;
    if (MODE == 1) {
        const int own = qt;
        float* kmw = (float*)(lds + 2 * BUFSZ); float* km = kmw + 7 * 8 * 64;
        {
            const int kc = lane & 7, kg = tid >> 3;
            const bf16_t* kb = a.k + (size_t)(b * S_ + kg * 4) * NE_IN + C_KB + h * 64 + kc * 8;
            u32x4 kv[7][4];
#pragma unroll
            for (int n = 0; n < 7; ++n) if (n < own) {
#pragma unroll
                for (int kk = 0; kk < 4; ++kk) kv[n][kk] = *(const u32x4*)(kb + (size_t)(n * 256 + kk) * NE_IN);
            }
#pragma unroll
            for (int n = 0; n < 7; ++n) if (n < own) {
                float sa[8];
#pragma unroll
                for (int e = 0; e < 8; ++e) sa[e] = 0.f;
#pragma unroll
                for (int kk = 0; kk < 4; ++kk)
#pragma unroll
                    for (int q = 0; q < 4; ++q) { sa[2 * q] += bf_lo(kv[n][kk][q]); sa[2 * q + 1] += bf_hi(kv[n][kk][q]); }
#pragma unroll
                for (int e = 0; e < 8; ++e) { sa[e] += __shfl_xor(sa[e], 8, 64); sa[e] += __shfl_xor(sa[e], 16, 64); sa[e] += __shfl_xor(sa[e], 32, 64); }
                if (lane < 8) { float* dst = kmw + (n * 8 + w) * 64 + kc * 8; *(f32x4*)dst = (f32x4){sa[0], sa[1], sa[2], sa[3]}; *(f32x4*)(dst + 4) = (f32x4){sa[4], sa[5], sa[6], sa[7]}; }
            }
        }
        __syncthreads();
        if (tid < own * 64) { const int n = tid >> 6, d = tid & 63; float sacc = 0.f;
#pragma unroll
            for (int ww = 0; ww < 8; ++ww) sacc += kmw[(n * 8 + ww) * 64 + d];
            km[n * 64 + d] = sacc * (1.0f / 256.0f); }
        __syncthreads();
        float gt[7];
#pragma unroll
        for (int n = 0; n < 7; ++n) {
            float g = 0.f;
            if (n < own) {
#pragma unroll
                for (int ks = 0; ks < NKS; ++ks)
#pragma unroll
                    for (int j = 0; j < 8; ++j) g += __uint_as_float((unsigned)(unsigned short)qf[ks][j] << 16) * km[n * 64 + ks * 16 + hf * 8 + j];
                g += __shfl_xor(g, 32, 64);
            }
            gt[n] = g;
        }
        blkmask = 1u << own;
#pragma unroll
        for (int n = 0; n < 7; ++n) {
            int rank = 0;
#pragma unroll
            for (int n2 = 0; n2 < 7; ++n2) if (n2 != n) rank += (n2 < own && (gt[n2] > gt[n] || (gt[n2] == gt[n] && n2 < n))) ? 1 : 0;
            if (n < own && rank < 3) blkmask |= 1u << n;
        }
    }

    u32x4 kreg[NKL], vreg[2]; u32x4 mw = {0u, 0u, 0u, 0u}, mwn = {0u, 0u, 0u, 0u};
#pragma unroll
    for (int j = 0; j < NKL; ++j) kreg[j] = *(const u32x4*)kp[j];
#pragma unroll
    for (int j = 0; j < 2; ++j) vreg[j] = *(const u32x4*)vp[j];
    if (MODE == 2) mw = *(const u32x4*)mp;
#pragma unroll
    for (int j = 0; j < NKL; ++j) *(u32x4*)(lds + kdst[j]) = kreg[j];
#pragma unroll
    for (int j = 0; j < 2; ++j) { *(u32x2*)(lds + vdst[j]) = (u32x2){vreg[j][0], vreg[j][1]}; *(u32x2*)(lds + vdst[j] + 16) = (u32x2){vreg[j][2], vreg[j][3]}; }
    __syncthreads();

    float m = NEG_INF, lsum = 0.f;
    f32x16 o0 = zero16(), o1 = zero16();
    if (w >= 4) __builtin_amdgcn_s_setprio(1);
    for (int i = 0; i < nt; ++i) {
        const bool more = (i + 1 < nt);
        if (more) {
#pragma unroll
            for (int j = 0; j < NKL; ++j) { kp[j] += kstep[j]; kreg[j] = *(const u32x4*)kp[j]; }
#pragma unroll
            for (int j = 0; j < 2; ++j) { vp[j] += KT; vreg[j] = *(const u32x4*)vp[j]; }
            if (MODE == 2) mwn = *(const u32x4*)(mp + 4 * (i + 1));
        }
        const unsigned char* Kb = lds + (i & 1) * BUFSZ; const unsigned char* Vb = Kb + KBYTES;
        bool active = (i <= wlast);
        if (MODE == 1) active = active && (__ballot((blkmask >> (i >> 1)) & 1u) != 0ull);
        if (active) {
            f32x16 s[4];
#pragma unroll
            for (int mt = 0; mt < 4; ++mt) {
                s[mt] = zero16();
#pragma unroll
                for (int ks = 0; ks < NKS; ++ks) s[mt] = mfma32(*(const bf16x8*)(Kb + (mt * 32 + r) * KROW + ks * 32 + hf * 16), qf[ks], s[mt]);
            }
            if (MODE == 2) {
#pragma unroll
                for (int mt = 0; mt < 4; ++mt) { const unsigned wd = mw[mt] >> (4 * hf);
#pragma unroll
                    for (int e = 0; e < 16; ++e) { const int bit = (e & 3) + 8 * (e >> 2); s[mt][e] = ((wd >> bit) & 1u) ? s[mt][e] : NEG_INF; } }
            } else {
                if (MODE == 1) { const bool allowed = (blkmask >> (i >> 1)) & 1u;
                    if (!allowed) {
#pragma unroll
                        for (int mt = 0; mt < 4; ++mt)
#pragma unroll
                            for (int e = 0; e < 16; ++e) s[mt][e] = NEG_INF; } }
                if (i * KT + KT - 1 > wmin) {
#pragma unroll
                    for (int mt = 0; mt < 4; ++mt) { const int kb0 = i * KT + mt * 32 + 4 * hf;
#pragma unroll
                        for (int e = 0; e < 16; ++e) { const int key = kb0 + (e & 3) + 8 * (e >> 2); s[mt][e] = (key <= qpos) ? s[mt][e] : NEG_INF; } }
                }
            }
            float mx4[4];
#pragma unroll
            for (int mt = 0; mt < 4; ++mt) { mx4[mt] = s[mt][0];
#pragma unroll
                for (int e = 1; e < 16; ++e) mx4[mt] = fmaxf(mx4[mt], s[mt][e]); }
            float mx = fmaxf(fmaxf(mx4[0], mx4[1]), fmaxf(mx4[2], mx4[3]));
            mx = fmaxf(mx, __shfl_xor(mx, 32, 64));
            const float mnew = fmaxf(m, mx), muse = (mnew == NEG_INF) ? 0.f : mnew;
            const float alpha = __builtin_amdgcn_exp2f(m - muse);
            float rs4[4];
#pragma unroll
            for (int mt = 0; mt < 4; ++mt) { rs4[mt] = 0.f;
#pragma unroll
                for (int e = 0; e < 16; ++e) { s[mt][e] = __builtin_amdgcn_exp2f(s[mt][e] - muse); rs4[mt] += s[mt][e]; } }
            lsum = lsum * alpha + ((rs4[0] + rs4[1]) + (rs4[2] + rs4[3])); m = mnew;
#pragma unroll
            for (int e = 0; e < 16; ++e) { o0[e] *= alpha; o1[e] *= alpha; }
#pragma unroll
            for (int mt = 0; mt < 4; ++mt)
#pragma unroll
                for (int sp = 0; sp < 2; ++sp) {
                    u32x4 pp;
#pragma unroll
                    for (int j = 0; j < 4; ++j) pp[j] = pk_bf16(s[mt][8 * sp + 2 * j], s[mt][8 * sp + 2 * j + 1]);
                    const bf16x8 pb = __builtin_bit_cast(bf16x8, pp);
                    const int koff = (mt * 32 + 16 * sp) * 2 + hf * 16;
                    o0 = mfma32(*(const bf16x8*)(Vb + r * VROW + koff), pb, o0);
                    o1 = mfma32(*(const bf16x8*)(Vb + (32 + r) * VROW + koff), pb, o1);
                }
        }
        if (more) {
            unsigned char* Nb = lds + ((i + 1) & 1) * BUFSZ;
#pragma unroll
            for (int j = 0; j < NKL; ++j) *(u32x4*)(Nb + kdst[j]) = kreg[j];
#pragma unroll
            for (int j = 0; j < 2; ++j) { *(u32x2*)(Nb + vdst[j]) = (u32x2){vreg[j][0], vreg[j][1]}; *(u32x2*)(Nb + vdst[j] + 16) = (u32x2){vreg[j][2], vreg[j][3]}; }
            if (MODE == 2) mw = mwn;
        }
        __syncthreads();
    }
    __builtin_amdgcn_s_setprio(0);
    const float ltot = lsum + __shfl_xor(lsum, 32, 64);
    float inv = 1.0f / ltot;
    if ((DBG_SKIP >> (MODE == 2 ? 1 : MODE == 1 ? 2 : 3)) & 1) inv = 0.f;
#pragma unroll
    for (int g4 = 0; g4 < 4; ++g4) {
        f32x4 v0 = {o0[4 * g4] * inv, o0[4 * g4 + 1] * inv, o0[4 * g4 + 2] * inv, o0[4 * g4 + 3] * inv};
        f32x4 v1 = {o1[4 * g4] * inv, o1[4 * g4 + 1] * inv, o1[4 * g4 + 2] * inv, o1[4 * g4 + 3] * inv};
        gm::st_bf4(optr + 8 * g4 + 4 * hf, v0); gm::st_bf4(optr + 32 + 8 * g4 + 4 * hf, v1);
    }
}
}

namespace ab {
typedef bf16_t bf16;
constexpr int SEQ=S_,D=64,DM=NE_IN,OM=1024;
constexpr int NW=8,QBLK=32,QB=QBLK*NW,KVBLK=64;
__device__ __forceinline__ int crow(int r,int hi){return (r&3)+8*(r>>2)+4*hi;}
#define SBAR() __builtin_amdgcn_sched_barrier(0)
__device__ __forceinline__ void cmask(f32x16&p0,f32x16&p1,int jb,int qrel,int hi){
  const float NEG=-INFINITY; int kb=64*jb+4*hi;
  #pragma unroll
  for(int r=0;r<16;++r){int kv=kb+(r&3)+8*(r>>2); if(kv>qrel)p0[r]=NEG; if(kv+32>qrel)p1[r]=NEG;}
}

constexpr int NSLOT=3, SLOTB=8192;
constexpr int LDS_K=0, LDS_V=NSLOT*SLOTB, LDS_WS=2*NSLOT*SLOTB, LDS_OST=LDS_WS+NW*64*4, LDS_BYTES=LDS_OST+NW*4096;
constexpr float C2=0.125f*1.4426950408889634f;
__device__ __forceinline__ void glds16(const void*gsrc,unsigned lds_dst){unsigned keep;
  asm volatile("s_mov_b32 %0, m0\n\ts_mov_b32 m0, %2\n\ts_nop 0\n\tglobal_load_lds_dwordx4 %1, off\n\ts_mov_b32 m0, %0":"=&s"(keep):"v"(gsrc),"s"(lds_dst):"memory");}
__device__ __forceinline__ float max3f(float a,float b,float c){float r;asm("v_max3_f32 %0, %1, %2, %3":"=v"(r):"v"(a),"v"(b),"v"(c));return r;}
__device__ __forceinline__ float max2f(float a,float b){float r;asm("v_max_f32_e32 %0, %1, %2":"=v"(r):"v"(a),"v"(b));return r;}
__device__ __forceinline__ float fadd_s(float a,float b){float r;asm("v_add_f32_e32 %0, %1, %2":"=v"(r):"v"(a),"v"(b));return r;}
__device__ __forceinline__ float fsub_s(float a,float b){float r;asm("v_sub_f32_e32 %0, %1, %2":"=v"(r):"v"(a),"v"(b));return r;}
typedef float f32x2_t __attribute__((ext_vector_type(2))); typedef __bf16 bf16x2_t __attribute__((ext_vector_type(2)));
__device__ __forceinline__ unsigned cvtpk_s(float lo,float hi){f32x2_t v={lo,hi};bf16x2_t b=__builtin_convertvector(v,bf16x2_t);return __builtin_bit_cast(unsigned,b);}
#define WAIT_BAR(N) asm volatile("s_waitcnt vmcnt(" #N ") lgkmcnt(0)\n\ts_barrier":::"memory")

__device__ __forceinline__ void qkt(f32x16&p0,f32x16&p1,const char*Kslot,const bf16x8*qr,const f32x16&negm,int r32,int hi){
  const char*kb=Kslot+hi*1024+r32*16;
  #pragma unroll
  for(int d0=0;d0<4;++d0){
    const bf16x8 b0=*reinterpret_cast<const bf16x8*>(kb+d0*2048);
    const bf16x8 b1=*reinterpret_cast<const bf16x8*>(kb+d0*2048+512);
    if(d0==0){p0=__builtin_amdgcn_mfma_f32_32x32x16_bf16(b0,qr[0],negm,0,0,0);p1=__builtin_amdgcn_mfma_f32_32x32x16_bf16(b1,qr[0],negm,0,0,0);}
    else{p0=__builtin_amdgcn_mfma_f32_32x32x16_bf16(b0,qr[d0],p0,0,0,0);p1=__builtin_amdgcn_mfma_f32_32x32x16_bf16(b1,qr[d0],p1,0,0,0);}}
}
typedef __attribute__((address_space(3))) const char* lds_cptr;
typedef short v4i16_t __attribute__((ext_vector_type(4)));
__device__ __forceinline__ void kload8(bf16x8*kf,lds_cptr kp){
  kf[0]=*(const __attribute__((address_space(3))) bf16x8*)(kp);      kf[1]=*(const __attribute__((address_space(3))) bf16x8*)(kp+512);
  kf[2]=*(const __attribute__((address_space(3))) bf16x8*)(kp+2048); kf[3]=*(const __attribute__((address_space(3))) bf16x8*)(kp+2560);
  kf[4]=*(const __attribute__((address_space(3))) bf16x8*)(kp+4096); kf[5]=*(const __attribute__((address_space(3))) bf16x8*)(kp+4608);
  kf[6]=*(const __attribute__((address_space(3))) bf16x8*)(kp+6144); kf[7]=*(const __attribute__((address_space(3))) bf16x8*)(kp+6656);
}
__device__ __forceinline__ void kload2(bf16x8*kf,lds_cptr kp,int j){ kf[2*j]=*(const __attribute__((address_space(3))) bf16x8*)(kp+j*2048); kf[2*j+1]=*(const __attribute__((address_space(3))) bf16x8*)(kp+j*2048+512); }
__device__ __forceinline__ s16x4 vtr(lds_cptr p){ return __builtin_bit_cast(s16x4,__builtin_amdgcn_ds_read_tr16_b64_v4i16((__attribute__((address_space(3))) v4i16_t*)p)); }
__device__ __forceinline__ float rowmax(const f32x16&p0,const f32x16&p1){
  float a=max3f(p0[0],p0[1],p1[0]),b=max3f(p0[2],p0[3],p1[1]);a=max3f(a,p1[2],p1[3]);
  #pragma unroll
  for(int r=4;r<16;r+=4){a=max3f(a,p0[r],p0[r+1]);b=max3f(b,p0[r+2],p0[r+3]);a=max3f(a,p1[r],p1[r+1]);b=max3f(b,p1[r+2],p1[r+3]);}
  const float m=max2f(a,b);
  auto rr=__builtin_amdgcn_permlane32_swap(__float_as_uint(m),__float_as_uint(m),false,false);
  return max2f(__uint_as_float(rr[0]),__uint_as_float(rr[1]));
}
__device__ __forceinline__ void pv(f32x16*o,int vb,bf16x8 pa0,bf16x8 pa1,bf16x8 pa2,bf16x8 pa3){
  #pragma unroll
  for(int d0=0;d0<2;++d0){s16x4 lo[4],hi[4];
    #pragma unroll
    for(int ks=0;ks<4;++ks){
      asm volatile("ds_read_b64_tr_b16 %0,%1 offset:%c2":"=&v"(lo[ks]):"v"(vb),"i"(d0*4096+ks*1024):"memory");
      asm volatile("ds_read_b64_tr_b16 %0,%1 offset:%c2":"=&v"(hi[ks]):"v"(vb),"i"(d0*4096+ks*1024+512):"memory");}
    asm volatile("s_waitcnt lgkmcnt(0)":::"memory");SBAR();
    #define PK(k) (bf16x8){lo[k][0],lo[k][1],lo[k][2],lo[k][3],hi[k][0],hi[k][1],hi[k][2],hi[k][3]}
    o[d0]=__builtin_amdgcn_mfma_f32_32x32x16_bf16(pa0,PK(0),o[d0],0,0,0);
    o[d0]=__builtin_amdgcn_mfma_f32_32x32x16_bf16(pa1,PK(1),o[d0],0,0,0);
    o[d0]=__builtin_amdgcn_mfma_f32_32x32x16_bf16(pa2,PK(2),o[d0],0,0,0);
    o[d0]=__builtin_amdgcn_mfma_f32_32x32x16_bf16(pa3,PK(3),o[d0],0,0,0);
    #undef PK
  }
}

constexpr int LDS_KM=LDS_BYTES;
__device__ __forceinline__ void moba_kmean(int b,int h,int nmax,const bf16*__restrict__ K,char*shm,int tid){
  const int lane=tid&63,wid=__builtin_amdgcn_readfirstlane(tid>>6);
  float*km=(float*)(shm+LDS_KM); float*kmw=km+7*64;
  const bf16*Kh=K+(long)b*SEQ*DM+h*D;
  { const int kc=lane&7,kg=tid>>3;
    const bf16*kb=Kh+(long)(kg*4)*DM+kc*8;
    u32x4 kv[7][4];
    #pragma unroll
    for(int n=0;n<7;++n) if(n<nmax){
      #pragma unroll
      for(int kk=0;kk<4;++kk)kv[n][kk]=*(const u32x4*)(kb+(long)(n*256+kk)*DM); }
    #pragma unroll
    for(int n=0;n<7;++n) if(n<nmax){ float sa[8];
      #pragma unroll
      for(int e=0;e<8;++e)sa[e]=0.f;
      #pragma unroll
      for(int kk=0;kk<4;++kk)
        #pragma unroll
        for(int q=0;q<4;++q){sa[2*q]+=bf_lo(kv[n][kk][q]);sa[2*q+1]+=bf_hi(kv[n][kk][q]);}
      #pragma unroll
      for(int e=0;e<8;++e){sa[e]+=__shfl_xor(sa[e],8,64);sa[e]+=__shfl_xor(sa[e],16,64);sa[e]+=__shfl_xor(sa[e],32,64);}
      if(lane<8){float*dst=kmw+(n*8+wid)*64+kc*8;*(f32x4*)dst=(f32x4){sa[0],sa[1],sa[2],sa[3]};*(f32x4*)(dst+4)=(f32x4){sa[4],sa[5],sa[6],sa[7]};} } }
  __syncthreads();
  if(tid<nmax*64){const int n=tid>>6,d=tid&63;float sacc=0.f;
    #pragma unroll
    for(int ww=0;ww<8;++ww)sacc+=kmw[(n*8+ww)*64+d];
    km[n*64+d]=sacc*(1.0f/256.0f);}
  __syncthreads();
}
#ifndef ATTN_STORE16
#define ATTN_STORE16(p,v) (*(u32x4*)(p)=(v))
#endif
template<int THRL,int MODE> __device__ __forceinline__ void attn_unit(int b,int h,int qb,const bf16*Q,const bf16*__restrict__ K,const bf16*__restrict__ V,bf16*O,const unsigned*msk,char*shm,int tid){
  const int lane=tid&63,r32=lane&31,hi=lane>>5; const int wid=__builtin_amdgcn_readfirstlane(tid>>6);
  const long rowbase=(long)b*SEQ; const int q0=(MODE==2)?qb*32:qb*QB;
  const bf16*Qrow=(MODE==2)?Q+(rowbase+q0+wid*4+(r32>>3))*DM+(r32&7)*D:Q+(rowbase+q0+wid*QBLK+r32)*DM+h*D;
  const bf16*Kh=K+rowbase*DM+((MODE==2)?0:h*D),*Vh=V+rowbase*DM+((MODE==2)?0:h*D);
  const unsigned lds0=(unsigned)(uintptr_t)shm;
  float*wsf=(float*)(shm+LDS_WS)+wid*64;
  const bf16*ksrc=Kh+(long)lane*DM+wid*8;
  const bf16*vsrc=Vh+(long)(16*(wid&3)+(lane>>2))*DM+(wid>>2)*32+(lane&3)*8;
  const unsigned kdst=lds0+LDS_K+wid*1024, vdst=lds0+LDS_V+wid*1024;
  #define DMA_K(t,slot) glds16(ksrc+(long)(t)*KVBLK*DM,(unsigned)__builtin_amdgcn_readfirstlane(kdst+(slot)))
  #define DMA_V(t,slot) glds16(vsrc+(long)(t)*KVBLK*DM,(unsigned)__builtin_amdgcn_readfirstlane(vdst+(slot)))
  const int vb0=(int)(lds0+LDS_V)+((lane>>4)&1)*32+(lane&3)*8+(4*hi+((lane&15)>>2))*64;
  const char*Kbase=shm+LDS_K; bf16x8 kf[8];
  const lds_cptr shm3=(lds_cptr)shm; const lds_cptr kp0=shm3+LDS_K+hi*1024+r32*16; const lds_cptr vp0=shm3+LDS_V+((lane>>4)&1)*32+(lane&3)*8+(4*hi+((lane&15)>>2))*64;
  const int NTr=(MODE==2)?((q0+31)>>6)+1:(q0+QB)/KVBLK; const int NT=(MODE==2)?((NTr<4)?4:((NTr+1)&~1)):NTr;
  bf16x8 qr[4];
  #pragma unroll
  for(int d0=0;d0<4;++d0)qr[d0]=*reinterpret_cast<const bf16x8*>(&Qrow[d0*16+hi*8]);
  unsigned blkmask=0xffffffffu;
  if(MODE==2){
    const u32x4 mv=*(const u32x4*)(msk+(size_t)(rowbase+q0+(tid>>4))*64+(tid&15)*4);
    *(u32x4*)(shm+LDS_OST+tid*16)=mv;
    __syncthreads();
  }
  if(MODE==1){
    const int own=qb;
    const float*km=(const float*)(shm+LDS_KM);
    float gt[7];
    #pragma unroll
    for(int n=0;n<7;++n){float g=0.f;
      if(n<own){
        #pragma unroll
        for(int ks=0;ks<4;++ks)
          #pragma unroll
          for(int j=0;j<8;++j)g+=__uint_as_float((unsigned)(unsigned short)qr[ks][j]<<16)*km[n*64+ks*16+hi*8+j];
        g+=__shfl_xor(g,32,64);}
      gt[n]=g;}
    blkmask=1u<<own;
    #pragma unroll
    for(int n=0;n<7;++n){int rank=0;
      #pragma unroll
      for(int n2=0;n2<7;++n2)if(n2!=n)rank+=(n2<own&&(gt[n2]>gt[n]||(gt[n2]==gt[n]&&n2<n)))?1:0;
      if(n<own&&rank<3)blkmask|=1u<<n;}
  }
  DMA_K(0,0);DMA_V(0,0);DMA_K(1,SLOTB);
  float mhat=0.f,l_reg=0.f;f32x16 o[2];o[0]=f32x16{};o[1]=f32x16{};f32x16 negm=f32x16{};asm volatile("":"+v"(negm));
  const int qrel=wid*QBLK+r32;
  const unsigned*mrow=(const unsigned*)(shm+LDS_OST)+(wid*4+(r32>>3))*64;
  #define BMASK(P0,P1,t) do{ const u32x2 mw_=*(const u32x2*)(mrow+2*(t)); const unsigned w0_=mw_[0]>>(4*hi),w1_=mw_[1]>>(4*hi); \
      _Pragma("unroll") for(int r_=0;r_<16;++r_){ const int bit_=(r_&3)+8*(r_>>2); P0[r_]=((w0_>>bit_)&1u)?P0[r_]:-INFINITY; P1[r_]=((w1_>>bit_)&1u)?P1[r_]:-INFINITY; } }while(0)
  #define GMASK(P0,P1,t) do{ if(MODE==2){BMASK(P0,P1,t);} else if(!((blkmask>>((t)>>2))&1u)){ _Pragma("unroll") for(int r_=0;r_<16;++r_){P0[r_]=-INFINITY;P1[r_]=-INFINITY;} } }while(0)
  #define CMASK(P0,P1,t) do{int jb_=(t)-(NT-4); if(MODE==1&&jb_>=0)cmask(P0,P1,jb_,qrel,hi); GMASK(P0,P1,t);}while(0)
  bool resc=false;
  #define START(P0,P1) do{ const float rm=rowmax(P0,P1); resc=false; \
    { const float dl=(rm==-INFINITY)?0.f:rm; mhat=fadd_s(mhat,dl); \
      _Pragma("unroll") for(int r=0;r<16;++r){P0[r]=fsub_s(P0[r],dl);P1[r]=fsub_s(P1[r],dl);} \
      _Pragma("unroll") for(int r=0;r<16;++r)negm[r]=-mhat; asm volatile("":"+v"(negm)); } \
    _Pragma("unroll") for(int r=0;r<16;++r)P0[r]=__builtin_amdgcn_exp2f(P0[r]); }while(0)
  #define RESC() do{ if(resc){ asm volatile("s_waitcnt lgkmcnt(0)":::"memory"); \
      _Pragma("unroll") for(int d_=0;d_<2;++d_) _Pragma("unroll") for(int r=0;r<16;++r)o[d_][r]*=wsf[crow(r,hi)]; } }while(0)
  f32x16 pA0,pA1,pB0,pB1;
  int sl_prev=0,sl_cur=0,sl_next=SLOTB;
  #define ROT() do{sl_prev=sl_cur;sl_cur=sl_next;sl_next=(sl_next==(NSLOT-1)*SLOTB)?0:sl_next+SLOTB;}while(0)
  DMA_K(2,2*SLOTB);
  WAIT_BAR(3);
  qkt(pA0,pA1,Kbase,qr,negm,r32,hi);asm volatile("s_nop 15\n\ts_nop 7":"+v"(pA0),"+v"(pA1));CMASK(pA0,pA1,0);
  START(pA0,pA1);
  _Pragma("unroll") for(int r=0;r<16;++r)pA1[r]=__builtin_amdgcn_exp2f(pA1[r]);
  WAIT_BAR(0);
  DMA_K(3,0);DMA_V(1,SLOTB);
  ROT();
  kload8(kf,kp0+sl_cur);
  WAIT_BAR(2);
  s16x4 vlo[8],vhi[8]; u32x4 pw0,pw1,pw2,pw3;
  #define PKW(P,B) cvtpk_s(P[B],P[B+1])
  #define PAF(k) __builtin_bit_cast(bf16x8,pw##k)
  #define VFR(i) (bf16x8){vlo[i][0],vlo[i][1],vlo[i][2],vlo[i][3],vhi[i][0],vhi[i][1],vhi[i][2],vhi[i][3]}
  #define PIN(x) asm volatile("":"+v"(x))
  #define MX3(a,b,c) __builtin_fmaxf(__builtin_fmaxf((a),(b)),(c))
  #define GAPA(MF,A0,A1,A2,A3,W0,W1,PW) do{ MF; sacc+=A0; sacc+=A1; sacc+=A2; sacc+=A3; PIN(sacc); W0; W1; PIN(PW); SBAR(); }while(0)
  #define EX(v) __builtin_amdgcn_exp2f(v)
  #define GAPB(MF,X,B) do{ MF; X[B]=EX(X[B]); X[B+1]=EX(X[B+1]); X[B+2]=EX(X[B+2]); X[B+3]=EX(X[B+3]); PIN(X); SBAR(); }while(0)
  #define VRD(i) do{ vlo[i]=vtr(vp_+(((i)>>2)*4096+((i)&3)*1024)); vhi[i]=vtr(vp_+(((i)>>2)*4096+((i)&3)*1024+512)); }while(0)
  #define KRD(G,j) do{ if(G){ kload2(kf,kp0+sl_next,j); SBAR(); } }while(0)
  #define STEP(C0,C1,P0,P1,t,GK,GV,GL) do{ SBAR(); \
    const lds_cptr vp_=vp0+sl_prev; \
    VRD(0); SBAR(); float sacc=(P0[0]+P0[1]); \
    GAPA(C0=__builtin_amdgcn_mfma_f32_32x32x16_bf16(kf[0],qr[0],negm,0,0,0), P0[2],P0[3],P0[4],P0[5],     pw0[0]=PKW(P0,0), pw0[1]=PKW(P0,2), pw0); \
    VRD(4); SBAR(); GAPA(C1=__builtin_amdgcn_mfma_f32_32x32x16_bf16(kf[1],qr[0],negm,0,0,0), P0[6],P0[7],P0[8],P0[9],     pw0[2]=PKW(P0,4), pw0[3]=PKW(P0,6), pw0); \
    VRD(1); SBAR(); GAPA(C0=__builtin_amdgcn_mfma_f32_32x32x16_bf16(kf[2],qr[1],C0,0,0,0),   P0[10],P0[11],P0[12],P0[13], pw1[0]=PKW(P0,8), pw1[1]=PKW(P0,10), pw1); \
    VRD(5); SBAR(); GAPA(C1=__builtin_amdgcn_mfma_f32_32x32x16_bf16(kf[3],qr[1],C1,0,0,0),   P0[14],P0[15],P1[0],P1[1],   pw1[2]=PKW(P0,12),pw1[3]=PKW(P0,14), pw1); \
    VRD(2); SBAR(); GAPA(C0=__builtin_amdgcn_mfma_f32_32x32x16_bf16(kf[4],qr[2],C0,0,0,0),   P1[2],P1[3],P1[4],P1[5],     pw2[0]=PKW(P1,0), pw2[1]=PKW(P1,2), pw2); \
    VRD(6); SBAR(); GAPA(C1=__builtin_amdgcn_mfma_f32_32x32x16_bf16(kf[5],qr[2],C1,0,0,0),   P1[6],P1[7],P1[8],P1[9],     pw2[2]=PKW(P1,4), pw2[3]=PKW(P1,6), pw2); \
    VRD(3); SBAR(); GAPA(C0=__builtin_amdgcn_mfma_f32_32x32x16_bf16(kf[6],qr[3],C0,0,0,0),   P1[10],P1[11],P1[12],P1[13], pw3[0]=PKW(P1,8), pw3[1]=PKW(P1,10), pw3); \
    VRD(7); SBAR(); GAPA(C1=__builtin_amdgcn_mfma_f32_32x32x16_bf16(kf[7],qr[3],C1,0,0,0),   P1[14],P1[15],0.f,0.f,       pw3[2]=PKW(P1,12),pw3[3]=PKW(P1,14), pw3); \
    l_reg+=sacc; \
    if(GK){DMA_K((t)+3,sl_cur);} if(GV){DMA_V((t)+1,sl_next);} \
    CMASK(C0,C1,t); \
    { float a=MX3(C0[0],C0[1],C1[0]),b=MX3(C0[2],C0[3],C1[1]); a=MX3(a,C1[2],C1[3]); \
      _Pragma("unroll") for(int r=4;r<16;r+=4){a=MX3(a,C0[r],C0[r+1]);b=MX3(b,C0[r+2],C0[r+3]);a=MX3(a,C1[r],C1[r+1]);b=MX3(b,C1[r+2],C1[r+3]);} \
      float rm=__builtin_fmaxf(a,b); { auto rr=__builtin_amdgcn_permlane32_swap(__float_as_uint(rm),__float_as_uint(rm),false,false); rm=__builtin_fmaxf(__uint_as_float(rr[0]),__uint_as_float(rr[1])); } \
      resc=false; \
      if(__builtin_expect(__any(rm>(float)THRL),0)){ const float dl=__builtin_fmaxf(rm,0.f); mhat+=dl; \
        _Pragma("unroll") for(int r=0;r<16;++r){C0[r]-=dl;C1[r]-=dl;} \
        _Pragma("unroll") for(int r=0;r<16;++r)negm[r]=-mhat; asm volatile("":"+v"(negm)); \
        const float f=__builtin_amdgcn_exp2f(-dl); l_reg*=f; if(hi==0)wsf[r32]=f; resc=true; } } \
    SBAR(); \
    GAPB(o[0]=__builtin_amdgcn_mfma_f32_32x32x16_bf16(PAF(0),VFR(0),o[0],0,0,0), C0,0); \
    GAPB(o[1]=__builtin_amdgcn_mfma_f32_32x32x16_bf16(PAF(0),VFR(4),o[1],0,0,0), C0,4); \
    KRD(GL,0); GAPB(o[0]=__builtin_amdgcn_mfma_f32_32x32x16_bf16(PAF(1),VFR(1),o[0],0,0,0), C0,8); \
    KRD(GL,1); GAPB(o[1]=__builtin_amdgcn_mfma_f32_32x32x16_bf16(PAF(1),VFR(5),o[1],0,0,0), C0,12); \
    KRD(GL,2); GAPB(o[0]=__builtin_amdgcn_mfma_f32_32x32x16_bf16(PAF(2),VFR(2),o[0],0,0,0), C1,0); \
    KRD(GL,3); GAPB(o[1]=__builtin_amdgcn_mfma_f32_32x32x16_bf16(PAF(2),VFR(6),o[1],0,0,0), C1,4); \
    GAPB(o[0]=__builtin_amdgcn_mfma_f32_32x32x16_bf16(PAF(3),VFR(3),o[0],0,0,0), C1,8); \
    GAPB(o[1]=__builtin_amdgcn_mfma_f32_32x32x16_bf16(PAF(3),VFR(7),o[1],0,0,0), C1,12); \
    }while(0)
  int t=1;
  #undef CMASK
  #define CMASK(P0,P1,t) GMASK(P0,P1,t)
  for(;t+5<NT;t+=2){
    STEP(pB0,pB1,pA0,pA1,t,true,true,true);     WAIT_BAR(2); RESC(); ROT();
    STEP(pA0,pA1,pB0,pB1,t+1,true,true,true);   WAIT_BAR(2); RESC(); ROT();
  }
  #undef CMASK
  #define CMASK(P0,P1,t) do{int jb_=(t)-(NT-4); if(MODE==1&&jb_>=0)cmask(P0,P1,jb_,qrel,hi); GMASK(P0,P1,t);}while(0)
  #define ENDW(tt) do{ if((tt)+3<NT){WAIT_BAR(2);} else if((tt)+2<NT){WAIT_BAR(1);} else {WAIT_BAR(0);} }while(0)
  for(;t+1<NT;t+=2){
    STEP(pB0,pB1,pA0,pA1,t,(t+3<NT),(t+1<NT),(t+1<NT));       ENDW(t);   RESC(); ROT();
    STEP(pA0,pA1,pB0,pB1,t+1,(t+4<NT),(t+2<NT),(t+2<NT));     ENDW(t+1); RESC(); ROT();
  }
  STEP(pB0,pB1,pA0,pA1,NT-1,false,false,false); RESC();
  { float sacc=pB0[0]+pB0[1]; _Pragma("unroll") for(int r=2;r<16;++r)sacc+=pB0[r]; _Pragma("unroll") for(int r=0;r<16;++r)sacc+=pB1[r]; l_reg+=sacc;
    pw0=(u32x4){PKW(pB0,0),PKW(pB0,2),PKW(pB0,4),PKW(pB0,6)};pw1=(u32x4){PKW(pB0,8),PKW(pB0,10),PKW(pB0,12),PKW(pB0,14)};pw2=(u32x4){PKW(pB1,0),PKW(pB1,2),PKW(pB1,4),PKW(pB1,6)};pw3=(u32x4){PKW(pB1,8),PKW(pB1,10),PKW(pB1,12),PKW(pB1,14)};
    SBAR(); pv(o,vb0+sl_cur,PAF(0),PAF(1),PAF(2),PAF(3)); }
  #undef PKW
  #undef PAF
  #undef VFR
  #undef PIN
  #undef MX3
  #undef GAPA
  #undef GAPB
  #undef EX
  #undef VRD
  #undef KRD
  #undef STEP
  #undef ENDW
  {auto rr=__builtin_amdgcn_permlane32_swap(__float_as_uint(l_reg),__float_as_uint(l_reg),false,false);l_reg=__uint_as_float(rr[0])+__uint_as_float(rr[1]);}
  if(hi==0)wsf[32+r32]=l_reg;asm volatile("s_waitcnt lgkmcnt(0)":::"memory");
  float rli[16];
  #pragma unroll
  for(int r=0;r<16;++r)rli[r]=__builtin_amdgcn_rcpf(wsf[32+crow(r,hi)]);
  if(MODE==2){ asm volatile("s_waitcnt lgkmcnt(0)\n\ts_barrier":::"memory"); }
  { bf16*stg=(bf16*)(shm+LDS_OST)+wid*2048;
    #pragma unroll
    for(int r=0;r<16;++r){const int orow=crow(r,hi);
      #pragma unroll
      for(int d0=0;d0<2;++d0)stg[orow*64+d0*32+r32]=f2bf(o[d0][r]*rli[r]);}
    asm volatile("s_waitcnt lgkmcnt(0)":::"memory");
    #pragma unroll
    for(int i=0;i<4;++i){const int row=i*8+(lane>>3),ch=lane&7; const u32x4 v=*(const u32x4*)(stg+row*64+ch*8);
      bf16*op=(MODE==2)?O+(rowbase+q0+wid*4+(row>>3))*OM+(row&7)*D+ch*8:O+(rowbase+q0+wid*QBLK+row)*OM+h*D+ch*8; ATTN_STORE16(op,v);} }
  asm volatile("s_waitcnt lgkmcnt(0)\n\ts_barrier":::"memory");
  #undef DMA_K
  #undef DMA_V
  #undef CMASK
  #undef GMASK
  #undef BMASK
  #undef START
  #undef RESC
  #undef ROT
}
constexpr int ATTN_LDS_BYTES=LDS_BYTES;
#undef SBAR
#undef WAIT_BAR
}

namespace am {
typedef bf16_t bf16;
constexpr int SEQ=S_,D=64;
constexpr int NW=8,QBLK=32,QB=QBLK*NW,KVBLK=64;
__device__ __forceinline__ int crow(int r,int hi){return (r&3)+8*(r>>2)+4*hi;}
#define SBAR() __builtin_amdgcn_sched_barrier(0)
__device__ __forceinline__ void cmask(f32x16&p0,f32x16&p1,int jb,int qrel,int hi){
  const float NEG=-INFINITY; int kb=64*jb+4*hi;
  #pragma unroll
  for(int r=0;r<16;++r){int kv=kb+(r&3)+8*(r>>2); if(kv>qrel)p0[r]=NEG; if(kv+32>qrel)p1[r]=NEG;}
}

constexpr int NSLOT=3, SLOTB=12288;
constexpr int LDS_K=0, LDS_V=NSLOT*SLOTB, LDS_WS=2*NSLOT*SLOTB, LDS_OST=LDS_WS+NW*64*4, LDS_DUMP=LDS_OST+NW*4096, LDS_BYTES=LDS_DUMP+4096;
constexpr float C2=0.10206207261596575f*1.4426950408889634f;
__device__ __forceinline__ void glds16(const void*gsrc,unsigned lds_dst){unsigned keep;
  asm volatile("s_mov_b32 %0, m0\n\ts_mov_b32 m0, %2\n\ts_nop 0\n\tglobal_load_lds_dwordx4 %1, off\n\ts_mov_b32 m0, %0":"=&s"(keep):"v"(gsrc),"s"(lds_dst):"memory");}
__device__ __forceinline__ float max3f(float a,float b,float c){float r;asm("v_max3_f32 %0, %1, %2, %3":"=v"(r):"v"(a),"v"(b),"v"(c));return r;}
__device__ __forceinline__ float max2f(float a,float b){float r;asm("v_max_f32_e32 %0, %1, %2":"=v"(r):"v"(a),"v"(b));return r;}
__device__ __forceinline__ float fadd_s(float a,float b){float r;asm("v_add_f32_e32 %0, %1, %2":"=v"(r):"v"(a),"v"(b));return r;}
__device__ __forceinline__ float fsub_s(float a,float b){float r;asm("v_sub_f32_e32 %0, %1, %2":"=v"(r):"v"(a),"v"(b));return r;}
typedef float f32x2_t __attribute__((ext_vector_type(2))); typedef __bf16 bf16x2_t __attribute__((ext_vector_type(2)));
__device__ __forceinline__ unsigned cvtpk_s(float lo,float hi){f32x2_t v={lo,hi};bf16x2_t b=__builtin_convertvector(v,bf16x2_t);return __builtin_bit_cast(unsigned,b);}
#define WAIT_BAR(N) asm volatile("s_waitcnt vmcnt(" #N ") lgkmcnt(0)\n\ts_barrier":::"memory")

__device__ __forceinline__ void qkt(f32x16&p0,f32x16&p1,const char*Kslot,const bf16x8*qr,const f32x16&negm,int r32,int hi){
  const char*kb=Kslot+hi*1024+r32*16;
  #pragma unroll
  for(int d0=0;d0<6;++d0){
    const bf16x8 b0=*reinterpret_cast<const bf16x8*>(kb+d0*2048);
    const bf16x8 b1=*reinterpret_cast<const bf16x8*>(kb+d0*2048+512);
    if(d0==0){p0=__builtin_amdgcn_mfma_f32_32x32x16_bf16(b0,qr[0],negm,0,0,0);p1=__builtin_amdgcn_mfma_f32_32x32x16_bf16(b1,qr[0],negm,0,0,0);}
    else{p0=__builtin_amdgcn_mfma_f32_32x32x16_bf16(b0,qr[d0],p0,0,0,0);p1=__builtin_amdgcn_mfma_f32_32x32x16_bf16(b1,qr[d0],p1,0,0,0);}}
}
typedef __attribute__((address_space(3))) const char* lds_cptr;
typedef short v4i16_t __attribute__((ext_vector_type(4)));
__device__ __forceinline__ void kload8(bf16x8*kf,lds_cptr kp){
  kf[0]=*(const __attribute__((address_space(3))) bf16x8*)(kp);      kf[1]=*(const __attribute__((address_space(3))) bf16x8*)(kp+512);
  kf[2]=*(const __attribute__((address_space(3))) bf16x8*)(kp+2048); kf[3]=*(const __attribute__((address_space(3))) bf16x8*)(kp+2560);
  kf[4]=*(const __attribute__((address_space(3))) bf16x8*)(kp+4096); kf[5]=*(const __attribute__((address_space(3))) bf16x8*)(kp+4608);
  kf[6]=*(const __attribute__((address_space(3))) bf16x8*)(kp+6144); kf[7]=*(const __attribute__((address_space(3))) bf16x8*)(kp+6656);
  kf[8]=*(const __attribute__((address_space(3))) bf16x8*)(kp+8192); kf[9]=*(const __attribute__((address_space(3))) bf16x8*)(kp+8704);
  kf[10]=*(const __attribute__((address_space(3))) bf16x8*)(kp+10240); kf[11]=*(const __attribute__((address_space(3))) bf16x8*)(kp+10752);
}
__device__ __forceinline__ void kload2(bf16x8*kf,lds_cptr kp,int j){ kf[2*j]=*(const __attribute__((address_space(3))) bf16x8*)(kp+j*2048); kf[2*j+1]=*(const __attribute__((address_space(3))) bf16x8*)(kp+j*2048+512); }
__device__ __forceinline__ s16x4 vtr(lds_cptr p){ return __builtin_bit_cast(s16x4,__builtin_amdgcn_ds_read_tr16_b64_v4i16((__attribute__((address_space(3))) v4i16_t*)p)); }
__device__ __forceinline__ float rowmax(const f32x16&p0,const f32x16&p1){
  float a=max3f(p0[0],p0[1],p1[0]),b=max3f(p0[2],p0[3],p1[1]);a=max3f(a,p1[2],p1[3]);
  #pragma unroll
  for(int r=4;r<16;r+=4){a=max3f(a,p0[r],p0[r+1]);b=max3f(b,p0[r+2],p0[r+3]);a=max3f(a,p1[r],p1[r+1]);b=max3f(b,p1[r+2],p1[r+3]);}
  const float m=max2f(a,b);
  auto rr=__builtin_amdgcn_permlane32_swap(__float_as_uint(m),__float_as_uint(m),false,false);
  return max2f(__uint_as_float(rr[0]),__uint_as_float(rr[1]));
}
__device__ __forceinline__ void pv(f32x16*o,int vb,bf16x8 pa0,bf16x8 pa1,bf16x8 pa2,bf16x8 pa3){
  #pragma unroll
  for(int d0=0;d0<2;++d0){s16x4 lo[4],hi[4];
    #pragma unroll
    for(int ks=0;ks<4;++ks){
      asm volatile("ds_read_b64_tr_b16 %0,%1 offset:%c2":"=&v"(lo[ks]):"v"(vb),"i"(d0*4096+ks*1024):"memory");
      asm volatile("ds_read_b64_tr_b16 %0,%1 offset:%c2":"=&v"(hi[ks]):"v"(vb),"i"(d0*4096+ks*1024+512):"memory");}
    asm volatile("s_waitcnt lgkmcnt(0)":::"memory");SBAR();
    #define PK(k) (bf16x8){lo[k][0],lo[k][1],lo[k][2],lo[k][3],hi[k][0],hi[k][1],hi[k][2],hi[k][3]}
    o[d0]=__builtin_amdgcn_mfma_f32_32x32x16_bf16(pa0,PK(0),o[d0],0,0,0);
    o[d0]=__builtin_amdgcn_mfma_f32_32x32x16_bf16(pa1,PK(1),o[d0],0,0,0);
    o[d0]=__builtin_amdgcn_mfma_f32_32x32x16_bf16(pa2,PK(2),o[d0],0,0,0);
    o[d0]=__builtin_amdgcn_mfma_f32_32x32x16_bf16(pa3,PK(3),o[d0],0,0,0);
    #undef PK
  }
}

#ifndef ATTN_STORE16
#define ATTN_STORE16(p,v) (*(u32x4*)(p)=(v))
#endif
template<int THRL> __device__ __forceinline__ void attn_unit(int b,int h,int qb,const bf16*Q,const bf16*__restrict__ KN,const bf16*__restrict__ KR,const bf16*__restrict__ V,bf16*O,char*shm,int tid){
  const int lane=tid&63,r32=lane&31,hi=lane>>5; const int wid=__builtin_amdgcn_readfirstlane(tid>>6);
  const long rowbase=(long)b*SEQ; const int q0=qb*QB;
  const bf16*Qrow=Q+(rowbase+q0+wid*QBLK+r32)*1536+h*96;
  const unsigned lds0=(unsigned)(uintptr_t)shm;
  float*wsf=(float*)(shm+LDS_WS)+wid*64;
  const bf16*ksrcA=KN+(rowbase+lane)*1024+h*64+wid*8;
  const long dKR=KR-KN;
  const bf16*ksrcB=KN+((wid<4)?dKR+(rowbase+lane)*1280+1024+wid*8:(rowbase+lane)*1024+h*64+wid*8);
  const long kstepB=(wid<4)?(long)KVBLK*1280:(long)KVBLK*1024;
  const bf16*vsrc=V+(rowbase+16*(wid&3)+(lane>>2))*1024+h*64+(wid>>2)*32+(lane&3)*8;
  const unsigned kdstA=lds0+LDS_K+wid*1024, kdstB=(wid<4)?lds0+LDS_K+(8+wid)*1024:lds0+LDS_DUMP+(wid-4)*1024, vdst=lds0+LDS_V+wid*1024;
  #define DMA_K(t,slot) do{ glds16(ksrcA+(long)(t)*KVBLK*1024,(unsigned)__builtin_amdgcn_readfirstlane(kdstA+(slot))); \
      glds16(ksrcB+(long)(t)*kstepB,(unsigned)__builtin_amdgcn_readfirstlane((wid<4)?kdstB+(slot):kdstB)); }while(0)
  #define DMA_V(t,slot) glds16(vsrc+(long)(t)*KVBLK*1024,(unsigned)__builtin_amdgcn_readfirstlane(vdst+(slot)))
  const int vb0=(int)(lds0+LDS_V)+((lane>>4)&1)*32+(lane&3)*8+(4*hi+((lane&15)>>2))*64;
  const char*Kbase=shm+LDS_K; bf16x8 kf[12];
  const lds_cptr shm3=(lds_cptr)shm; const lds_cptr kp0=shm3+LDS_K+hi*1024+r32*16; const lds_cptr vp0=shm3+LDS_V+((lane>>4)&1)*32+(lane&3)*8+(4*hi+((lane&15)>>2))*64;
  const int NT=(q0+QB)/KVBLK;
  DMA_K(0,0);DMA_V(0,0);DMA_K(1,SLOTB);
  bf16x8 qr[6];
  #pragma unroll
  for(int d0=0;d0<6;++d0)qr[d0]=*reinterpret_cast<const bf16x8*>(&Qrow[d0*16+hi*8]);
  float mhat=0.f,l_reg=0.f;f32x16 o[2];o[0]=f32x16{};o[1]=f32x16{};f32x16 negm=f32x16{};asm volatile("":"+v"(negm));
  const int qrel=wid*QBLK+r32;
  #define CMASK(P0,P1,t) do{int jb_=(t)-(NT-4); if(jb_>=0)cmask(P0,P1,jb_,qrel,hi);}while(0)
  bool resc=false;
  #define START(P0,P1) do{ const float rm=rowmax(P0,P1); resc=false; \
    { const float dl=rm; mhat=fadd_s(mhat,dl); \
      _Pragma("unroll") for(int r=0;r<16;++r){P0[r]=fsub_s(P0[r],dl);P1[r]=fsub_s(P1[r],dl);} \
      _Pragma("unroll") for(int r=0;r<16;++r)negm[r]=-mhat; asm volatile("":"+v"(negm)); } \
    _Pragma("unroll") for(int r=0;r<16;++r)P0[r]=__builtin_amdgcn_exp2f(P0[r]); }while(0)
  #define RESC() do{ if(resc){ asm volatile("s_waitcnt lgkmcnt(0)":::"memory"); \
      _Pragma("unroll") for(int d_=0;d_<2;++d_) _Pragma("unroll") for(int r=0;r<16;++r)o[d_][r]*=wsf[crow(r,hi)]; } }while(0)
  f32x16 pA0,pA1,pB0,pB1;
  int sl_prev=0,sl_cur=0,sl_next=SLOTB;
  #define ROT() do{sl_prev=sl_cur;sl_cur=sl_next;sl_next=(sl_next==(NSLOT-1)*SLOTB)?0:sl_next+SLOTB;}while(0)
  DMA_K(2,2*SLOTB);
  WAIT_BAR(5);
  qkt(pA0,pA1,Kbase,qr,negm,r32,hi);asm volatile("s_nop 15\n\ts_nop 7":"+v"(pA0),"+v"(pA1));CMASK(pA0,pA1,0);
  START(pA0,pA1);
  _Pragma("unroll") for(int r=0;r<16;++r)pA1[r]=__builtin_amdgcn_exp2f(pA1[r]);
  WAIT_BAR(0);
  DMA_K(3,0);DMA_V(1,SLOTB);
  ROT();
  kload8(kf,kp0+sl_cur);
  WAIT_BAR(3);
  s16x4 vlo[8],vhi[8]; u32x4 pw0,pw1,pw2,pw3;
  #define PKW(P,B) cvtpk_s(P[B],P[B+1])
  #define PAF(k) __builtin_bit_cast(bf16x8,pw##k)
  #define VFR(i) (bf16x8){vlo[i][0],vlo[i][1],vlo[i][2],vlo[i][3],vhi[i][0],vhi[i][1],vhi[i][2],vhi[i][3]}
  #define PIN(x) asm volatile("":"+v"(x))
  #define MX3(a,b,c) __builtin_fmaxf(__builtin_fmaxf((a),(b)),(c))
  #define GAPA(MF,A0,A1,A2,A3,W0,W1,PW) do{ MF; sacc+=A0; sacc+=A1; sacc+=A2; sacc+=A3; PIN(sacc); W0; W1; PIN(PW); SBAR(); }while(0)
  #define EX(v) __builtin_amdgcn_exp2f(v)
  #define GAPB(MF,X,B) do{ MF; X[B]=EX(X[B]); X[B+1]=EX(X[B+1]); X[B+2]=EX(X[B+2]); X[B+3]=EX(X[B+3]); PIN(X); SBAR(); }while(0)
  #define VRD(i) do{ vlo[i]=vtr(vp_+(((i)>>2)*4096+((i)&3)*1024)); vhi[i]=vtr(vp_+(((i)>>2)*4096+((i)&3)*1024+512)); }while(0)
  #define KRD(G,j) do{ if(G){ kload2(kf,kp0+sl_next,j); SBAR(); } }while(0)
  #define STEP(C0,C1,P0,P1,t,GK,GV,GL) do{ SBAR(); \
    const lds_cptr vp_=vp0+sl_prev; \
    VRD(0); SBAR(); float sacc=(P0[0]+P0[1]); \
    GAPA(C0=__builtin_amdgcn_mfma_f32_32x32x16_bf16(kf[0],qr[0],negm,0,0,0), P0[2],P0[3],P0[4],P0[5],     pw0[0]=PKW(P0,0), pw0[1]=PKW(P0,2), pw0); \
    VRD(4); SBAR(); GAPA(C1=__builtin_amdgcn_mfma_f32_32x32x16_bf16(kf[1],qr[0],negm,0,0,0), P0[6],P0[7],P0[8],P0[9],     pw0[2]=PKW(P0,4), pw0[3]=PKW(P0,6), pw0); \
    VRD(1); SBAR(); GAPA(C0=__builtin_amdgcn_mfma_f32_32x32x16_bf16(kf[2],qr[1],C0,0,0,0),   P0[10],P0[11],P0[12],P0[13], pw1[0]=PKW(P0,8), pw1[1]=PKW(P0,10), pw1); \
    VRD(5); SBAR(); GAPA(C1=__builtin_amdgcn_mfma_f32_32x32x16_bf16(kf[3],qr[1],C1,0,0,0),   P0[14],P0[15],P1[0],P1[1],   pw1[2]=PKW(P0,12),pw1[3]=PKW(P0,14), pw1); \
    VRD(2); SBAR(); GAPA(C0=__builtin_amdgcn_mfma_f32_32x32x16_bf16(kf[4],qr[2],C0,0,0,0),   P1[2],P1[3],P1[4],P1[5],     pw2[0]=PKW(P1,0), pw2[1]=PKW(P1,2), pw2); \
    VRD(6); SBAR(); GAPA(C1=__builtin_amdgcn_mfma_f32_32x32x16_bf16(kf[5],qr[2],C1,0,0,0),   P1[6],P1[7],P1[8],P1[9],     pw2[2]=PKW(P1,4), pw2[3]=PKW(P1,6), pw2); \
    VRD(3); SBAR(); GAPA(C0=__builtin_amdgcn_mfma_f32_32x32x16_bf16(kf[6],qr[3],C0,0,0,0),   P1[10],P1[11],P1[12],P1[13], pw3[0]=PKW(P1,8), pw3[1]=PKW(P1,10), pw3); \
    VRD(7); SBAR(); GAPA(C1=__builtin_amdgcn_mfma_f32_32x32x16_bf16(kf[7],qr[3],C1,0,0,0),   P1[14],P1[15],0.f,0.f,       pw3[2]=PKW(P1,12),pw3[3]=PKW(P1,14), pw3); \
    C0=__builtin_amdgcn_mfma_f32_32x32x16_bf16(kf[8],qr[4],C0,0,0,0); C1=__builtin_amdgcn_mfma_f32_32x32x16_bf16(kf[9],qr[4],C1,0,0,0); SBAR(); \
    C0=__builtin_amdgcn_mfma_f32_32x32x16_bf16(kf[10],qr[5],C0,0,0,0); C1=__builtin_amdgcn_mfma_f32_32x32x16_bf16(kf[11],qr[5],C1,0,0,0); SBAR(); \
    l_reg+=sacc; \
    if(GK){DMA_K((t)+3,sl_cur);} if(GV){DMA_V((t)+1,sl_next);} \
    CMASK(C0,C1,t); \
    { float a=MX3(C0[0],C0[1],C1[0]),b=MX3(C0[2],C0[3],C1[1]); a=MX3(a,C1[2],C1[3]); \
      _Pragma("unroll") for(int r=4;r<16;r+=4){a=MX3(a,C0[r],C0[r+1]);b=MX3(b,C0[r+2],C0[r+3]);a=MX3(a,C1[r],C1[r+1]);b=MX3(b,C1[r+2],C1[r+3]);} \
      float rm=__builtin_fmaxf(a,b); { auto rr=__builtin_amdgcn_permlane32_swap(__float_as_uint(rm),__float_as_uint(rm),false,false); rm=__builtin_fmaxf(__uint_as_float(rr[0]),__uint_as_float(rr[1])); } \
      resc=false; \
      if(__builtin_expect(__any(rm>(float)THRL),0)){ const float dl=__builtin_fmaxf(rm,0.f); mhat+=dl; \
        _Pragma("unroll") for(int r=0;r<16;++r){C0[r]-=dl;C1[r]-=dl;} \
        _Pragma("unroll") for(int r=0;r<16;++r)negm[r]=-mhat; asm volatile("":"+v"(negm)); \
        const float f=__builtin_amdgcn_exp2f(-dl); l_reg*=f; if(hi==0)wsf[r32]=f; resc=true; } } \
    SBAR(); \
    GAPB(o[0]=__builtin_amdgcn_mfma_f32_32x32x16_bf16(PAF(0),VFR(0),o[0],0,0,0), C0,0); \
    GAPB(o[1]=__builtin_amdgcn_mfma_f32_32x32x16_bf16(PAF(0),VFR(4),o[1],0,0,0), C0,4); \
    KRD(GL,0); GAPB(o[0]=__builtin_amdgcn_mfma_f32_32x32x16_bf16(PAF(1),VFR(1),o[0],0,0,0), C0,8); \
    KRD(GL,1); GAPB(o[1]=__builtin_amdgcn_mfma_f32_32x32x16_bf16(PAF(1),VFR(5),o[1],0,0,0), C0,12); \
    KRD(GL,2); GAPB(o[0]=__builtin_amdgcn_mfma_f32_32x32x16_bf16(PAF(2),VFR(2),o[0],0,0,0), C1,0); \
    KRD(GL,3); GAPB(o[1]=__builtin_amdgcn_mfma_f32_32x32x16_bf16(PAF(2),VFR(6),o[1],0,0,0), C1,4); \
    KRD(GL,4); GAPB(o[0]=__builtin_amdgcn_mfma_f32_32x32x16_bf16(PAF(3),VFR(3),o[0],0,0,0), C1,8); \
    KRD(GL,5); GAPB(o[1]=__builtin_amdgcn_mfma_f32_32x32x16_bf16(PAF(3),VFR(7),o[1],0,0,0), C1,12); \
    }while(0)
  int t=1;
  #undef CMASK
  #define CMASK(P0,P1,t) do{}while(0)
  for(;t+5<NT;t+=2){
    STEP(pB0,pB1,pA0,pA1,t,true,true,true);     WAIT_BAR(3); RESC(); ROT();
    STEP(pA0,pA1,pB0,pB1,t+1,true,true,true);   WAIT_BAR(3); RESC(); ROT();
  }
  #undef CMASK
  #define CMASK(P0,P1,t) do{int jb_=(t)-(NT-4); if(jb_>=0)cmask(P0,P1,jb_,qrel,hi);}while(0)
  #define ENDW(tt) do{ if((tt)+3<NT){WAIT_BAR(3);} else if((tt)+2<NT){WAIT_BAR(1);} else {WAIT_BAR(0);} }while(0)
  for(;t+1<NT;t+=2){
    STEP(pB0,pB1,pA0,pA1,t,(t+3<NT),(t+1<NT),(t+1<NT));       ENDW(t);   RESC(); ROT();
    STEP(pA0,pA1,pB0,pB1,t+1,(t+4<NT),(t+2<NT),(t+2<NT));     ENDW(t+1); RESC(); ROT();
  }
  STEP(pB0,pB1,pA0,pA1,NT-1,false,false,false); RESC();
  { float sacc=pB0[0]+pB0[1]; _Pragma("unroll") for(int r=2;r<16;++r)sacc+=pB0[r]; _Pragma("unroll") for(int r=0;r<16;++r)sacc+=pB1[r]; l_reg+=sacc;
    pw0=(u32x4){PKW(pB0,0),PKW(pB0,2),PKW(pB0,4),PKW(pB0,6)};pw1=(u32x4){PKW(pB0,8),PKW(pB0,10),PKW(pB0,12),PKW(pB0,14)};pw2=(u32x4){PKW(pB1,0),PKW(pB1,2),PKW(pB1,4),PKW(pB1,6)};pw3=(u32x4){PKW(pB1,8),PKW(pB1,10),PKW(pB1,12),PKW(pB1,14)};
    SBAR(); pv(o,vb0+sl_cur,PAF(0),PAF(1),PAF(2),PAF(3)); }
  #undef PKW
  #undef PAF
  #undef VFR
  #undef PIN
  #undef MX3
  #undef GAPA
  #undef GAPB
  #undef EX
  #undef VRD
  #undef KRD
  #undef STEP
  #undef ENDW
  {auto rr=__builtin_amdgcn_permlane32_swap(__float_as_uint(l_reg),__float_as_uint(l_reg),false,false);l_reg=__uint_as_float(rr[0])+__uint_as_float(rr[1]);}
  if(hi==0)wsf[32+r32]=l_reg;asm volatile("s_waitcnt lgkmcnt(0)":::"memory");
  float rli[16];
  #pragma unroll
  for(int r=0;r<16;++r)rli[r]=__builtin_amdgcn_rcpf(wsf[32+crow(r,hi)]);
  bf16*Ow=O+(rowbase+q0+wid*QBLK)*1024+h*D;
  { bf16*stg=(bf16*)(shm+LDS_OST)+wid*2048;
    #pragma unroll
    for(int r=0;r<16;++r){const int orow=crow(r,hi);
      #pragma unroll
      for(int d0=0;d0<2;++d0)stg[orow*64+d0*32+r32]=f2bf(o[d0][r]*rli[r]);}
    asm volatile("s_waitcnt lgkmcnt(0)":::"memory");
    #pragma unroll
    for(int i=0;i<4;++i){const int row=i*8+(lane>>3),ch=lane&7; const u32x4 v=*(const u32x4*)(stg+row*64+ch*8); ATTN_STORE16(Ow+(long)row*1024+ch*8,v);} }
  asm volatile("s_waitcnt lgkmcnt(0)\n\ts_barrier":::"memory");
  #undef DMA_K
  #undef DMA_V
  #undef CMASK
  #undef START
  #undef RESC
  #undef ROT
}
constexpr int ATTN_LDS_BYTES=LDS_BYTES;
#undef SBAR
#undef WAIT_BAR
}

namespace ix {
constexpr int IKROW = 144;
DI unsigned sortable(float f) { const unsigned u = __float_as_uint(f); return (u & 0x80000000u) ? ~u : (u | 0x80000000u); }

DI void indexer_unit(const bf16_t* proj, const float* iw, unsigned* mask, int b, int qt16, unsigned char* lds, int tid) {
    float* SC = (float*)lds;
    unsigned char* IK = lds + 131072;
    const int w = __builtin_amdgcn_readfirstlane(tid >> 6), lane = tid & 63, r = lane & 31, hf = lane >> 5;
    const int mtile = w & 3, par = w >> 2;
    const int q0 = qt16 * 16, nch = (q0 + 16 + 127) >> 7;
    const int qq = ((r >> 4) & 1) + 2 * ((r >> 2) & 1), hh = (r & 3) + 4 * ((r >> 3) & 1);
    const bf16_t* ap = proj + (size_t)(b * S_ + q0 + 4 * mtile + qq) * NE_IN + C_IQ + hh * 64 + hf * 8;
    bf16x8 af[4];
#pragma unroll
    for (int ks = 0; ks < 4; ++ks) af[ks] = *(const bf16x8*)(ap + ks * 16);
    const int qA = 4 * mtile + 2 * hf;
    const float* iwp = iw + (size_t)(b * S_ + q0 + qA) * 8;
    const f32x4 iwA0 = *(const f32x4*)(iwp), iwA1 = *(const f32x4*)(iwp + 4), iwB0 = *(const f32x4*)(iwp + 8), iwB1 = *(const f32x4*)(iwp + 12);
    const int kr0 = tid >> 3, kc = tid & 7;
    const bf16_t* kp = proj + (size_t)(b * S_ + kr0) * NE_IN + C_IK + kc * 8;
    u32x4 g0 = *(const u32x4*)kp, g1 = *(const u32x4*)(kp + (size_t)64 * NE_IN);
    for (int c = 0; c < nch; ++c) {
        __syncthreads();
        *(u32x4*)(IK + kr0 * IKROW + kc * 16) = g0; *(u32x4*)(IK + (kr0 + 64) * IKROW + kc * 16) = g1;
        __syncthreads();
        if (c + 1 < nch) { kp += (size_t)128 * NE_IN; g0 = *(const u32x4*)kp; g1 = *(const u32x4*)(kp + (size_t)64 * NE_IN); }
#pragma unroll
        for (int t2 = 0; t2 < 2; ++t2) {
            const int ntile = par * 2 + t2;
            f32x16 acc = zero16();
#pragma unroll
            for (int ks = 0; ks < 4; ++ks) { const bf16x8 bfr = *(const bf16x8*)(IK + (ntile * 32 + r) * IKROW + ks * 32 + hf * 16); acc = mfma32(af[ks], bfr, acc); }
            float sA = 0.f, sB = 0.f;
#pragma unroll
            for (int e = 0; e < 4; ++e) { sA += fmaxf(acc[e], 0.f) * iwA0[e] + fmaxf(acc[4 + e], 0.f) * iwA1[e]; sB += fmaxf(acc[8 + e], 0.f) * iwB0[e] + fmaxf(acc[12 + e], 0.f) * iwB1[e]; }
            const int key = c * 128 + ntile * 32 + r, qposA = q0 + qA;
            SC[qA * 2048 + key] = (key <= qposA) ? sA : NEG_INF;
            SC[(qA + 1) * 2048 + key] = (key <= qposA + 1) ? sB : NEG_INF;
        }
    }
    __syncthreads();
    const int nI = nch * 2;
    LAS unsigned* hist = (LAS unsigned*)(lds + 153600 + w * 1024);
#pragma unroll 1
    for (int qsel = 0; qsel < 2; ++qsel) {
        const int qi = 2 * w + qsel, qpos = q0 + qi;
        unsigned u[32];
#pragma unroll
        for (int i = 0; i < 32; ++i) u[i] = (i < nI) ? sortable(SC[qi * 2048 + i * 64 + lane]) : 0u;
        unsigned long long mymask = 0ull;
        if (qpos < 256) {
#pragma unroll
            for (int i = 0; i < 32; ++i) { const unsigned long long bal = __ballot((i * 64 + lane) <= qpos); if (lane == i) mymask = bal; }
        } else {
            unsigned prefix = 0u; int need = 256, shift = 24; bool whole = false;
#pragma unroll 1
            for (int pass = 0; pass < 4; ++pass) {
                shift = 24 - 8 * pass;
                { unsigned zz = 0u; asm volatile("" : "+v"(zz)); *(u32x4*)(hist + lane * 4) = (u32x4){zz, zz, zz, zz}; }
#pragma unroll
                for (int i = 0; i < 32; ++i) if (i < nI) {
                    const bool in = (pass == 0) ? (u[i] > 0x007fffffu) : ((u[i] >> (shift + 8)) == prefix);
                    if (in) __hip_atomic_fetch_add(hist + ((u[i] >> shift) & 255u), 1u, __ATOMIC_RELAXED, __HIP_MEMORY_SCOPE_WAVEFRONT);
                }
                const u32x4 hv = *(const u32x4*)(hist + (63 - lane) * 4);
                const int sl = (int)(hv[0] + hv[1] + hv[2] + hv[3]);
                int pre = sl;
                pre += __builtin_amdgcn_update_dpp(0, pre, 0x111, 0xf, 0xf, false);
                pre += __builtin_amdgcn_update_dpp(0, pre, 0x112, 0xf, 0xf, false);
                pre += __builtin_amdgcn_update_dpp(0, pre, 0x114, 0xf, 0xf, false);
                pre += __builtin_amdgcn_update_dpp(0, pre, 0x118, 0xf, 0xf, false);
                pre += __builtin_amdgcn_update_dpp(0, pre, 0x142, 0xa, 0xf, false);
                pre += __builtin_amdgcn_update_dpp(0, pre, 0x143, 0xc, 0xf, false);
                const unsigned long long mk = __ballot(pre >= need);
                const int Lsel = __builtin_ctzll(mk);
                int above = pre - sl, bin = 4 * (63 - lane), nn = need, cnt = 0;
                if (above + (int)hv[3] >= need) { bin += 3; nn = need - above; cnt = (int)hv[3]; }
                else { above += (int)hv[3];
                    if (above + (int)hv[2] >= need) { bin += 2; nn = need - above; cnt = (int)hv[2]; }
                    else { above += (int)hv[2];
                        if (above + (int)hv[1] >= need) { bin += 1; nn = need - above; cnt = (int)hv[1]; }
                        else { above += (int)hv[1]; nn = need - above; cnt = (int)hv[0]; } } }
                bin = __builtin_amdgcn_readlane(bin, Lsel); need = __builtin_amdgcn_readlane(nn, Lsel); cnt = __builtin_amdgcn_readlane(cnt, Lsel);
                prefix = (prefix << 8) | (unsigned)bin;
                if (cnt == need) { whole = true; break; }
            }
            const unsigned T = whole ? (prefix << shift) : prefix;
            int tc = 0;
#pragma unroll
            for (int i = 0; i < 32; ++i) if (i < nI) {
                bool sel;
                if (whole) sel = (u[i] >= T);
                else {
                    const unsigned long long eq = __ballot(u[i] == T);
                    const int myrank = tc + (int)__builtin_amdgcn_mbcnt_hi((unsigned)(eq >> 32), __builtin_amdgcn_mbcnt_lo((unsigned)eq, 0u));
                    sel = (u[i] > T) || (u[i] == T && myrank < need);
                    tc += __popcll(eq);
                }
                const unsigned long long bal = __ballot(sel);
                if (lane == i) mymask = bal;
            }
        }
        if (lane < 32) { u32x2 o; o[0] = (unsigned)mymask; o[1] = (unsigned)(mymask >> 32); *(u32x2*)(mask + (size_t)(b * S_ + qpos) * 64 + 2 * lane) = o; }
    }
    __syncthreads();
}
}

namespace pr {
DI void ce_desc(float& x, float& y) { const float hi = fmaxf(x, y), lo = fminf(x, y); x = hi; y = lo; }
DI void sort16_desc(float (&a)[16]) {
    ce_desc(a[0], a[13]); ce_desc(a[1], a[12]); ce_desc(a[2], a[15]); ce_desc(a[3], a[14]); ce_desc(a[4], a[8]); ce_desc(a[5], a[6]); ce_desc(a[7], a[11]); ce_desc(a[9], a[10]);
    ce_desc(a[0], a[5]); ce_desc(a[1], a[7]); ce_desc(a[2], a[9]); ce_desc(a[3], a[4]); ce_desc(a[6], a[13]); ce_desc(a[8], a[14]); ce_desc(a[10], a[15]); ce_desc(a[11], a[12]);
    ce_desc(a[0], a[1]); ce_desc(a[2], a[3]); ce_desc(a[4], a[5]); ce_desc(a[6], a[8]); ce_desc(a[7], a[9]); ce_desc(a[10], a[11]); ce_desc(a[12], a[13]); ce_desc(a[14], a[15]);
    ce_desc(a[0], a[2]); ce_desc(a[1], a[3]); ce_desc(a[4], a[10]); ce_desc(a[5], a[11]); ce_desc(a[6], a[7]); ce_desc(a[8], a[9]); ce_desc(a[12], a[14]); ce_desc(a[13], a[15]);
    ce_desc(a[1], a[2]); ce_desc(a[3], a[12]); ce_desc(a[4], a[6]); ce_desc(a[5], a[7]); ce_desc(a[8], a[10]); ce_desc(a[9], a[11]); ce_desc(a[13], a[14]);
    ce_desc(a[1], a[4]); ce_desc(a[2], a[6]); ce_desc(a[5], a[8]); ce_desc(a[7], a[10]); ce_desc(a[9], a[13]); ce_desc(a[11], a[14]);
    ce_desc(a[2], a[4]); ce_desc(a[3], a[6]); ce_desc(a[9], a[12]); ce_desc(a[11], a[13]);
    ce_desc(a[3], a[5]); ce_desc(a[6], a[8]); ce_desc(a[7], a[9]); ce_desc(a[10], a[12]);
    ce_desc(a[3], a[4]); ce_desc(a[5], a[6]); ce_desc(a[7], a[8]); ce_desc(a[9], a[10]); ce_desc(a[11], a[12]);
    ce_desc(a[6], a[7]); ce_desc(a[8], a[9]);
}
DI void merge_top16(float (&a)[16], const float (&b)[16]) {
#pragma unroll
    for (int i = 0; i < 16; ++i) a[i] = fmaxf(a[i], b[15 - i]);
#pragma unroll
    for (int j = 8; j > 0; j >>= 1)
#pragma unroll
        for (int i = 0; i < 16; ++i) if ((i & j) == 0) ce_desc(a[i], a[i + j]);
}
constexpr int SUBK_MAT = 128 * 256;
constexpr int ROUTE_SCR = 2 * SUBK_MAT;
DI void stage_subk(const bf16_t* subk, int hp0, int hp1, unsigned char* lds, int tid) {
#pragma unroll
    for (int i = 0; i < 8; ++i) {
        const int piece = i * 512 + tid, slot = piece >> 11, pp = piece & 2047, row = pp >> 4, ch = pp & 15;
        const bf16_t* src = subk + (size_t)((slot ? hp1 : hp0) * 128 + row) * 128 + ((ch ^ (row & 15)) * 8);
        __builtin_amdgcn_global_load_lds((const unsigned*)src, (unsigned*)(lds + slot * SUBK_MAT + pp * 16), 16, 0, 0);
    }
}
DI void subkey_scores(const bf16x8 (&qf)[8], const unsigned char* mat, int r, int hf, float (&c)[4][16]) {
#pragma unroll
    for (int mt = 0; mt < 4; ++mt) {
        f32x16 acc = zero16();
        const int row = mt * 32 + r;
        const unsigned char* rp = mat + row * 256;
#pragma unroll
        for (int ks = 0; ks < 8; ++ks) acc = mfma32(*(const bf16x8*)(rp + (((2 * ks + hf) ^ (row & 15)) * 16)), qf[ks], acc);
#pragma unroll
        for (int e = 0; e < 16; ++e) {
            const unsigned key = (unsigned)(mt * 32 + (e & 3) + 8 * (e >> 2)) + 4u * (unsigned)hf;
            c[mt][e] = __uint_as_float((__float_as_uint(acc[e]) & ~127u) | key);
        }
    }
}
DI void sort_top16(float (&c)[4][16], float (&V)[16]) {
#pragma unroll
    for (int mt = 0; mt < 4; ++mt) sort16_desc(c[mt]);
    merge_top16(c[0], c[1]); merge_top16(c[2], c[3]); merge_top16(c[0], c[2]);
    float pb[16];
#pragma unroll
    for (int k = 0; k < 16; ++k) pb[k] = __shfl_xor(c[0][k], 32, 64);
    merge_top16(c[0], pb);
#pragma unroll
    for (int k = 0; k < 16; ++k) V[k] = c[0][k];
}
DI void route_block(const bf16_t* qp, const bf16_t* subk, unsigned short* re, float* rg, int unit, unsigned char* lds, int tid) {
    const int w = __builtin_amdgcn_readfirstlane(tid >> 6), lane = tid & 63, r = lane & 31, hf = lane >> 5;
    const int tg = w & 3, hh = w >> 2, token = unit * 128 + tg * 32 + r;
    unsigned char* ldsw = lds + ROUTE_SCR + w * 8192;
    const unsigned char* mat = lds + hh * SUBK_MAT;
    stage_subk(subk, 0, 8, lds, tid);
    bf16x8 qn[8];
    {
        const bf16_t* qptr = qp + (size_t)token * 2048 + (hh * 8) * 128 + hf * 8;
#pragma unroll
        for (int ks = 0; ks < 8; ++ks) qn[ks] = *(const bf16x8*)(qptr + ks * 16);
    }
#pragma unroll 1
    for (int hpair = 0; hpair < 2; ++hpair) {
        const int hA = hh * 4 + hpair * 2;
        float V0[16], V1[16];
#pragma unroll
        for (int k = 0; k < 16; ++k) { V0[k] = 0.f; V1[k] = 0.f; }
#pragma unroll 1
        for (int st = 0; st < 4; ++st) {
            const int s = hpair * 4 + st;
            bf16x8 qf[8];
#pragma unroll
            for (int ks = 0; ks < 8; ++ks) qf[ks] = qn[ks];
            asm volatile("s_waitcnt vmcnt(0)" ::: "memory");
            __syncthreads();
            float c[4][16];
            subkey_scores(qf, mat, r, hf, c);
            __syncthreads();
            if (s + 1 < 8) {
                stage_subk(subk, s + 1, 8 + s + 1, lds, tid);
                const bf16_t* qptr = qp + (size_t)token * 2048 + (hh * 8 + s + 1) * 128 + hf * 8;
#pragma unroll
                for (int ks = 0; ks < 8; ++ks) qn[ks] = *(const bf16x8*)(qptr + ks * 16);
            }
            float Bt[16]; sort_top16(c, Bt);
            const bool to0 = (st == 0) || (st == 2 && hf), to1 = (st == 1) || (st == 3 && hf);
#pragma unroll
            for (int k = 0; k < 16; ++k) { V0[k] = to0 ? Bt[k] : V0[k]; V1[k] = to1 ? Bt[k] : V1[k]; }
        }
        const int head = hA + hf;
        float cv[64];
        {
            int n = 0;
#pragma unroll
            for (int i = 0; i < 16; ++i)
#pragma unroll
                for (int j = 0; j < 16; ++j) if ((i + 1) * (j + 1) <= 16) { cv[n] = V0[i] + V1[j]; ++n; }
#pragma unroll
            for (int k = 50; k < 64; ++k) cv[k] = NEG_INF;
        }
        float sv[4][16];
#pragma unroll
        for (int g = 0; g < 4; ++g) {
#pragma unroll
            for (int i = 0; i < 16; ++i) sv[g][i] = cv[g * 16 + i];
            sort16_desc(sv[g]);
        }
        merge_top16(sv[0], sv[1]); merge_top16(sv[2], sv[3]); merge_top16(sv[0], sv[2]);
        const float smax = sv[0][0], thr = sv[0][15];
        float den = 0.f;
#pragma unroll
        for (int k = 0; k < 16; ++k) den += __expf(sv[0][k] - smax);
        const float inv = 1.0f / den;
        int pos = 0;
        {
            int n = 0;
#pragma unroll
            for (int i = 0; i < 16; ++i)
#pragma unroll
                for (int j = 0; j < 16; ++j) if ((i + 1) * (j + 1) <= 16) {
                    if (cv[n] >= thr && pos < 16) {
                        u32x2 ent; ent[0] = ((__float_as_uint(V0[i]) & 127u) << 7) | (__float_as_uint(V1[j]) & 127u); ent[1] = __float_as_uint(__expf(cv[n] - smax) * inv);
                        *(u32x2*)(ldsw + pos * 512 + lane * 8) = ent; ++pos;
                    }
                    ++n;
                }
        }
        unsigned short* rep = re + (size_t)token * 128 + head * 16; float* rgp = rg + (size_t)token * 128 + head * 16;
        unsigned ev[8];
#pragma unroll
        for (int k4 = 0; k4 < 4; ++k4) {
            f32x4 gv; unsigned e4[4];
#pragma unroll
            for (int q = 0; q < 4; ++q) { const u32x2 ent = *(const u32x2*)(ldsw + (k4 * 4 + q) * 512 + lane * 8); e4[q] = ent[0]; gv[q] = __uint_as_float(ent[1]); }
            ev[2 * k4] = e4[0] | (e4[1] << 16); ev[2 * k4 + 1] = e4[2] | (e4[3] << 16);
            *(f32x4*)(rgp + 4 * k4) = gv;
        }
        *(u32x4*)rep = (u32x4){ev[0], ev[1], ev[2], ev[3]}; *(u32x4*)(rep + 8) = (u32x4){ev[4], ev[5], ev[6], ev[7]};
    }
    __syncthreads();
}

DI void fp8x16_to_f32(const u32x4 d, float (&f)[16]) {
#pragma unroll
    for (int q = 0; q < 4; ++q) {
        const f32x2 lo = __builtin_amdgcn_cvt_pk_f32_fp8((int)d[q], false), hi = __builtin_amdgcn_cvt_pk_f32_fp8((int)d[q], true);
        f[4 * q] = lo[0]; f[4 * q + 1] = lo[1]; f[4 * q + 2] = hi[0]; f[4 * q + 3] = hi[1];
    }
}
DI void ld_ids(const unsigned short* re, int t, int g, int (&ids)[16]) {
    const u32x4 a = *(const u32x4*)(re + (size_t)t * 128 + g * 16), b = *(const u32x4*)(re + (size_t)t * 128 + g * 16 + 8);
#pragma unroll
    for (int q = 0; q < 4; ++q) { ids[2 * q] = (int)(a[q] & 0xffffu); ids[2 * q + 1] = (int)(a[q] >> 16); ids[8 + 2 * q] = (int)(b[q] & 0xffffu); ids[8 + 2 * q + 1] = (int)(b[q] >> 16); }
}
DI void ld_rows(const unsigned char* tab, unsigned laneoff, const int (&ids)[16], u32x4 (&data)[16]) {
#pragma unroll
    for (int i = 0; i < 16; ++i) data[i] = *(const u32x4*)(tab + (size_t)((unsigned)ids[i] * 128u + laneoff));
}
DI void peer_u_loop(const bf16_t* h2, const unsigned char* U, const unsigned short* re, bf16_t* pd, int t0, int tstep, int slice, int lane) {
    const int g = lane >> 3, c = lane & 7;
    const unsigned laneoff = (unsigned)(slice * (NEXP * 128) + c * 16);
    const bf16_t* hb = h2 + slice * 128 + c * 16;
    if (t0 >= T_) return;
    int idsn[16]; u32x4 data[16]; u32x4 h0, h1;
    ld_ids(re, t0, g, idsn); ld_rows(U, laneoff, idsn, data);
    h0 = *(const u32x4*)(hb + (size_t)t0 * 1024); h1 = *(const u32x4*)(hb + (size_t)t0 * 1024 + 8);
    ld_ids(re, min(t0 + tstep, T_ - 1), g, idsn);
    const bool b2 = (c & 4) != 0, b1 = (c & 2) != 0, b0 = (c & 1) != 0;
#pragma unroll 1
    for (int t = t0; t < T_; t += tstep) {
        const int tnc = min(t + tstep, T_ - 1), tnn = min(t + 2 * tstep, T_ - 1);
        f32x2 hp[8];
#pragma unroll
        for (int q = 0; q < 4; ++q) { hp[q] = (f32x2){bf_lo(h0[q]), bf_hi(h0[q])}; hp[4 + q] = (f32x2){bf_lo(h1[q]), bf_hi(h1[q])}; }
        h0 = *(const u32x4*)(hb + (size_t)tnc * 1024); h1 = *(const u32x4*)(hb + (size_t)tnc * 1024 + 8);
        float part[16];
#pragma unroll
        for (int i = 0; i < 16; ++i) {
            const u32x4 d = data[i];
            data[i] = *(const u32x4*)(U + (size_t)((unsigned)idsn[i] * 128u + laneoff));
            f32x2 s2 = {0.f, 0.f};
#pragma unroll
            for (int q = 0; q < 4; ++q) {
                const f32x2 lo = __builtin_amdgcn_cvt_pk_f32_fp8((int)d[q], false), hi = __builtin_amdgcn_cvt_pk_f32_fp8((int)d[q], true);
                s2 = __builtin_elementwise_fma(lo, hp[2 * q], s2); s2 = __builtin_elementwise_fma(hi, hp[2 * q + 1], s2);
            }
            part[i] = s2[0] + s2[1];
        }
        ld_ids(re, tnn, g, idsn);
        float a8[8], a4[4], a2[2];
#pragma unroll
        for (int k = 0; k < 8; ++k) { const float keep = b2 ? part[8 + k] : part[k], send = b2 ? part[k] : part[8 + k]; a8[k] = keep + __shfl_xor(send, 4, 64); }
#pragma unroll
        for (int k = 0; k < 4; ++k) { const float keep = b1 ? a8[4 + k] : a8[k], send = b1 ? a8[k] : a8[4 + k]; a4[k] = keep + __shfl_xor(send, 2, 64); }
#pragma unroll
        for (int k = 0; k < 2; ++k) { const float keep = b0 ? a4[2 + k] : a4[k], send = b0 ? a4[k] : a4[2 + k]; a2[k] = keep + __shfl_xor(send, 1, 64); }
        *(unsigned*)(pd + (size_t)t * 1024 + slice * 128 + 2 * lane) = pk_bf16(a2[0], a2[1]);
    }
}
DI void peer_combine(const bf16_t* pd, float* wg, const float* ps, int tb, int lane) {
    const int t = tb + (lane >> 4), p0 = (lane & 15) * 8;
    const f32x4 q0 = *(const f32x4*)(ps + (size_t)t * 16), q1 = *(const f32x4*)(ps + (size_t)t * 16 + 4), q2 = *(const f32x4*)(ps + (size_t)t * 16 + 8), q3 = *(const f32x4*)(ps + (size_t)t * 16 + 12);
    const float sq = (((q0[0] + q0[1]) + (q0[2] + q0[3])) + ((q1[0] + q1[1]) + (q1[2] + q1[3]))) + (((q2[0] + q2[1]) + (q2[2] + q2[3])) + ((q3[0] + q3[1]) + (q3[2] + q3[3])));
    const float rs = (1.0f / TAB_SCALE) / sqrtf(sq * (1.0f / 1024.0f) + 1e-6f);
    u32x4 v[8];
#pragma unroll
    for (int sl = 0; sl < 8; ++sl) v[sl] = *(const u32x4*)(pd + (size_t)t * 1024 + sl * 128 + p0);
    float* gp = wg + (size_t)t * 128 + p0;
    const f32x4 g0 = *(const f32x4*)gp, g1 = *(const f32x4*)(gp + 4);
    float d[8];
#pragma unroll
    for (int k = 0; k < 8; ++k) d[k] = 0.f;
#pragma unroll
    for (int sl = 0; sl < 8; ++sl)
#pragma unroll
        for (int q = 0; q < 4; ++q) { d[2 * q] += bf_lo(v[sl][q]); d[2 * q + 1] += bf_hi(v[sl][q]); }
    f32x4 o0, o1;
#pragma unroll
    for (int k = 0; k < 8; ++k) {
        const float cc = d[k] * rs;
        const float g = (k < 4) ? g0[k & 3] : g1[k & 3];
        const float r = g * 0.5f * cc * (1.0f + erff(cc * 0.70710678118654752f)) * (1.0f / TAB_SCALE);
        if (k < 4) o0[k & 3] = r; else o1[k & 3] = r;
    }
    *(f32x4*)gp = o0; *(f32x4*)(gp + 4) = o1;
}
DI void ld_w(const float* wg, int t, int g, float (&wv)[16]) {
#pragma unroll
    for (int q = 0; q < 4; ++q) { const f32x4 wq = *(const f32x4*)(wg + (size_t)t * 128 + g * 16 + q * 4); wv[4 * q] = wq[0]; wv[4 * q + 1] = wq[1]; wv[4 * q + 2] = wq[2]; wv[4 * q + 3] = wq[3]; }
}
DI void peer_v_loop(bf16_t* xb, float* psa, const unsigned char* V, const unsigned short* re, const float* wg, int t0, int tstep, int slice, int lane) {
    const int g = lane >> 3, c = lane & 7;
    const unsigned laneoff = (unsigned)(slice * (NEXP * 128) + c * 16);
    if (t0 >= T_) return;
    int idsn[16]; u32x4 data[16]; float wv[16], wn[16];
    ld_ids(re, t0, g, idsn); ld_rows(V, laneoff, idsn, data); ld_w(wg, t0, g, wv);
    { const int tc = min(t0 + tstep, T_ - 1); ld_ids(re, tc, g, idsn); ld_w(wg, tc, g, wn); }
    const bool b5 = (lane & 32) != 0, b4 = (lane & 16) != 0, b3 = (lane & 8) != 0;
#pragma unroll 1
    for (int t = t0; t < T_; t += tstep) {
        const int tnn = min(t + 2 * tstep, T_ - 1);
        const size_t o = (size_t)t * 1024 + slice * 128 + c * 16 + 2 * g;
        const unsigned xo = *(const unsigned*)(xb + o);
        f32x2 acc2[8];
#pragma unroll
        for (int k = 0; k < 8; ++k) acc2[k] = (f32x2){0.f, 0.f};
#pragma unroll
        for (int i = 0; i < 16; ++i) {
            const u32x4 d = data[i];
            data[i] = *(const u32x4*)(V + (size_t)((unsigned)idsn[i] * 128u + laneoff));
            const f32x2 w2 = {wv[i], wv[i]};
#pragma unroll
            for (int q = 0; q < 4; ++q) {
                const f32x2 lo = __builtin_amdgcn_cvt_pk_f32_fp8((int)d[q], false), hi = __builtin_amdgcn_cvt_pk_f32_fp8((int)d[q], true);
                acc2[2 * q] = __builtin_elementwise_fma(lo, w2, acc2[2 * q]); acc2[2 * q + 1] = __builtin_elementwise_fma(hi, w2, acc2[2 * q + 1]);
            }
        }
        float acc[16];
#pragma unroll
        for (int k = 0; k < 8; ++k) { acc[2 * k] = acc2[k][0]; acc[2 * k + 1] = acc2[k][1]; }
#pragma unroll
        for (int k = 0; k < 16; ++k) wv[k] = wn[k];
        ld_ids(re, tnn, g, idsn); ld_w(wg, tnn, g, wn);
        float a8[8], a4[4], a2[2];
#pragma unroll
        for (int k = 0; k < 8; ++k) { const float keep = b5 ? acc[8 + k] : acc[k], send = b5 ? acc[k] : acc[8 + k]; a8[k] = keep + __shfl_xor(send, 32, 64); }
#pragma unroll
        for (int k = 0; k < 4; ++k) { const float keep = b4 ? a8[4 + k] : a8[k], send = b4 ? a8[k] : a8[4 + k]; a4[k] = keep + __shfl_xor(send, 16, 64); }
#pragma unroll
        for (int k = 0; k < 2; ++k) { const float keep = b3 ? a4[2 + k] : a4[k], send = b3 ? a4[k] : a4[2 + k]; a2[k] = keep + __shfl_xor(send, 8, 64); }
        const float y0 = bf_lo(xo) + a2[0], y1 = bf_hi(xo) + a2[1];
        *(unsigned*)(xb + o) = pk_bf16(y0, y1);
        const float ss = wave_sum(y0 * y0 + y1 * y1);
        if (lane == 0) psa[(size_t)t * 8 + slice] = ss;
    }
}
}

constexpr int NPHASE = 1 + 12 * DEPTH_;

#ifndef MK_ONE_LAUNCH
#define MK_ONE_LAUNCH 1
#endif

__global__ void __launch_bounds__(NTHR, 2) k_main(Params p) {
    extern __shared__ __attribute__((aligned(16))) unsigned char lds[];
    unsigned char* const ws = p.ws;
    const int bid = blockIdx.x, nblk = gridDim.x;
    const bool fused = (p.ph_hi - p.ph_lo) > 1;
    XcdBarrier bar; bar.bar = (unsigned*)(ws + WS_BAR); bar.x = 0; bar.st = (volatile LAS unsigned*)(lds + LDS_BYTES - 16);
    if (fused) {
        if (threadIdx.x == 0) *(u32x4*)(lds + LDS_BYTES - 16) = (u32x4){0u, 0u, 0u, 0u};
        __syncthreads();
        bar = xcd_barrier_post((unsigned*)(ws + WS_BAR), (volatile LAS unsigned*)(lds + LDS_BYTES - 16));
    }
#define PH_BEGIN(k) if (p.ph_lo <= (k) && (k) < p.ph_hi) { int tv = threadIdx.x; asm volatile("" : "+v"(tv)); (void)tv;
#define PH_END(k) if ((k) + 1 < p.ph_hi) xcd_barrier(bar); }
#define REPN(bit) (((DBG_REP >> (bit)) & 1) ? 2 : 1)

    float* const PSA = (float*)(ws + WS_RSTD);
    bf16_t* const H = (bf16_t*)(ws + WS_H);
    bf16_t* const O = (bf16_t*)(ws + WS_O);
    const float* const c64 = (const float*)(ws + WS_COS64); const float* const s64 = (const float*)(ws + WS_SIN64);
    const float* const c32 = (const float*)(ws + WS_COS32); const float* const s32 = (const float*)(ws + WS_SIN32);

    PH_BEGIN(0)
        int toff = 0;
        for (int rep = 0; rep < REPN(14); ++rep) {
        for (int j = 0; j < 2; ++j) {
            prep_wt<1>(p.hyb_w_in + (size_t)j * 1024 * 2760, 1024, 2760, (bf16_t*)(ws + WS_WEIN + j * SZ_WEIN), NE_IN, p.attn_norm + (2 * j) * 1024, toff, bid, nblk, tv);
            prep_wt<2>(p.hyb_w_out + (size_t)j * 1024 * 1024, 1024, 1024, (bf16_t*)(ws + WS_WEOUT + j * SZ_WSQ), 1024, nullptr, toff, bid, nblk, tv);
            prep_wt<3>(p.mla_w_in + (size_t)j * 1024 * 1056, 1024, 1056, (bf16_t*)(ws + WS_WMIN + j * SZ_WMIN), NM_IN, p.attn_norm + (2 * j + 1) * 1024, toff, bid, nblk, tv);
            prep_wt<4>(p.mla_w_uq + (size_t)j * 768 * 1536, 768, 1536, (bf16_t*)(ws + WS_WUQ + j * SZ_WUQ), 1536, p.mla_q_norm + j * 768, toff, bid, nblk, tv);
            prep_wt<2>(p.mla_w_ukv + (size_t)j * 256 * 2048, 256, 2048, (bf16_t*)(ws + WS_WUKV + j * SZ_WUKV), 2048, p.mla_kv_norm + j * 256, toff, bid, nblk, tv);
            prep_wt<2>(p.mla_w_out + (size_t)j * 1024 * 1024, 1024, 1024, (bf16_t*)(ws + WS_WMOUT + j * SZ_WSQ), 1024, nullptr, toff, bid, nblk, tv);
        }
        for (int j = 0; j < 4; ++j) prep_wt<2>(p.peer_w_q + (size_t)j * 1024 * 2048, 1024, 2048, (bf16_t*)(ws + WS_WPQ + j * SZ_WPQ), 2048, p.ffn_norm + j * 1024, toff, bid, nblk, tv);
        cvt_bf16(p.peer_sub_keys, (bf16_t*)(ws + WS_SUBK), (size_t)4 * 16 * 128 * 128, bid, nblk, tv);
        cvt_fp8(p.peer_u, ws + WS_U16, (size_t)4 * NEXP * 1024, TAB_SCALE, p.ffn_norm, bid, nblk, tv);
        cvt_fp8(p.peer_v, ws + WS_V16, (size_t)4 * NEXP * 1024, TAB_SCALE, nullptr, bid, nblk, tv);
        rope_tables(p.pos, (float*)(ws + WS_COS64), (float*)(ws + WS_SIN64), (float*)(ws + WS_COS32), (float*)(ws + WS_SIN32), bid, nblk, tv);
        x_to_stream(p.x, H, PSA, bid, nblk, tv);
        }
    PH_END(0)

#pragma unroll 1
    for (int L = 0; L < DEPTH_; ++L) {
        const int base = 1 + 12 * L, j = L >> 1;
        if ((L & 1) == 0) {
            bf16_t* PROJ = (bf16_t*)(ws + WS_P); bf16_t* vaT = (bf16_t*)(ws + WS_VT); bf16_t* vbT = (bf16_t*)(ws + WS_VT + 4 * MiB);
            float* IW = (float*)(ws + WS_IW); unsigned* MASK = (unsigned*)(ws + WS_MASK);
            PH_BEGIN(base + 0)
                gm::EpiEvenIn e{PROJ, vaT, vbT, IW, c64, s64, PSA};
                for (int rep = 0; rep < REPN(0); ++rep)
                gm::gemm_phase(H, 1024, (const bf16_t*)(ws + WS_WEIN + j * SZ_WEIN), T_, NE_IN, 1024, e, lds, bid, nblk);
            PH_END(base + 0)
            PH_BEGIN(base + 1)
                const at::Args aB{PROJ, PROJ, nullptr, vbT, nullptr, O};
                for (int rep = 0; rep < REPN(1); ++rep) {
                int kbh = -1;
                for (int u = bid; u < 1024; u += nblk) {
                    int tw = threadIdx.x; asm volatile("" : "+v"(tw));
                    const int i = u >> 7, bh = u & 127;
                    const int qt = (0x32451067 >> (4 * i)) & 7;
                    if (bh != kbh) { ab::moba_kmean(bh >> 3, bh & 7, 7, PROJ + C_KB, (char*)lds, tw); kbh = bh; }
                    ab::attn_unit<8, 1>(bh >> 3, bh & 7, qt, PROJ + C_QB, PROJ + C_KB, PROJ + C_VB, O + 512, nullptr, (char*)lds, tw);
                }
                }
                for (int rep = 0; rep < REPN(2); ++rep)
                for (int u = bid; u < 2048; u += nblk) {
                    int tw = threadIdx.x; asm volatile("" : "+v"(tw));
                    const int b = u & 15, g = u >> 4, k = g >> 4, gl = g & 15;
                    const int qt16 = 16 * (7 - k) + ((k & 1) ? gl : 15 - gl);
                    ix::indexer_unit(PROJ, IW, MASK, b, qt16, lds, tw);
                }
            PH_END(base + 1)
            PH_BEGIN(base + 2)
                const at::Args aA{PROJ, PROJ, nullptr, vaT, MASK, O};
                for (int rep = 0; rep < REPN(3); ++rep)
                for (int u = bid; u < 1024; u += nblk) {
                    int tw = threadIdx.x; asm volatile("" : "+v"(tw));
                    const int k = u >> 8, c = u & 255, b = c >> 4, jj = c & 15;
                    const int qt = (k == 0) ? 63 - jj : (k == 1) ? 32 + jj : (k == 2) ? 31 - jj : jj;
                    ab::attn_unit<8, 2>(b, 0, qt, PROJ + C_QA, PROJ + C_KA, PROJ + C_VA, O, MASK, (char*)lds, tw);
                }
            PH_END(base + 2)
            PH_BEGIN(base + 4)
                {
                gm::EpiResid e{H, (float*)(ws + WS_PSF), nullptr};
                gm::gemm_phase(O, 1024, (const bf16_t*)(ws + WS_WEOUT + j * SZ_WSQ), T_, 1024, 1024, e, lds, bid, nblk); }
            PH_END(base + 4)
        } else {
            bf16_t* CIN = (bf16_t*)(ws + WS_P_CIN); bf16_t* QM = (bf16_t*)(ws + WS_P_QM); bf16_t* KN = (bf16_t*)(ws + WS_P_KN); bf16_t* vT = (bf16_t*)(ws + WS_VT);
            float* RSTD = (float*)(ws + WS_MASK);
            PH_BEGIN(base + 0)
                gm::EpiMlaIn e{CIN, c32, s32, RSTD, PSA};
                for (int rep = 0; rep < REPN(0); ++rep)
                gm::gemm_phase(H, 1024, (const bf16_t*)(ws + WS_WMIN + j * SZ_WMIN), T_, 1024, 1024, e, lds, bid, nblk);
            PH_END(base + 0)
            PH_BEGIN(base + 2)
                for (int rep = 0; rep < REPN(5); ++rep) {
                mla_krope_units(H, (const bf16_t*)(ws + WS_WMIN + j * SZ_WMIN) + (size_t)1024 * 1024, PSA, c32, s32, CIN, bid, nblk, tv);
                { gm::EpiQup e{QM, RSTD, c32, s32, RSTD};
                  gm::gemm_phase(CIN, NM_IN, (const bf16_t*)(ws + WS_WUQ + j * SZ_WUQ), T_, 1536, 768, e, lds, bid, nblk); }
                { gm::EpiKVup e{KN, vT, RSTD, RSTD};
                  gm::gemm_phase(CIN + 768, NM_IN, (const bf16_t*)(ws + WS_WUKV + j * SZ_WUKV), T_, 2048, 256, e, lds, bid, nblk); } }
            PH_END(base + 2)
            PH_BEGIN(base + 3)
                const at::Args aC{QM, KN, CIN, vT, nullptr, O};
                for (int rep = 0; rep < REPN(6); ++rep)
                for (int u = bid; u < 2048; u += nblk) {
                    int tw = threadIdx.x; asm volatile("" : "+v"(tw));
                    const int i = u >> 8, bh = u & 255;
                    am::attn_unit<8>(bh >> 4, bh & 15, 7 - i, QM, KN, CIN, vT, O, (char*)lds, tw);
                }
            PH_END(base + 3)
            PH_BEGIN(base + 4)
                {
                gm::EpiResid e{H, (float*)(ws + WS_PSF), nullptr};
                gm::gemm_phase(O, 1024, (const bf16_t*)(ws + WS_WMOUT + j * SZ_WSQ), T_, 1024, 1024, e, lds, bid, nblk); }
            PH_END(base + 4)
        }
        bf16_t* QP = (bf16_t*)(ws + WS_P);
        unsigned short* RE = (unsigned short*)(ws + WS_RE); float* RG = (float*)(ws + WS_RG);
        PH_BEGIN(base + 6)
            gm::EpiBf16 e{QP, 2048, (const float*)(ws + WS_PSF)};
            for (int rep = 0; rep < REPN(9); ++rep)
            gm::gemm_phase(H, 1024, (const bf16_t*)(ws + WS_WPQ + L * SZ_WPQ), T_, 2048, 1024, e, lds, bid, nblk);
        PH_END(base + 6)
        PH_BEGIN(base + 7)
            const int w = tv >> 6;
            for (int rep = 0; rep < REPN(10); ++rep)
            for (int u = bid; u < T_ / 128; u += nblk) { int tw = threadIdx.x; asm volatile("" : "+v"(tw)); pr::route_block(QP, (const bf16_t*)(ws + WS_SUBK + L * SZ_SUBK), RE, RG, u, lds, tw); }
        PH_END(base + 7)
        bf16_t* PD = (bf16_t*)(ws + WS_P);
        PH_BEGIN(base + 8)
            const int w = tv >> 6, ngrp = nblk >> 3, slice = bid & 7, rank = bid >> 3;
            if (rank < ngrp)
            for (int rep = 0; rep < REPN(11); ++rep)
            pr::peer_u_loop(H, ws + WS_U16 + L * SZ_TAB, RE, PD, rank * 8 + w, ngrp * 8, slice, tv & 63);
        PH_END(base + 8)
        PH_BEGIN(base + 9)
            const int w = tv >> 6;
            for (int t = (bid * 8 + w) * 4; t < T_; t += nblk * 32) pr::peer_combine(PD, RG, (const float*)(ws + WS_PSF), t, tv & 63);
        PH_END(base + 9)
        PH_BEGIN(base + 10)
            const int w = tv >> 6, ngrp = nblk >> 3, slice = bid & 7, rank = bid >> 3;
            if (rank < ngrp)
            pr::peer_v_loop(H, PSA, ws + WS_V16 + L * SZ_TAB, RE, RG, rank * 8 + w, ngrp * 8, slice, tv & 63);
        PH_END(base + 10)
        if (L + 1 == DEPTH_) {
        PH_BEGIN(base + 11)
            final_norm_rows(H, p.final_norm, p.out, bid, nblk, tv);
        PH_END(base + 11)
        }
    }
#undef PH_BEGIN
#undef PH_END
}

extern "C" void kernel_launch(void* const* d_in, const int* in_sizes, int n_in, void* d_out, int out_size, void* d_ws, size_t ws_size, hipStream_t stream) {
    static int grid = 0;
    if (grid == 0) {
        if (n_in != 17 || out_size != T_ * D_ || ws_size < WS_END) { fprintf(stderr, "kernel_launch: unexpected shapes (n_in %d out %d ws %zu need %zu)\n", n_in, out_size, ws_size, (size_t)WS_END); grid = -1; return; }
        int dev = 0, cus = 0, per_cu = 0;
        if (hipGetDevice(&dev) != hipSuccess || hipDeviceGetAttribute(&cus, hipDeviceAttributeMultiprocessorCount, dev) != hipSuccess) { grid = -1; return; }
        if (hipFuncSetAttribute((const void*)k_main, hipFuncAttributeMaxDynamicSharedMemorySize, LDS_BYTES) != hipSuccess) { fprintf(stderr, "kernel_launch: hipFuncSetAttribute failed\n"); grid = -1; return; }
        if (hipOccupancyMaxActiveBlocksPerMultiprocessor(&per_cu, (const void*)k_main, NTHR, LDS_BYTES) != hipSuccess || per_cu < 1) { fprintf(stderr, "kernel_launch: occupancy query says %d\n", per_cu); per_cu = 1; }
        (void)hipGetLastError();
        grid = cus;
    }
    if (grid < 0) return;
    (void)hipMemsetAsync((char*)d_ws + WS_BAR, 0, XCD_BAR_WORDS * sizeof(unsigned), stream);
    Params p{};
    p.x = (const float*)d_in[0]; p.pos = (const int*)d_in[1]; p.attn_norm = (const float*)d_in[2]; p.ffn_norm = (const float*)d_in[3]; p.final_norm = (const float*)d_in[4];
    p.hyb_w_in = (const float*)d_in[5]; p.hyb_w_out = (const float*)d_in[6]; p.mla_w_in = (const float*)d_in[7]; p.mla_q_norm = (const float*)d_in[8]; p.mla_kv_norm = (const float*)d_in[9];
    p.mla_w_uq = (const float*)d_in[10]; p.mla_w_ukv = (const float*)d_in[11]; p.mla_w_out = (const float*)d_in[12]; p.peer_w_q = (const float*)d_in[13]; p.peer_sub_keys = (const float*)d_in[14];
    p.peer_u = (const float*)d_in[15]; p.peer_v = (const float*)d_in[16];
    p.out = (float*)d_out; p.ws = (unsigned char*)d_ws;
#if MK_ONE_LAUNCH
    p.ph_lo = 0; p.ph_hi = NPHASE;
    hipLaunchKernelGGL(k_main, dim3(grid), dim3(NTHR), LDS_BYTES, stream, p);
#else
    for (int ph = 0; ph < NPHASE; ++ph) {
        if (ph > 0) { const int L = (ph - 1) / 12, slot = (ph - 1) % 12; if ((slot == 3 && (L & 1) == 0) || (slot == 1 && (L & 1) == 1) || slot == 5 || (slot == 11 && L + 1 < DEPTH_)) continue; }
        p.ph_lo = ph; p.ph_hi = ph + 1;
        hipLaunchKernelGGL(k_main, dim3(grid), dim3(NTHR), LDS_BYTES, stream, p);
    }
#endif
}
```

```cpp
#include <hip/hip_runtime.h>
#include <stdint.h>
#include <stdio.h>
#include <cmath>

#define DI __device__ __forceinline__
#ifndef DBG_REP
#define DBG_REP 0
#endif
#ifndef DBG_SKIP
#define DBG_SKIP 0
#endif
#define LAS __attribute__((address_space(3)))
typedef unsigned short bf16_t;
typedef short bf16x8 __attribute__((ext_vector_type(8)));
typedef short s16x4 __attribute__((ext_vector_type(4)));
typedef float f32x2 __attribute__((ext_vector_type(2)));
typedef float f32x4 __attribute__((ext_vector_type(4)));
typedef float f32x16 __attribute__((ext_vector_type(16)));
typedef unsigned u32x2 __attribute__((ext_vector_type(2)));
typedef unsigned u32x4 __attribute__((ext_vector_type(4)));
typedef __bf16 bf2_t __attribute__((ext_vector_type(2)));

constexpr int T_ = 32768, D_ = 1024, S_ = 2048, NB_ = 16, DEPTH_ = 4;
constexpr int NE_IN = 2816;
constexpr int NM_IN = 1280;
constexpr int NEXP = 16384;
constexpr int NTHR = 512;
constexpr int LDS_BYTES = 163840;
constexpr float LOG2E = 1.4426950408889634f;
constexpr float NEG_INF = -__builtin_inff();
constexpr float TAB_SCALE = 64.0f;

constexpr int C_QA = 0, C_KA = 512, C_VA = 576, C_IQ = 640, C_IK = 1152, C_QB = 1216, C_KB = 1728, C_VB = 2240, C_IW = 2752;

constexpr size_t MiB = 1024 * 1024;
constexpr size_t WS_BAR = 0;
constexpr size_t WS_COS64 = 64 * 1024;
constexpr size_t WS_SIN64 = WS_COS64 + 4 * MiB;
constexpr size_t WS_COS32 = WS_SIN64 + 4 * MiB;
constexpr size_t WS_SIN32 = WS_COS32 + 2 * MiB;
constexpr size_t WS_WEIN = WS_SIN32 + 2 * MiB;
constexpr size_t SZ_WEIN = (size_t)NE_IN * 1024 * 2;
constexpr size_t WS_WEOUT = WS_WEIN + 2 * SZ_WEIN;
constexpr size_t SZ_WSQ = (size_t)1024 * 1024 * 2;
constexpr size_t WS_WMIN = WS_WEOUT + 2 * SZ_WSQ;
constexpr size_t SZ_WMIN = (size_t)NM_IN * 1024 * 2;
constexpr size_t WS_WUQ = WS_WMIN + 2 * SZ_WMIN;
constexpr size_t SZ_WUQ = (size_t)1536 * 768 * 2;
constexpr size_t WS_WUKV = WS_WUQ + 2 * SZ_WUQ;
constexpr size_t SZ_WUKV = (size_t)2048 * 256 * 2;
constexpr size_t WS_WMOUT = WS_WUKV + 2 * SZ_WUKV;
constexpr size_t WS_WPQ = WS_WMOUT + 2 * SZ_WSQ;
constexpr size_t SZ_WPQ = (size_t)2048 * 1024 * 2;
constexpr size_t WS_SUBK = WS_WPQ + 4 * SZ_WPQ;
constexpr size_t SZ_SUBK = (size_t)16 * 128 * 128 * 2;
constexpr size_t WS_U16 = WS_SUBK + 4 * SZ_SUBK;
constexpr size_t SZ_TAB = (size_t)NEXP * 1024;
constexpr size_t WS_V16 = WS_U16 + 4 * SZ_TAB;
constexpr size_t WS_X = WS_V16 + 4 * SZ_TAB;
constexpr size_t WS_H = WS_X + 128 * MiB;
constexpr size_t WS_O = WS_H + 64 * MiB;
constexpr size_t WS_P = WS_O + 64 * MiB;
constexpr size_t WS_P_CIN = WS_P;
constexpr size_t WS_P_QM = WS_P + 80 * MiB;
constexpr size_t WS_P_KN = WS_P + 176 * MiB;
constexpr size_t WS_VT = WS_P + 240 * MiB;
constexpr size_t WS_MASK = WS_VT + 64 * MiB;
constexpr size_t WS_IW = WS_MASK + 8 * MiB;
constexpr size_t WS_RSTD = WS_IW + 1 * MiB;
constexpr size_t WS_RE = WS_RSTD + 1 * MiB;
constexpr size_t WS_RG = WS_RE + 16 * MiB;
constexpr size_t WS_PSF = WS_RG + 16 * MiB;
constexpr size_t WS_END = WS_PSF + 2 * MiB;

struct Params {
    const float* x; const int* pos; const float* attn_norm; const float* ffn_norm; const float* final_norm;
    const float* hyb_w_in; const float* hyb_w_out; const float* mla_w_in; const float* mla_q_norm; const float* mla_kv_norm;
    const float* mla_w_uq; const float* mla_w_ukv; const float* mla_w_out; const float* peer_w_q; const float* peer_sub_keys;
    const float* peer_u; const float* peer_v;
    float* out; unsigned char* ws;
    int ph_lo, ph_hi;
};

DI unsigned pk_bf16(float lo, float hi) { f32x2 v = {lo, hi}; bf2_t b = __builtin_convertvector(v, bf2_t); return __builtin_bit_cast(unsigned, b); }
DI bf16_t f2bf(float x) { return (bf16_t)(pk_bf16(x, 0.f) & 0xffffu); }
DI float bf_lo(unsigned u) { return __uint_as_float(u << 16); }
DI float bf_hi(unsigned u) { return __uint_as_float(u & 0xffff0000u); }
DI float wave_sum(float v) {
#pragma unroll
    for (int o = 32; o > 0; o >>= 1) v += __shfl_xor(v, o, 64);
    return v;
}
DI f32x16 mfma32(bf16x8 a, bf16x8 b, f32x16 c) { return __builtin_amdgcn_mfma_f32_32x32x16_bf16(a, b, c, 0, 0, 0); }
DI f32x16 zero16() { f32x16 z;
#pragma unroll
    for (int i = 0; i < 16; ++i) z[i] = 0.f; return z; }

#define XB_TMO      128
#define XB_XCNT(j)  (256  + 64 * (j))
#define XB_XSUB(j)  (1280 + 64 * (j))
#define XB_XGEN(j)  (2304 + 64 * (j))
#define XB_TOP      3328
#define XB_TOPGEN   3392
#define XCD_BAR_WORDS 3456
#define XB_SPIN_CAP (1u << 25)

DI unsigned xb_ld(unsigned* p)              { return __hip_atomic_load(p, __ATOMIC_RELAXED, __HIP_MEMORY_SCOPE_AGENT); }
DI unsigned xb_add(unsigned* p, unsigned v) { return __hip_atomic_fetch_add(p, v, __ATOMIC_RELAXED, __HIP_MEMORY_SCOPE_AGENT); }
DI unsigned xb_xcc_id() { return (unsigned)__builtin_amdgcn_s_getreg((3 << 11) | 20) & 0xFu; }
#define XB_SPIN(cond, bar) do { unsigned _sp = 0; while (cond) { __builtin_amdgcn_s_sleep(1); \
    if ((++_sp & 255u) == 0u) { if (xb_ld(&(bar)[XB_TMO])) break; if (_sp > XB_SPIN_CAP) { atomicAdd(&(bar)[XB_TMO], 1u); break; } } } } while (0)

struct XcdBarrier { unsigned* bar; unsigned x; volatile LAS unsigned* st; };

DI XcdBarrier xcd_barrier_post(unsigned* bar, volatile LAS unsigned* st) {
    XcdBarrier b; b.bar = bar; b.x = xb_xcc_id(); b.st = st;
    if (threadIdx.x == 0) (void)xb_add(&bar[XB_XCNT(b.x)], 1u);
    return b;
}
DI void xcd_barrier_complete(unsigned* bar, unsigned x, unsigned& nloc, unsigned& nx) {
    const unsigned G = gridDim.x * gridDim.y * gridDim.z;
    unsigned sum, cnt, mine, sp = 0u;
    for (;;) {
        sum = 0u; cnt = 0u; mine = 0u;
#pragma unroll
        for (unsigned j = 0; j < 16; ++j) { const unsigned c = xb_ld(&bar[XB_XCNT(j)]); sum += c; cnt += (c > 0u) ? 1u : 0u; mine = (j == x) ? c : mine; }
        if (sum == G) break;
        __builtin_amdgcn_s_sleep(1);
        if ((++sp & 255u) == 0u) { if (xb_ld(&bar[XB_TMO])) break; if (sp > XB_SPIN_CAP) { atomicAdd(&bar[XB_TMO], 1u); break; } }
    }
    nloc = mine > 0u ? mine : 1u; nx = cnt > 0u ? cnt : 1u;
}
DI void xcd_barrier(const XcdBarrier& b) {
    asm volatile("s_waitcnt vmcnt(0)" ::: "memory");
    __syncthreads();
    if (threadIdx.x == 0) {
        unsigned* bar = b.bar;
        __builtin_amdgcn_s_waitcnt(0);
        unsigned nloc = b.st[0], nx = b.st[1];
        if (nloc == 0u) { xcd_barrier_complete(bar, b.x, nloc, nx); b.st[0] = nloc; b.st[1] = nx; }
        const unsigned old = xb_add(&bar[XB_XSUB(b.x)], 1u);
        const unsigned gen = old / nloc;
        if (old + 1u == (gen + 1u) * nloc) {
            __builtin_amdgcn_fence(__ATOMIC_RELEASE, "agent");
            asm volatile("s_waitcnt vmcnt(0)" ::: "memory");
            const unsigned og = xb_add(&bar[XB_TOP], 1u);
            const unsigned tg = og / nx;
            if (og + 1u == (tg + 1u) * nx) xb_add(&bar[XB_TOPGEN], 1u);
            else XB_SPIN(xb_ld(&bar[XB_TOPGEN]) == tg, bar);
            __builtin_amdgcn_fence(__ATOMIC_ACQUIRE, "agent");
            xb_add(&bar[XB_XGEN(b.x)], 1u);
            asm volatile("s_waitcnt vmcnt(0)" ::: "memory");
        } else {
            XB_SPIN(xb_ld(&bar[XB_XGEN(b.x)]) == gen, bar);
            __builtin_amdgcn_fence(__ATOMIC_ACQUIRE, "agent");
            asm volatile("s_waitcnt vmcnt(0)" ::: "memory");
        }
    }
    __syncthreads();
}

DI int perm32(int rho) { return 8 * ((rho & 15) >> 2) + 4 * (rho >> 4) + (rho & 3); }
template <int MODE> DI int src_col(int np, int N) {
    if (MODE == 0) return np < N ? np : -1;
    if (MODE == 2) { const int c = (np & ~31) + perm32(np & 31); return c < N ? c : -1; }
    if (MODE == 3) { const int c = (np < 1024) ? (np & ~31) + perm32(np & 31) : np; return c < N ? c : -1; }
    if (MODE == 4) { const int c = (((np >> 5) % 3) == 2) ? np : (np & ~31) + perm32(np & 31); return c < N ? c : -1; }
    if (MODE == 5) { const int c = ((np >> 6) & 1) ? np : (np & ~31) + perm32(np & 31); return c < N ? c : -1; }
    const int tile = np >> 8, loc = np & 255, bj = loc >> 7, wc = (loc >> 5) & 3, n = (loc >> 4) & 1, ip = loc & 15;
    const int nat = tile * 256 + wc * 64 + bj * 32 + 8 * (ip >> 2) + 4 * n + (ip & 3);
    if (nat < 1216) return nat;
    if (nat < 2752) return nat + 8;
    if (nat < 2760) return nat - 2752 + 1216;
    return -1;
}
template <int MODE> DI void prep_wt(const float* W, int K, int N, bf16_t* WT, int Npad, const float* kscale, int& toff, int bid, int nblk, int tid) {
    const int tx = tid & 63, w = __builtin_amdgcn_readfirstlane(tid >> 6);
    const int ntn = Npad / 256, ntk = K / 16, nw = nblk * 8;
    int t = (bid * 8 + w - toff) % nw; if (t < 0) t += nw;
    toff = (toff + ntn * ntk) % nw;
    for (; t < ntn * ntk; t += nw) {
        const int n0 = (t % ntn) * 256 + 4 * tx, k0 = (t / ntn) * 16;
        const int sn = src_col<MODE>(n0, N);
        const float keep = (sn >= 0) ? 1.f : 0.f;
        const float* src = W + (size_t)k0 * N + (sn >= 0 ? sn : 0);
        f32x4 v[16];
#pragma unroll
        for (int kk = 0; kk < 16; ++kk) v[kk] = *(const f32x4*)(src + (size_t)kk * N);
#pragma unroll
        for (int kk = 0; kk < 16; ++kk) v[kk] *= (kscale ? kscale[k0 + kk] : 1.f) * keep;
#pragma unroll
        for (int r = 0; r < 4; ++r) {
            bf16_t* dst = WT + (size_t)(n0 + r) * K + k0;
#pragma unroll
            for (int h = 0; h < 2; ++h) {
                u32x4 o;
#pragma unroll
                for (int q = 0; q < 4; ++q) o[q] = pk_bf16(v[8 * h + 2 * q][r], v[8 * h + 2 * q + 1][r]);
                *(u32x4*)(dst + 8 * h) = o;
            }
        }
    }
}
DI void cvt_bf16(const float* src, bf16_t* dst, size_t n, int bid, int nblk, int tid) {
    const size_t n8 = n / 8;
    for (size_t i = (size_t)bid * NTHR + tid; i < n8; i += (size_t)nblk * NTHR) {
        const f32x4 a = *(const f32x4*)(src + i * 8), b = *(const f32x4*)(src + i * 8 + 4);
        u32x4 o; o[0] = pk_bf16(a[0], a[1]); o[1] = pk_bf16(a[2], a[3]); o[2] = pk_bf16(b[0], b[1]); o[3] = pk_bf16(b[2], b[3]);
        *(u32x4*)(dst + i * 8) = o;
    }
}
DI void cvt_fp8(const float* src, unsigned char* dst, size_t n, float scale, const float* colscale  , int bid, int nblk, int tid) {
    const size_t n16 = n / 16;
    for (size_t i = (size_t)bid * NTHR + tid; i < n16; i += (size_t)nblk * NTHR) {
        u32x4 o;
#pragma unroll
        for (int q = 0; q < 4; ++q) {
            f32x4 a = *(const f32x4*)(src + i * 16 + q * 4) * scale;
            if (colscale) a *= *(const f32x4*)(colscale + (i / ((size_t)NEXP * 64)) * 1024 + (i & 63) * 16 + q * 4);
            int w = 0;
            w = __builtin_amdgcn_cvt_pk_fp8_f32(a[0], a[1], w, false);
            w = __builtin_amdgcn_cvt_pk_fp8_f32(a[2], a[3], w, true);
            o[q] = (unsigned)w;
        }
        const size_t lay = i / ((size_t)NEXP * 64), rem = i % ((size_t)NEXP * 64), e = rem >> 6, ch = rem & 63;
        *(u32x4*)(dst + lay * ((size_t)NEXP * 1024) + (ch >> 3) * ((size_t)NEXP * 128) + e * 128 + (ch & 7) * 16) = o;
    }
}
DI void rope_tables(const int* pos, float* c64, float* s64, float* c32, float* s32, int bid, int nblk, int tid) {
    for (int i = bid * NTHR + tid; i < T_ * 48; i += nblk * NTHR) {
        const int t = i / 48, j = i % 48;
        const float p = (float)pos[t];
        const int k = (j < 32) ? j : j - 32;
        const float inv = exp2f(-(float)(2 * k) * ((j < 32) ? (13.287712379549449f / 64.0f) : (13.287712379549449f / 32.0f)));
        float sv, cv; sincosf(p * inv, &sv, &cv);
        if (j < 32) { c64[t * 32 + k] = cv; s64[t * 32 + k] = sv; } else { c32[t * 16 + k] = cv; s32[t * 16 + k] = sv; }
    }
}

DI void rmsnorm_rows(const float* x, const float* g, bf16_t* outb, float* outf, int bid, int nblk, int tid) {
    const int lane = tid & 63, w = tid >> 6;
    f32x4 gv[4];
#pragma unroll
    for (int i = 0; i < 4; ++i) gv[i] = *(const f32x4*)(g + i * 256 + lane * 4);
    for (int row = bid * 8 + w; row < T_; row += nblk * 8) {
        const float* xr = x + (size_t)row * 1024;
        f32x4 v[4]; float ss = 0.f;
#pragma unroll
        for (int i = 0; i < 4; ++i) { v[i] = *(const f32x4*)(xr + i * 256 + lane * 4); ss += v[i][0] * v[i][0] + v[i][1] * v[i][1] + v[i][2] * v[i][2] + v[i][3] * v[i][3]; }
        ss = wave_sum(ss);
        const float rs = 1.0f / sqrtf(ss * (1.0f / 1024.0f) + 1e-6f);
#pragma unroll
        for (int i = 0; i < 4; ++i) {
            const f32x4 y = v[i] * rs * gv[i];
            if (outb) { u32x2 o; o[0] = pk_bf16(y[0], y[1]); o[1] = pk_bf16(y[2], y[3]); *(u32x2*)(outb + (size_t)row * 1024 + i * 256 + lane * 4) = o; }
            else *(f32x4*)(outf + (size_t)row * 1024 + i * 256 + lane * 4) = y;
        }
    }
}
DI void x_to_stream(const float* x, bf16_t* xb, float* psa, int bid, int nblk, int tid) {
    const int lane = tid & 63, w = tid >> 6;
    for (int row = bid * 8 + w; row < T_; row += nblk * 8) {
        const float* xr = x + (size_t)row * 1024 + lane * 16;
        f32x4 v[4]; float ss = 0.f;
#pragma unroll
        for (int i = 0; i < 4; ++i) { v[i] = *(const f32x4*)(xr + i * 4); ss += (v[i][0] * v[i][0] + v[i][1] * v[i][1]) + (v[i][2] * v[i][2] + v[i][3] * v[i][3]); }
        ss += __shfl_xor(ss, 1, 64); ss += __shfl_xor(ss, 2, 64); ss += __shfl_xor(ss, 4, 64);
        u32x4 o0, o1;
        o0[0] = pk_bf16(v[0][0], v[0][1]); o0[1] = pk_bf16(v[0][2], v[0][3]); o0[2] = pk_bf16(v[1][0], v[1][1]); o0[3] = pk_bf16(v[1][2], v[1][3]);
        o1[0] = pk_bf16(v[2][0], v[2][1]); o1[1] = pk_bf16(v[2][2], v[2][3]); o1[2] = pk_bf16(v[3][0], v[3][1]); o1[3] = pk_bf16(v[3][2], v[3][3]);
        bf16_t* dst = xb + (size_t)row * 1024 + lane * 16;
        *(u32x4*)dst = o0; *(u32x4*)(dst + 8) = o1;
        if ((lane & 7) == 0) psa[(size_t)row * 8 + (lane >> 3)] = ss;
    }
}
DI void final_norm_rows(const bf16_t* xb, const float* g, float* out, int bid, int nblk, int tid) {
    const int lane = tid & 63, w = tid >> 6;
    f32x4 gv[4];
#pragma unroll
    for (int i = 0; i < 4; ++i) gv[i] = *(const f32x4*)(g + lane * 16 + i * 4);
    for (int row0 = bid * 8 + w; row0 < T_; row0 += nblk * 16) {
        const int row1 = row0 + nblk * 8;
        const bool two = row1 < T_;
        u32x4 a[2], b[2];
#pragma unroll
        for (int h = 0; h < 2; ++h) { const bf16_t* xr = xb + (size_t)((h && two) ? row1 : row0) * 1024 + lane * 16; a[h] = *(const u32x4*)xr; b[h] = *(const u32x4*)(xr + 8); }
#pragma unroll
        for (int h = 0; h < 2; ++h) {
            if (h == 1 && !two) continue;
            f32x4 v[4];
#pragma unroll
            for (int q = 0; q < 2; ++q) { v[0][2 * q] = bf_lo(a[h][q]); v[0][2 * q + 1] = bf_hi(a[h][q]); v[1][2 * q] = bf_lo(a[h][2 + q]); v[1][2 * q + 1] = bf_hi(a[h][2 + q]);
                                          v[2][2 * q] = bf_lo(b[h][q]); v[2][2 * q + 1] = bf_hi(b[h][q]); v[3][2 * q] = bf_lo(b[h][2 + q]); v[3][2 * q + 1] = bf_hi(b[h][2 + q]); }
            float ss = 0.f;
#pragma unroll
            for (int i = 0; i < 4; ++i) ss += (v[i][0] * v[i][0] + v[i][1] * v[i][1]) + (v[i][2] * v[i][2] + v[i][3] * v[i][3]);
            ss = wave_sum(ss);
            const float rs = 1.0f / sqrtf(ss * (1.0f / 1024.0f) + 1e-6f);
            float* op = out + (size_t)(h ? row1 : row0) * 1024 + lane * 16;
#pragma unroll
            for (int i = 0; i < 4; ++i) *(f32x4*)(op + i * 4) = v[i] * rs * gv[i];
        }
    }
}
DI void mla_stats(const bf16_t* cin, float* rstd, int bid, int nblk, int tid) {
    const int lane = tid & 63, w = tid >> 6;
    for (int row = bid * 8 + w; row < T_; row += nblk * 8) {
        const bf16_t* r = cin + (size_t)row * NM_IN;
        const u32x4 a = *(const u32x4*)(r + lane * 8), b = *(const u32x4*)(r + 512 + lane * 8);
        float sa = 0.f, sb = 0.f;
#pragma unroll
        for (int i = 0; i < 4; ++i) { float lo = bf_lo(a[i]), hi = bf_hi(a[i]); sa += lo * lo + hi * hi; lo = bf_lo(b[i]); hi = bf_hi(b[i]); sb += lo * lo + hi * hi; }
        float sq = sa + (lane < 32 ? sb : 0.f), skv = (lane < 32 ? 0.f : sb);
        sq = wave_sum(sq); skv = wave_sum(skv);
        if (lane == 0) { rstd[row * 2] = 1.0f / sqrtf(sq * (1.0f / 768.0f) + 1e-6f); rstd[row * 2 + 1] = 1.0f / sqrtf(skv * (1.0f / 256.0f) + 1e-6f); }
    }
}

DI void gm_st_bf4(bf16_t* p, f32x4 v) { u32x2 o; o[0] = pk_bf16(v[0], v[1]); o[1] = pk_bf16(v[2], v[3]); *(u32x2*)p = o; }
DI void mla_krope_units(const bf16_t* xb, const bf16_t* wkr  , const float* psa, const float* c32, const float* s32, bf16_t* cin, int bid, int nblk, int tid) {
    const int w = __builtin_amdgcn_readfirstlane(tid >> 6), lane = tid & 63, r = lane & 31, hf = lane >> 5;
    for (int u = bid + w * nblk; u < T_ / 32; u += 8 * nblk) {
        const int t = u * 32 + r;
        const bf16_t* xp = xb + (size_t)t * 1024 + hf * 8;
        const bf16_t* wp = wkr + (size_t)r * 1024 + hf * 8;
        f32x16 acc = zero16(), acc2 = zero16();
#pragma unroll 1
        for (int k8 = 0; k8 < 8; ++k8) {
            bf16x8 xa[8], wa[8];
#pragma unroll
            for (int ks = 0; ks < 8; ++ks) { xa[ks] = *(const bf16x8*)(xp + (k8 * 8 + ks) * 16); wa[ks] = *(const bf16x8*)(wp + (k8 * 8 + ks) * 16); }
#pragma unroll
            for (int ks = 0; ks < 8; ++ks) { if (ks & 1) acc2 = mfma32(wa[ks], xa[ks], acc2); else acc = mfma32(wa[ks], xa[ks], acc); }
        }
        const f32x4 p0 = *(const f32x4*)(psa + (size_t)t * 8), p1 = *(const f32x4*)(psa + (size_t)t * 8 + 4);
        const float rs = 1.0f / sqrtf((((p0[0] + p0[1]) + (p0[2] + p0[3])) + ((p1[0] + p1[1]) + (p1[2] + p1[3]))) * (1.0f / 1024.0f) + 1e-6f);
#pragma unroll
        for (int q = 0; q < 2; ++q) {
            const int c0 = 8 * q + 4 * hf;
            const f32x4 cs = *(const f32x4*)(c32 + (size_t)t * 16 + c0), sn = *(const f32x4*)(s32 + (size_t)t * 16 + c0);
            f32x4 a, b;
#pragma unroll
            for (int jj = 0; jj < 4; ++jj) { a[jj] = (acc[4 * q + jj] + acc2[4 * q + jj]) * rs; b[jj] = (acc[8 + 4 * q + jj] + acc2[8 + 4 * q + jj]) * rs; }
            bf16_t* dst = cin + (size_t)t * NM_IN + 1024 + c0;
            gm_st_bf4(dst, a * cs - b * sn); gm_st_bf4(dst + 16, a * sn + b * cs);
        }
    }
}

namespace gm {
constexpr int BM = 256, BK = 64, HALF = 128, NXCD = 8, WGM = 8, HT = HALF * BK;
DI int lds_byte(int r, int c) { int st = (r >> 4) * 2 + (c >> 5), rr = r & 15, cc = c & 31, ob = rr * 64 + cc * 2; return st * 1024 + (ob ^ (((ob >> 9) & 1) << 5)); }
DI void stage_rc(int b, int& R, int& C) { int st = b / 1024, sb = b % 1024, swz = sb ^ (((sb >> 9) & 1) << 5); R = (st >> 1) * 16 + swz / 64; C = (st & 1) * 32 + (swz % 64) / 2; }

template <class Epi>
DI void gemm_phase(const bf16_t* A, int lda, const bf16_t* Bt, int M, int N, int K, const Epi& epi, unsigned char* ldsraw, int bid, int nblk) {
    bf16_t* shm = (bf16_t*)ldsraw;
#define SA(b, h) (shm + ((b) * 2 + (h)) * HT)
#define SB(b, h) (shm + (4 + (b) * 2 + (h)) * HT)
#define STAGE_X(T, P, BASE, LD, br, kt) do { long _g = (long)(br) * (LD) + (long)(kt) * BK; \
    for (int _i = 0; _i < 2; ++_i) { int _b = (T) * 16 + _i * 8192; int _r, _c; stage_rc(_b, _r, _c); \
      __builtin_amdgcn_global_load_lds((const unsigned*)((BASE) + _g + (long)_r * (LD) + _c), \
        (unsigned*)((char*)(P) + _b), 16, 0, 0); } } while (0)
#define STAGE_A(P, br, kt) STAGE_X(tv, P, A, lda, br, kt)
#define STAGE_B(P, br, kt) STAGE_X(tv, P, Bt, K, br, kt)
#define LDA(dst, b, h) for (int m = 0; m < 4; ++m) for (int k = 0; k < 2; ++k) \
    dst[m][k] = *reinterpret_cast<const bf16x8*>((char*)SA(b, h) + lds_byte(wr * 64 + m * 16 + fr, k * 32 + fq * 8))
#define LDB(dst, b, h) for (int n = 0; n < 2; ++n) for (int k = 0; k < 2; ++k) \
    dst[n][k] = *reinterpret_cast<const bf16x8*>((char*)SB(b, h) + lds_byte(wc * 32 + n * 16 + fr, k * 32 + fq * 8))
#define MMA(ai, bj, At_, Bt_) do { __builtin_amdgcn_s_setprio(1); \
    for (int m = 0; m < 4; ++m) for (int n = 0; n < 2; ++n) for (int k = 0; k < 2; ++k) \
      acc[ai][bj][m][n] = __builtin_amdgcn_mfma_f32_16x16x32_bf16(Bt_[n][k], At_[m][k], acc[ai][bj][m][n], 0, 0, 0); \
    __builtin_amdgcn_s_setprio(0); } while (0)
#define WAIT_V(n) asm volatile("s_waitcnt vmcnt(" #n ")" ::: "memory")
#define WAIT_L(n) asm volatile("s_waitcnt lgkmcnt(" #n ")" ::: "memory")
#define BAR __builtin_amdgcn_s_barrier()
#define SCHED __builtin_amdgcn_sched_barrier(0)
    const int nM = M / BM, nN = N / BM, nwg = nM * nN, nt = K / BK;
    for (int it = 0;; ++it) {
        const long L = (long)it * nblk + bid;
        if (L >= nwg) break;
        int wgid = (int)L;
        { int q = nwg / NXCD, r = nwg % NXCD, xcd = wgid % NXCD, off = wgid / NXCD; wgid = (xcd < r ? xcd * (q + 1) : r * (q + 1) + (xcd - r) * q) + off; }
        const int nig = WGM * nN, gid = wgid / nig, fm = gid * WGM, gsz = min(nM - fm, WGM);
        const int pm = fm + ((wgid % nig) % gsz), pn = (wgid % nig) / gsz, brow = pm * BM, bcol = pn * BM;
        int tv = threadIdx.x; asm volatile("" : "+v"(tv));
        int wid = tv >> 6, lane = tv & 63, wr = wid >> 2, wc = wid & 3, fr = lane & 15, fq = lane >> 4;
        f32x4 acc[2][2][4][2] = {};
        bf16x8 At[4][2], B0[2][2], B1[2][2];
        f32x4 q0 = {0.f, 0.f, 0.f, 0.f}, q1 = {0.f, 0.f, 0.f, 0.f};
        if (epi.psa && tv < 256) {
            const float* pp = epi.psa + ((size_t)brow + tv) * Epi::PS_STRIDE + Epi::PS_FIRST;
            q0 = *(const f32x4*)pp;
            if (Epi::PS_COUNT >= 8) q1 = *(const f32x4*)(pp + 4);
            if (Epi::PS_COUNT >= 12) q0 += *(const f32x4*)(pp + 8);
            if (Epi::PS_COUNT >= 16) q1 += *(const f32x4*)(pp + 12);
        }
        STAGE_B(SB(0, 0), bcol, 0); STAGE_A(SA(0, 0), brow, 0);
        STAGE_B(SB(0, 1), bcol + HALF, 0); STAGE_A(SA(0, 1), brow + HALF, 0);
        if (wr == 1) BAR;
        WAIT_V(4); BAR;
        STAGE_B(SB(1, 0), bcol, 1); STAGE_A(SA(1, 0), brow, 1); STAGE_B(SB(1, 1), bcol + HALF, 1);
        WAIT_V(6); BAR;
        if (epi.psa && tv < 256)
            *(LAS float*)((LAS unsigned char*)ldsraw + 131072 + (it & 1) * 1024 + tv * 4) = 1.0f / sqrtf((((q0[0] + q0[1]) + (q0[2] + q0[3])) + ((q1[0] + q1[1]) + (q1[2] + q1[3]))) * (1.0f / (float)Epi::PS_DIV) + 1e-6f);
        for (int t = 0; t < nt - 2; t += 2) {
            LDB(B0, 0, 0); SCHED; LDA(At, 0, 0); STAGE_A(SA(1, 1), brow + HALF, t + 1);
            WAIT_L(8); BAR; WAIT_L(0); MMA(0, 0, At, B0); BAR; SCHED;
            LDB(B1, 0, 1); STAGE_B(SB(0, 0), bcol, t + 2);
            BAR; WAIT_L(0); MMA(0, 1, At, B1); BAR;
            LDA(At, 0, 1); STAGE_A(SA(0, 0), brow, t + 2);
            BAR; WAIT_L(0); MMA(1, 0, At, B0); BAR; SCHED;
            STAGE_B(SB(0, 1), bcol + HALF, t + 2);
            WAIT_V(6); BAR; MMA(1, 1, At, B1); BAR;
            LDB(B0, 1, 0); SCHED; LDA(At, 1, 0); STAGE_A(SA(0, 1), brow + HALF, t + 2);
            WAIT_L(8); BAR; WAIT_L(0); MMA(0, 0, At, B0); BAR; SCHED;
            LDB(B1, 1, 1); STAGE_B(SB(1, 0), bcol, t + 3);
            BAR; WAIT_L(0); MMA(0, 1, At, B1); BAR;
            LDA(At, 1, 1); STAGE_A(SA(1, 0), brow, t + 3);
            BAR; WAIT_L(0); MMA(1, 0, At, B0); BAR; SCHED;
            STAGE_B(SB(1, 1), bcol + HALF, t + 3);
            WAIT_V(6); BAR; MMA(1, 1, At, B1); BAR;
        }
        int tz = threadIdx.x; asm volatile("" : "+v"(tz)); wid = tz >> 6; lane = tz & 63; wr = wid >> 2; wc = wid & 3; fr = lane & 15; fq = lane >> 4;
        { LDB(B0, 0, 0); WAIT_V(0); LDA(At, 0, 0); STAGE_X(tz, SA(1, 1), A, lda, brow + HALF, nt - 1);
          BAR; WAIT_L(0); MMA(0, 0, At, B0); BAR;
          LDB(B1, 0, 1); BAR; WAIT_L(0); MMA(0, 1, At, B1); BAR;
          LDA(At, 0, 1); WAIT_V(4); BAR; WAIT_L(0); MMA(1, 0, At, B0); MMA(1, 1, At, B1); BAR; }
        { LDB(B0, 1, 0); LDA(At, 1, 0); WAIT_V(2); BAR; WAIT_L(0); MMA(0, 0, At, B0); BAR;
          LDB(B1, 1, 1); WAIT_V(0); BAR; WAIT_L(0); MMA(0, 1, At, B1); BAR;
          LDA(At, 1, 1); BAR; WAIT_L(0); MMA(1, 0, At, B0); MMA(1, 1, At, B1); BAR; }
        if (wr == 0) BAR;
        { int ty = threadIdx.x; asm volatile("" : "+v"(ty)); const int wid2 = ty >> 6, lane2 = ty & 63;
          if (epi.psa) {
#pragma unroll
              for (int ai = 0; ai < 2; ++ai)
#pragma unroll
                  for (int m = 0; m < 4; ++m) {
                      const float rs = *(const LAS float*)((LAS unsigned char*)ldsraw + 131072 + (it & 1) * 1024 + (ai * 128 + (wid2 >> 2) * 64 + m * 16 + (lane2 & 15)) * 4);
#pragma unroll
                      for (int bj = 0; bj < 2; ++bj)
#pragma unroll
                          for (int n = 0; n < 2; ++n) acc[ai][bj][m][n] *= rs;
                  }
          }
          epi(acc, pm, pn, wid2 >> 2, wid2 & 3, lane2 & 15, lane2 >> 4); }
    }
#undef SA
#undef SB
#undef STAGE_X
#undef STAGE_A
#undef STAGE_B
#undef LDA
#undef LDB
#undef MMA
#undef WAIT_V
#undef WAIT_L
#undef BAR
#undef SCHED
}

DI void st_bf4(bf16_t* p, f32x4 v) { u32x2 o; o[0] = pk_bf16(v[0], v[1]); o[1] = pk_bf16(v[2], v[3]); *(u32x2*)p = o; }
DI void st_bf8(bf16_t* p, f32x4 a, f32x4 b) { u32x4 o; o[0] = pk_bf16(a[0], a[1]); o[1] = pk_bf16(a[2], a[3]); o[2] = pk_bf16(b[0], b[1]); o[3] = pk_bf16(b[2], b[3]); *(u32x4*)p = o; }

struct EpiEvenIn {
    static constexpr int PS_STRIDE = 8, PS_FIRST = 0, PS_COUNT = 8, PS_DIV = 1024;
    bf16_t* proj; bf16_t* vaT; bf16_t* vbT; float* iw; const float* c64; const float* s64; const float* psa;
    DI void operator()(const f32x4 (&acc)[2][2][4][2], int pm, int pn, int wr, int wc, int fr, int fq) const {
        const float qscale = 0.125f * LOG2E;
        const int g = pn * 4 + wc, d0 = 8 * fq;
        const int kind = (g < 8 || (g >= 19 && g < 27)) ? 0 : (g == 9) ? 2 : (g >= 35 && g < 43) ? 3 : (g == 43) ? 4 : (g > 43) ? 5 : 1;
#pragma unroll
        for (int ai = 0; ai < 2; ++ai)
#pragma unroll
            for (int m = 0; m < 4; ++m) {
                const int t = pm * 256 + ai * 128 + wr * 64 + m * 16 + fr;
                if (kind <= 1) {
                    f32x4 y0[2], y1[2];
#pragma unroll
                    for (int n = 0; n < 2; ++n) {
                        const f32x4 c = *(const f32x4*)(c64 + (size_t)t * 32 + d0 + 4 * n), sn = *(const f32x4*)(s64 + (size_t)t * 32 + d0 + 4 * n);
                        const f32x4 v0 = acc[ai][0][m][n], v1 = acc[ai][1][m][n];
                        y0[n] = v0 * c - v1 * sn; y1[n] = v0 * sn + v1 * c;
                        if (kind == 0) { y0[n] *= qscale; y1[n] *= qscale; }
                    }
                    bf16_t* dst = proj + (size_t)t * NE_IN + g * 64 + d0;
                    st_bf8(dst, y0[0], y0[1]); st_bf8(dst + 32, y1[0], y1[1]);
                } else if (kind == 2 || kind == 3) {
                    bf16_t* dst = proj + (size_t)t * NE_IN + g * 64 + d0;
                    st_bf8(dst, acc[ai][0][m][0], acc[ai][0][m][1]); st_bf8(dst + 32, acc[ai][1][m][0], acc[ai][1][m][1]);
                } else if (kind == 4) {
                    if (fq == 0) { *(f32x4*)(iw + (size_t)t * 8) = acc[ai][0][m][0]; *(f32x4*)(iw + (size_t)t * 8 + 4) = acc[ai][0][m][1]; }
                }
            }
    }
};
struct EpiMlaIn {
    static constexpr int PS_STRIDE = 8, PS_FIRST = 0, PS_COUNT = 8, PS_DIV = 1024;
    bf16_t* cin; const float* c32; const float* s32; float* ps; const float* psa;
    DI void operator()(const f32x4 (&acc)[2][2][4][2], int pm, int pn, int wr, int wc, int fr, int fq) const {
        if (pn < 4) {
#pragma unroll
            for (int ai = 0; ai < 2; ++ai)
#pragma unroll
                for (int m = 0; m < 4; ++m) {
                    float ss = 0.f;
#pragma unroll
                    for (int bj = 0; bj < 2; ++bj)
#pragma unroll
                        for (int n = 0; n < 2; ++n) { const f32x4 a = acc[ai][bj][m][n]; ss += a[0] * a[0] + a[1] * a[1] + a[2] * a[2] + a[3] * a[3]; }
                    ss += __shfl_xor(ss, 16, 64); ss += __shfl_xor(ss, 32, 64);
                    const int t = pm * 256 + ai * 128 + wr * 64 + m * 16 + fr;
                    if (fq == 0) ps[(size_t)t * 16 + pn * 4 + wc] = ss;
                }
        }
#pragma unroll
        for (int bj = 0; bj < 2; ++bj) {
            const int colbase = pn * 256 + bj * 128 + wc * 32;
            if (colbase > 1024) continue;
#pragma unroll
            for (int ai = 0; ai < 2; ++ai)
#pragma unroll
                for (int m = 0; m < 4; ++m) {
                    const int t = pm * 256 + ai * 128 + wr * 64 + m * 16 + fr;
                    if (colbase == 1024) {
                        const f32x4 c = *(const f32x4*)(c32 + (size_t)t * 16 + 4 * fq), sn = *(const f32x4*)(s32 + (size_t)t * 16 + 4 * fq);
                        const f32x4 a = acc[ai][bj][m][0], b = acc[ai][bj][m][1];
                        bf16_t* dst = cin + (size_t)t * NM_IN + colbase + 4 * fq;
                        st_bf4(dst, a * c - b * sn); st_bf4(dst + 16, a * sn + b * c);
                    } else st_bf8(cin + (size_t)t * NM_IN + colbase + 8 * fq, acc[ai][bj][m][0], acc[ai][bj][m][1]);
                }
        }
    }
};
struct EpiQup {
    static constexpr int PS_STRIDE = 16, PS_FIRST = 0, PS_COUNT = 12, PS_DIV = 768;
    bf16_t* qm; const float* rstd; const float* c32; const float* s32; const float* psa;
    DI void operator()(const f32x4 (&acc)[2][2][4][2], int pm, int pn, int wr, int wc, int fr, int fq) const {
        const float qscale = 0.10206207261596575f * LOG2E;
#pragma unroll
        for (int bj = 0; bj < 2; ++bj) {
            const int colbase = pn * 256 + bj * 128 + wc * 32;
            const bool rope = ((colbase >> 5) % 3) == 2;
#pragma unroll
            for (int ai = 0; ai < 2; ++ai)
#pragma unroll
                for (int m = 0; m < 4; ++m) {
                    const int t = pm * 256 + ai * 128 + wr * 64 + m * 16 + fr;
                    const float rs = qscale;
                    const f32x4 a = acc[ai][bj][m][0] * rs, b = acc[ai][bj][m][1] * rs;
                    if (rope) {
                        const f32x4 c = *(const f32x4*)(c32 + (size_t)t * 16 + 4 * fq), sn = *(const f32x4*)(s32 + (size_t)t * 16 + 4 * fq);
                        bf16_t* dst = qm + (size_t)t * 1536 + colbase + 4 * fq;
                        st_bf4(dst, a * c - b * sn); st_bf4(dst + 16, a * sn + b * c);
                    } else st_bf8(qm + (size_t)t * 1536 + colbase + 8 * fq, a, b);
                }
        }
    }
};
struct EpiKVup {
    static constexpr int PS_STRIDE = 16, PS_FIRST = 12, PS_COUNT = 4, PS_DIV = 256;
    bf16_t* kn; bf16_t* vn; const float* rstd; const float* psa;
    DI void operator()(const f32x4 (&acc)[2][2][4][2], int pm, int pn, int wr, int wc, int fr, int fq) const {
#pragma unroll
        for (int bj = 0; bj < 2; ++bj) {
            const int colbase = pn * 256 + bj * 128 + wc * 32;
            const int g = colbase >> 6, h = g >> 1, within = colbase & 63;
            const long dv = vn - kn;
            bf16_t* const dstb = kn + ((g & 1) ? dv : 0L) + h * 64 + within + 8 * fq;
#pragma unroll
            for (int ai = 0; ai < 2; ++ai)
#pragma unroll
                for (int m = 0; m < 4; ++m) {
                    const int t = pm * 256 + ai * 128 + wr * 64 + m * 16 + fr;
                    st_bf8(dstb + (size_t)t * 1024, acc[ai][bj][m][0], acc[ai][bj][m][1]);
                }
        }
    }
};
struct EpiResid {
    static constexpr int PS_STRIDE = 8, PS_FIRST = 0, PS_COUNT = 8, PS_DIV = 1024;
    bf16_t* xb; float* ps; const float* psa;
    DI void operator()(const f32x4 (&acc)[2][2][4][2], int pm, int pn, int wr, int wc, int fr, int fq) const {
#pragma unroll
        for (int ai = 0; ai < 2; ++ai)
#pragma unroll
            for (int m = 0; m < 4; ++m) {
                const size_t t = pm * 256 + ai * 128 + wr * 64 + m * 16 + fr;
                float ss = 0.f;
#pragma unroll
                for (int bj = 0; bj < 2; ++bj) {
                    bf16_t* px = xb + t * 1024 + pn * 256 + bj * 128 + wc * 32 + 8 * fq;
                    const u32x4 xo = *(const u32x4*)px;
                    const f32x4 a0 = acc[ai][bj][m][0], a1 = acc[ai][bj][m][1];
                    const f32x4 y0 = {bf_lo(xo[0]) + a0[0], bf_hi(xo[0]) + a0[1], bf_lo(xo[1]) + a0[2], bf_hi(xo[1]) + a0[3]};
                    const f32x4 y1 = {bf_lo(xo[2]) + a1[0], bf_hi(xo[2]) + a1[1], bf_lo(xo[3]) + a1[2], bf_hi(xo[3]) + a1[3]};
                    st_bf8(px, y0, y1);
                    ss += (y0[0] * y0[0] + y0[1] * y0[1]) + (y0[2] * y0[2] + y0[3] * y0[3]) + (y1[0] * y1[0] + y1[1] * y1[1]) + (y1[2] * y1[2] + y1[3] * y1[3]);
                }
                ss += __shfl_xor(ss, 16, 64); ss += __shfl_xor(ss, 32, 64);
                if (fq == 0) ps[t * 16 + pn * 4 + wc] = ss;
            }
    }
};
struct EpiBf16 {
    static constexpr int PS_STRIDE = 16, PS_FIRST = 0, PS_COUNT = 16, PS_DIV = 1024;
    bf16_t* out; int ld; const float* psa;
    DI void operator()(const f32x4 (&acc)[2][2][4][2], int pm, int pn, int wr, int wc, int fr, int fq) const {
#pragma unroll
        for (int ai = 0; ai < 2; ++ai)
#pragma unroll
            for (int m = 0; m < 4; ++m) {
                const size_t t = pm * 256 + ai * 128 + wr * 64 + m * 16 + fr;
#pragma unroll
                for (int bj = 0; bj < 2; ++bj) st_bf8(out + t * ld + pn * 256 + bj * 128 + wc * 32 + 8 * fq, acc[ai][bj][m][0], acc[ai][bj][m][1]);
            }
    }
};
}

namespace at {
constexpr int KT = 128, VROW = KT * 2 + 16;
template <int MODE> struct Cfg { static constexpr int DQK = (MODE == 0) ? 96 : 64, NKS = DQK / 16, KROW = DQK * 2 + 16, NCH = DQK / 8, NKL = KT * NCH / 512, KBYTES = KT * KROW, BUFSZ = KBYTES + 64 * VROW; };
struct Args { const bf16_t* q; const bf16_t* k; const bf16_t* k2; const bf16_t* vT; const unsigned* mask; bf16_t* o; };

template <int MODE>
DI void attn_unit(const Args& a, int b, int h, int qt, unsigned char* lds, int tid) {
    constexpr int DQK = Cfg<MODE>::DQK, NKS = Cfg<MODE>::NKS, KROW = Cfg<MODE>::KROW, NCH = Cfg<MODE>::NCH, NKL = Cfg<MODE>::NKL, KBYTES = Cfg<MODE>::KBYTES, BUFSZ = Cfg<MODE>::BUFSZ;
    const int w = __builtin_amdgcn_readfirstlane(tid >> 6), lane = tid & 63, r = lane & 31, hf = lane >> 5;
    int tq, qpos, wmin, wlast, nt;
    const bf16_t* qptr; bf16_t* optr;
    if (MODE == 2) {
        const int qloc = w * 4 + (r >> 3), head = r & 7;
        qpos = qt * 32 + qloc; tq = b * S_ + qpos; wmin = qt * 32 + w * 4; wlast = (qt * 32 + w * 4 + 3) >> 7; nt = ((qt * 32 + 31) >> 7) + 1;
        qptr = a.q + (size_t)tq * NE_IN + C_QA + head * 64; optr = a.o + (size_t)tq * 1024 + head * 64;
    } else {
        qpos = qt * 256 + w * 32 + r; tq = b * S_ + qpos; wmin = qt * 256 + w * 32; wlast = 2 * qt + (w >> 2); nt = 2 * (qt + 1);
        if (MODE == 0) { qptr = a.q + (size_t)tq * 1536 + h * 96; optr = a.o + (size_t)tq * 1024 + h * 64; }
        else { qptr = a.q + (size_t)tq * NE_IN + C_QB + h * 64; optr = a.o + (size_t)tq * 1024 + 512 + h * 64; }
    }
    bf16x8 qf[NKS];
#pragma unroll
    for (int ks = 0; ks < NKS; ++ks) qf[ks] = *(const bf16x8*)(qptr + ks * 16 + hf * 8);

    const bf16_t* kp[NKL]; size_t kstep[NKL]; int kdst[NKL];
#pragma unroll
    for (int j = 0; j < NKL; ++j) {
        const int idx = tid + 512 * j, kr = idx / NCH, kc = idx % NCH;
        kdst[j] = kr * KROW + kc * 16;
        if (MODE == 0) {
            if (kc < 8) { kp[j] = a.k + (size_t)(b * S_ + kr) * 1024 + h * 64 + kc * 8; kstep[j] = (size_t)KT * 1024; }
            else { kp[j] = a.k2 + (size_t)(b * S_ + kr) * NM_IN + 1024 + (kc - 8) * 8; kstep[j] = (size_t)KT * NM_IN; }
        } else { kp[j] = a.k + (size_t)(b * S_ + kr) * NE_IN + (MODE == 1 ? C_KB + h * 64 : C_KA) + kc * 8; kstep[j] = (size_t)KT * NE_IN; }
    }
    const bf16_t* vp[2]; int vdst[2];
#pragma unroll
    for (int j = 0; j < 2; ++j) {
        const int idx = tid + 512 * j, vd = idx >> 4, vc = idx & 15;
        vp[j] = a.vT + ((size_t)((MODE == 0) ? (b * 16 + h) : (MODE == 1) ? (b * 8 + h) : b) * 64 + vd) * S_ + vc * 8;
        vdst[j] = KBYTES + vd * VROW + (vc >> 1) * 32 + (vc & 1) * 8;
    }
    const unsigned* mp = (MODE == 2) ? a.mask + (size_t)tq * 64 : nullptr;

    unsigned blkmask = 0xffu;
    if (MODE == 1) {
        const int own = qt;
        float* kmw = (float*)(lds + 2 * BUFSZ); float* km = kmw + 7 * 8 * 64;
        {
            const int kc = lane & 7, kg = tid >> 3;
            const bf16_t* kb = a.k + (size_t)(b * S_ + kg * 4) * NE_IN + C_KB + h * 64 + kc * 8;
            u32x4 kv[7][4];
#pragma unroll
            for (int n = 0; n < 7; ++n) if (n < own) {
#pragma unroll
                for (int kk = 0; kk < 4; ++kk) kv[n][kk] = *(const u32x4*)(kb + (size_t)(n * 256 + kk) * NE_IN);
            }
#pragma unroll
            for (int n = 0; n < 7; ++n) if (n < own) {
                float sa[8];
#pragma unroll
                for (int e = 0; e < 8; ++e) sa[e] = 0.f;
#pragma unroll
                for (int kk = 0; kk < 4; ++kk)
#pragma unroll
                    for (int q = 0; q < 4; ++q) { sa[2 * q] += bf_lo(kv[n][kk][q]); sa[2 * q + 1] += bf_hi(kv[n][kk][q]); }
#pragma unroll
                for (int e = 0; e < 8; ++e) { sa[e] += __shfl_xor(sa[e], 8, 64); sa[e] += __shfl_xor(sa[e], 16, 64); sa[e] += __shfl_xor(sa[e], 32, 64); }
                if (lane < 8) { float* dst = kmw + (n * 8 + w) * 64 + kc * 8; *(f32x4*)dst = (f32x4){sa[0], sa[1], sa[2], sa[3]}; *(f32x4*)(dst + 4) = (f32x4){sa[4], sa[5], sa[6], sa[7]}; }
            }
        }
        __syncthreads();
        if (tid < own * 64) { const int n = tid >> 6, d = tid & 63; float sacc = 0.f;
#pragma unroll
            for (int ww = 0; ww < 8; ++ww) sacc += kmw[(n * 8 + ww) * 64 + d];
            km[n * 64 + d] = sacc * (1.0f / 256.0f); }
        __syncthreads();
        float gt[7];
#pragma unroll
        for (int n = 0; n < 7; ++n) {
            float g = 0.f;
            if (n < own) {
#pragma unroll
                for (int ks = 0; ks < NKS; ++ks)
#pragma unroll
                    for (int j = 0; j < 8; ++j) g += __uint_as_float((unsigned)(unsigned short)qf[ks][j] << 16) * km[n * 64 + ks * 16 + hf * 8 + j];
                g += __shfl_xor(g, 32, 64);
            }
            gt[n] = g;
        }
        blkmask = 1u << own;
#pragma unroll
        for (int n = 0; n < 7; ++n) {
            int rank = 0;
#pragma unroll
            for (int n2 = 0; n2 < 7; ++n2) if (n2 != n) rank += (n2 < own && (gt[n2] > gt[n] || (gt[n2] == gt[n] && n2 < n))) ? 1 : 0;
            if (n < own && rank < 3) blkmask |= 1u << n;
        }
    }

    u32x4 kreg[NKL], vreg[2]; u32x4 mw = {0u, 0u, 0u, 0u}, mwn = {0u, 0u, 0u, 0u};
#pragma unroll
    for (int j = 0; j < NKL; ++j) kreg[j] = *(const u32x4*)kp[j];
#pragma unroll
    for (int j = 0; j < 2; ++j) vreg[j] = *(const u32x4*)vp[j];
    if (MODE == 2) mw = *(const u32x4*)mp;
#pragma unroll
    for (int j = 0; j < NKL; ++j) *(u32x4*)(lds + kdst[j]) = kreg[j];
#pragma unroll
    for (int j = 0; j < 2; ++j) { *(u32x2*)(lds + vdst[j]) = (u32x2){vreg[j][0], vreg[j][1]}; *(u32x2*)(lds + vdst[j] + 16) = (u32x2){vreg[j][2], vreg[j][3]}; }
    __syncthreads();

    float m = NEG_INF, lsum = 0.f;
    f32x16 o0 = zero16(), o1 = zero16();
    if (w >= 4) __builtin_amdgcn_s_setprio(1);
    for (int i = 0; i < nt; ++i) {
        const bool more = (i + 1 < nt);
        if (more) {
#pragma unroll
            for (int j = 0; j < NKL; ++j) { kp[j] += kstep[j]; kreg[j] = *(const u32x4*)kp[j]; }
#pragma unroll
            for (int j = 0; j < 2; ++j) { vp[j] += KT; vreg[j] = *(const u32x4*)vp[j]; }
            if (MODE == 2) mwn = *(const u32x4*)(mp + 4 * (i + 1));
        }
        const unsigned char* Kb = lds + (i & 1) * BUFSZ; const unsigned char* Vb = Kb + KBYTES;
        bool active = (i <= wlast);
        if (MODE == 1) active = active && (__ballot((blkmask >> (i >> 1)) & 1u) != 0ull);
        if (active) {
            f32x16 s[4];
#pragma unroll
            for (int mt = 0; mt < 4; ++mt) {
                s[mt] = zero16();
#pragma unroll
                for (int ks = 0; ks < NKS; ++ks) s[mt] = mfma32(*(const bf16x8*)(Kb + (mt * 32 + r) * KROW + ks * 32 + hf * 16), qf[ks], s[mt]);
            }
            if (MODE == 2) {
#pragma unroll
                for (int mt = 0; mt < 4; ++mt) { const unsigned wd = mw[mt] >> (4 * hf);
#pragma unroll
                    for (int e = 0; e < 16; ++e) { const int bit = (e & 3) + 8 * (e >> 2); s[mt][e] = ((wd >> bit) & 1u) ? s[mt][e] : NEG_INF; } }
            } else {
                if (MODE == 1) { const bool allowed = (blkmask >> (i >> 1)) & 1u;
                    if (!allowed) {
#pragma unroll
                        for (int mt = 0; mt < 4; ++mt)
#pragma unroll
                            for (int e = 0; e < 16; ++e) s[mt][e] = NEG_INF; } }
                if (i * KT + KT - 1 > wmin) {
#pragma unroll
                    for (int mt = 0; mt < 4; ++mt) { const int kb0 = i * KT + mt * 32 + 4 * hf;
#pragma unroll
                        for (int e = 0; e < 16; ++e) { const int key = kb0 + (e & 3) + 8 * (e >> 2); s[mt][e] = (key <= qpos) ? s[mt][e] : NEG_INF; } }
                }
            }
            float mx4[4];
#pragma unroll
            for (int mt = 0; mt < 4; ++mt) { mx4[mt] = s[mt][0];
#pragma unroll
                for (int e = 1; e < 16; ++e) mx4[mt] = fmaxf(mx4[mt], s[mt][e]); }
            float mx = fmaxf(fmaxf(mx4[0], mx4[1]), fmaxf(mx4[2], mx4[3]));
            mx = fmaxf(mx, __shfl_xor(mx, 32, 64));
            const float mnew = fmaxf(m, mx), muse = (mnew == NEG_INF) ? 0.f : mnew;
            const float alpha = __builtin_amdgcn_exp2f(m - muse);
            float rs4[4];
#pragma unroll
            for (int mt = 0; mt < 4; ++mt) { rs4[mt] = 0.f;
#pragma unroll
                for (int e = 0; e < 16; ++e) { s[mt][e] = __builtin_amdgcn_exp2f(s[mt][e] - muse); rs4[mt] += s[mt][e]; } }
            lsum = lsum * alpha + ((rs4[0] + rs4[1]) + (rs4[2] + rs4[3])); m = mnew;
#pragma unroll
            for (int e = 0; e < 16; ++e) { o0[e] *= alpha; o1[e] *= alpha; }
#pragma unroll
            for (int mt = 0; mt < 4; ++mt)
#pragma unroll
                for (int sp = 0; sp < 2; ++sp) {
                    u32x4 pp;
#pragma unroll
                    for (int j = 0; j < 4; ++j) pp[j] = pk_bf16(s[mt][8 * sp + 2 * j], s[mt][8 * sp + 2 * j + 1]);
                    const bf16x8 pb = __builtin_bit_cast(bf16x8, pp);
                    const int koff = (mt * 32 + 16 * sp) * 2 + hf * 16;
                    o0 = mfma32(*(const bf16x8*)(Vb + r * VROW + koff), pb, o0);
                    o1 = mfma32(*(const bf16x8*)(Vb + (32 + r) * VROW + koff), pb, o1);
                }
        }
        if (more) {
            unsigned char* Nb = lds + ((i + 1) & 1) * BUFSZ;
#pragma unroll
            for (int j = 0; j < NKL; ++j) *(u32x4*)(Nb + kdst[j]) = kreg[j];
#pragma unroll
            for (int j = 0; j < 2; ++j) { *(u32x2*)(Nb + vdst[j]) = (u32x2){vreg[j][0], vreg[j][1]}; *(u32x2*)(Nb + vdst[j] + 16) = (u32x2){vreg[j][2], vreg[j][3]}; }
            if (MODE == 2) mw = mwn;
        }
        __syncthreads();
    }
    __builtin_amdgcn_s_setprio(0);
    const float ltot = lsum + __shfl_xor(lsum, 32, 64);
    float inv = 1.0f / ltot;
    if ((DBG_SKIP >> (MODE == 2 ? 1 : MODE == 1 ? 2 : 3)) & 1) inv = 0.f;
#pragma unroll
    for (int g4 = 0; g4 < 4; ++g4) {
        f32x4 v0 = {o0[4 * g4] * inv, o0[4 * g4 + 1] * inv, o0[4 * g4 + 2] * inv, o0[4 * g4 + 3] * inv};
        f32x4 v1 = {o1[4 * g4] * inv, o1[4 * g4 + 1] * inv, o1[4 * g4 + 2] * inv, o1[4 * g4 + 3] * inv};
        gm::st_bf4(optr + 8 * g4 + 4 * hf, v0); gm::st_bf4(optr + 32 + 8 * g4 + 4 * hf, v1);
    }
}
}

namespace ab {
typedef bf16_t bf16;
constexpr int SEQ=S_,D=64,DM=NE_IN,OM=1024;
constexpr int NW=8,QBLK=32,QB=QBLK*NW,KVBLK=64;
__device__ __forceinline__ int crow(int r,int hi){return (r&3)+8*(r>>2)+4*hi;}
#define SBAR() __builtin_amdgcn_sched_barrier(0)
__device__ __forceinline__ void cmask(f32x16&p0,f32x16&p1,int jb,int qrel,int hi){
  const float NEG=-INFINITY; int kb=64*jb+4*hi;
  #pragma unroll
  for(int r=0;r<16;++r){int kv=kb+(r&3)+8*(r>>2); if(kv>qrel)p0[r]=NEG; if(kv+32>qrel)p1[r]=NEG;}
}

constexpr int NSLOT=3, SLOTB=8192;
constexpr int LDS_K=0, LDS_V=NSLOT*SLOTB, LDS_WS=2*NSLOT*SLOTB, LDS_OST=LDS_WS+NW*64*4, LDS_BYTES=LDS_OST+NW*4096;
constexpr float C2=0.125f*1.4426950408889634f;
__device__ __forceinline__ void glds16(const void*gsrc,unsigned lds_dst){unsigned keep;
  asm volatile("s_mov_b32 %0, m0\n\ts_mov_b32 m0, %2\n\ts_nop 0\n\tglobal_load_lds_dwordx4 %1, off\n\ts_mov_b32 m0, %0":"=&s"(keep):"v"(gsrc),"s"(lds_dst):"memory");}
__device__ __forceinline__ float max3f(float a,float b,float c){float r;asm("v_max3_f32 %0, %1, %2, %3":"=v"(r):"v"(a),"v"(b),"v"(c));return r;}
__device__ __forceinline__ float max2f(float a,float b){float r;asm("v_max_f32_e32 %0, %1, %2":"=v"(r):"v"(a),"v"(b));return r;}
__device__ __forceinline__ float fadd_s(float a,float b){float r;asm("v_add_f32_e32 %0, %1, %2":"=v"(r):"v"(a),"v"(b));return r;}
__device__ __forceinline__ float fsub_s(float a,float b){float r;asm("v_sub_f32_e32 %0, %1, %2":"=v"(r):"v"(a),"v"(b));return r;}
typedef float f32x2_t __attribute__((ext_vector_type(2))); typedef __bf16 bf16x2_t __attribute__((ext_vector_type(2)));
__device__ __forceinline__ unsigned cvtpk_s(float lo,float hi){f32x2_t v={lo,hi};bf16x2_t b=__builtin_convertvector(v,bf16x2_t);return __builtin_bit_cast(unsigned,b);}
#define WAIT_BAR(N) asm volatile("s_waitcnt vmcnt(" #N ") lgkmcnt(0)\n\ts_barrier":::"memory")

__device__ __forceinline__ void qkt(f32x16&p0,f32x16&p1,const char*Kslot,const bf16x8*qr,const f32x16&negm,int r32,int hi){
  const char*kb=Kslot+hi*1024+r32*16;
  #pragma unroll
  for(int d0=0;d0<4;++d0){
    const bf16x8 b0=*reinterpret_cast<const bf16x8*>(kb+d0*2048);
    const bf16x8 b1=*reinterpret_cast<const bf16x8*>(kb+d0*2048+512);
    if(d0==0){p0=__builtin_amdgcn_mfma_f32_32x32x16_bf16(b0,qr[0],negm,0,0,0);p1=__builtin_amdgcn_mfma_f32_32x32x16_bf16(b1,qr[0],negm,0,0,0);}
    else{p0=__builtin_amdgcn_mfma_f32_32x32x16_bf16(b0,qr[d0],p0,0,0,0);p1=__builtin_amdgcn_mfma_f32_32x32x16_bf16(b1,qr[d0],p1,0,0,0);}}
}
typedef __attribute__((address_space(3))) const char* lds_cptr;
typedef short v4i16_t __attribute__((ext_vector_type(4)));
__device__ __forceinline__ void kload8(bf16x8*kf,lds_cptr kp){
  kf[0]=*(const __attribute__((address_space(3))) bf16x8*)(kp);      kf[1]=*(const __attribute__((address_space(3))) bf16x8*)(kp+512);
  kf[2]=*(const __attribute__((address_space(3))) bf16x8*)(kp+2048); kf[3]=*(const __attribute__((address_space(3))) bf16x8*)(kp+2560);
  kf[4]=*(const __attribute__((address_space(3))) bf16x8*)(kp+4096); kf[5]=*(const __attribute__((address_space(3))) bf16x8*)(kp+4608);
  kf[6]=*(const __attribute__((address_space(3))) bf16x8*)(kp+6144); kf[7]=*(const __attribute__((address_space(3))) bf16x8*)(kp+6656);
}
__device__ __forceinline__ void kload2(bf16x8*kf,lds_cptr kp,int j){ kf[2*j]=*(const __attribute__((address_space(3))) bf16x8*)(kp+j*2048); kf[2*j+1]=*(const __attribute__((address_space(3))) bf16x8*)(kp+j*2048+512); }
__device__ __forceinline__ s16x4 vtr(lds_cptr p){ return __builtin_bit_cast(s16x4,__builtin_amdgcn_ds_read_tr16_b64_v4i16((__attribute__((address_space(3))) v4i16_t*)p)); }
__device__ __forceinline__ float rowmax(const f32x16&p0,const f32x16&p1){
  float a=max3f(p0[0],p0[1],p1[0]),b=max3f(p0[2],p0[3],p1[1]);a=max3f(a,p1[2],p1[3]);
  #pragma unroll
  for(int r=4;r<16;r+=4){a=max3f(a,p0[r],p0[r+1]);b=max3f(b,p0[r+2],p0[r+3]);a=max3f(a,p1[r],p1[r+1]);b=max3f(b,p1[r+2],p1[r+3]);}
  const float m=max2f(a,b);
  auto rr=__builtin_amdgcn_permlane32_swap(__float_as_uint(m),__float_as_uint(m),false,false);
  return max2f(__uint_as_float(rr[0]),__uint_as_float(rr[1]));
}
__device__ __forceinline__ void pv(f32x16*o,int vb,bf16x8 pa0,bf16x8 pa1,bf16x8 pa2,bf16x8 pa3){
  #pragma unroll
  for(int d0=0;d0<2;++d0){s16x4 lo[4],hi[4];
    #pragma unroll
    for(int ks=0;ks<4;++ks){
      asm volatile("ds_read_b64_tr_b16 %0,%1 offset:%c2":"=&v"(lo[ks]):"v"(vb),"i"(d0*4096+ks*1024):"memory");
      asm volatile("ds_read_b64_tr_b16 %0,%1 offset:%c2":"=&v"(hi[ks]):"v"(vb),"i"(d0*4096+ks*1024+512):"memory");}
    asm volatile("s_waitcnt lgkmcnt(0)":::"memory");SBAR();
    #define PK(k) (bf16x8){lo[k][0],lo[k][1],lo[k][2],lo[k][3],hi[k][0],hi[k][1],hi[k][2],hi[k][3]}
    o[d0]=__builtin_amdgcn_mfma_f32_32x32x16_bf16(pa0,PK(0),o[d0],0,0,0);
    o[d0]=__builtin_amdgcn_mfma_f32_32x32x16_bf16(pa1,PK(1),o[d0],0,0,0);
    o[d0]=__builtin_amdgcn_mfma_f32_32x32x16_bf16(pa2,PK(2),o[d0],0,0,0);
    o[d0]=__builtin_amdgcn_mfma_f32_32x32x16_bf16(pa3,PK(3),o[d0],0,0,0);
    #undef PK
  }
}

constexpr int LDS_KM=LDS_BYTES;
__device__ __forceinline__ void moba_kmean(int b,int h,int nmax,const bf16*__restrict__ K,char*shm,int tid){
  const int lane=tid&63,wid=__builtin_amdgcn_readfirstlane(tid>>6);
  float*km=(float*)(shm+LDS_KM); float*kmw=km+7*64;
  const bf16*Kh=K+(long)b*SEQ*DM+h*D;
  { const int kc=lane&7,kg=tid>>3;
    const bf16*kb=Kh+(long)(kg*4)*DM+kc*8;
    u32x4 kv[7][4];
    #pragma unroll
    for(int n=0;n<7;++n) if(n<nmax){
      #pragma unroll
      for(int kk=0;kk<4;++kk)kv[n][kk]=*(const u32x4*)(kb+(long)(n*256+kk)*DM); }
    #pragma unroll
    for(int n=0;n<7;++n) if(n<nmax){ float sa[8];
      #pragma unroll
      for(int e=0;e<8;++e)sa[e]=0.f;
      #pragma unroll
      for(int kk=0;kk<4;++kk)
        #pragma unroll
        for(int q=0;q<4;++q){sa[2*q]+=bf_lo(kv[n][kk][q]);sa[2*q+1]+=bf_hi(kv[n][kk][q]);}
      #pragma unroll
      for(int e=0;e<8;++e){sa[e]+=__shfl_xor(sa[e],8,64);sa[e]+=__shfl_xor(sa[e],16,64);sa[e]+=__shfl_xor(sa[e],32,64);}
      if(lane<8){float*dst=kmw+(n*8+wid)*64+kc*8;*(f32x4*)dst=(f32x4){sa[0],sa[1],sa[2],sa[3]};*(f32x4*)(dst+4)=(f32x4){sa[4],sa[5],sa[6],sa[7]};} } }
  __syncthreads();
  if(tid<nmax*64){const int n=tid>>6,d=tid&63;float sacc=0.f;
    #pragma unroll
    for(int ww=0;ww<8;++ww)sacc+=kmw[(n*8+ww)*64+d];
    km[n*64+d]=sacc*(1.0f/256.0f);}
  __syncthreads();
}
#ifndef ATTN_STORE16
#define ATTN_STORE16(p,v) (*(u32x4*)(p)=(v))
#endif
template<int THRL,int MODE> __device__ __forceinline__ void attn_unit(int b,int h,int qb,const bf16*Q,const bf16*__restrict__ K,const bf16*__restrict__ V,bf16*O,const unsigned*msk,char*shm,int tid){
  const int lane=tid&63,r32=lane&31,hi=lane>>5; const int wid=__builtin_amdgcn_readfirstlane(tid>>6);
  const long rowbase=(long)b*SEQ; const int q0=(MODE==2)?qb*32:qb*QB;
  const bf16*Qrow=(MODE==2)?Q+(rowbase+q0+wid*4+(r32>>3))*DM+(r32&7)*D:Q+(rowbase+q0+wid*QBLK+r32)*DM+h*D;
  const bf16*Kh=K+rowbase*DM+((MODE==2)?0:h*D),*Vh=V+rowbase*DM+((MODE==2)?0:h*D);
  const unsigned lds0=(unsigned)(uintptr_t)shm;
  float*wsf=(float*)(shm+LDS_WS)+wid*64;
  const bf16*ksrc=Kh+(long)lane*DM+wid*8;
  const bf16*vsrc=Vh+(long)(16*(wid&3)+(lane>>2))*DM+(wid>>2)*32+(lane&3)*8;
  const unsigned kdst=lds0+LDS_K+wid*1024, vdst=lds0+LDS_V+wid*1024;
  #define DMA_K(t,slot) glds16(ksrc+(long)(t)*KVBLK*DM,(unsigned)__builtin_amdgcn_readfirstlane(kdst+(slot)))
  #define DMA_V(t,slot) glds16(vsrc+(long)(t)*KVBLK*DM,(unsigned)__builtin_amdgcn_readfirstlane(vdst+(slot)))
  const int vb0=(int)(lds0+LDS_V)+((lane>>4)&1)*32+(lane&3)*8+(4*hi+((lane&15)>>2))*64;
  const char*Kbase=shm+LDS_K; bf16x8 kf[8];
  const lds_cptr shm3=(lds_cptr)shm; const lds_cptr kp0=shm3+LDS_K+hi*1024+r32*16; const lds_cptr vp0=shm3+LDS_V+((lane>>4)&1)*32+(lane&3)*8+(4*hi+((lane&15)>>2))*64;
  const int NTr=(MODE==2)?((q0+31)>>6)+1:(q0+QB)/KVBLK; const int NT=(MODE==2)?((NTr<4)?4:((NTr+1)&~1)):NTr;
  bf16x8 qr[4];
  #pragma unroll
  for(int d0=0;d0<4;++d0)qr[d0]=*reinterpret_cast<const bf16x8*>(&Qrow[d0*16+hi*8]);
  unsigned blkmask=0xffffffffu;
  if(MODE==2){
    const u32x4 mv=*(const u32x4*)(msk+(size_t)(rowbase+q0+(tid>>4))*64+(tid&15)*4);
    *(u32x4*)(shm+LDS_OST+tid*16)=mv;
    __syncthreads();
  }
  if(MODE==1){
    const int own=qb;
    const float*km=(const float*)(shm+LDS_KM);
    float gt[7];
    #pragma unroll
    for(int n=0;n<7;++n){float g=0.f;
      if(n<own){
        #pragma unroll
        for(int ks=0;ks<4;++ks)
          #pragma unroll
          for(int j=0;j<8;++j)g+=__uint_as_float((unsigned)(unsigned short)qr[ks][j]<<16)*km[n*64+ks*16+hi*8+j];
        g+=__shfl_xor(g,32,64);}
      gt[n]=g;}
    blkmask=1u<<own;
    #pragma unroll
    for(int n=0;n<7;++n){int rank=0;
      #pragma unroll
      for(int n2=0;n2<7;++n2)if(n2!=n)rank+=(n2<own&&(gt[n2]>gt[n]||(gt[n2]==gt[n]&&n2<n)))?1:0;
      if(n<own&&rank<3)blkmask|=1u<<n;}
  }
  DMA_K(0,0);DMA_V(0,0);DMA_K(1,SLOTB);
  float mhat=0.f,l_reg=0.f;f32x16 o[2];o[0]=f32x16{};o[1]=f32x16{};f32x16 negm=f32x16{};asm volatile("":"+v"(negm));
  const int qrel=wid*QBLK+r32;
  const unsigned*mrow=(const unsigned*)(shm+LDS_OST)+(wid*4+(r32>>3))*64;
  #define BMASK(P0,P1,t) do{ const u32x2 mw_=*(const u32x2*)(mrow+2*(t)); const unsigned w0_=mw_[0]>>(4*hi),w1_=mw_[1]>>(4*hi); \
      _Pragma("unroll") for(int r_=0;r_<16;++r_){ const int bit_=(r_&3)+8*(r_>>2); P0[r_]=((w0_>>bit_)&1u)?P0[r_]:-INFINITY; P1[r_]=((w1_>>bit_)&1u)?P1[r_]:-INFINITY; } }while(0)
  #define GMASK(P0,P1,t) do{ if(MODE==2){BMASK(P0,P1,t);} else if(!((blkmask>>((t)>>2))&1u)){ _Pragma("unroll") for(int r_=0;r_<16;++r_){P0[r_]=-INFINITY;P1[r_]=-INFINITY;} } }while(0)
  #define CMASK(P0,P1,t) do{int jb_=(t)-(NT-4); if(MODE==1&&jb_>=0)cmask(P0,P1,jb_,qrel,hi); GMASK(P0,P1,t);}while(0)
  bool resc=false;
  #define START(P0,P1) do{ const float rm=rowmax(P0,P1); resc=false; \
    { const float dl=(rm==-INFINITY)?0.f:rm; mhat=fadd_s(mhat,dl); \
      _Pragma("unroll") for(int r=0;r<16;++r){P0[r]=fsub_s(P0[r],dl);P1[r]=fsub_s(P1[r],dl);} \
      _Pragma("unroll") for(int r=0;r<16;++r)negm[r]=-mhat; asm volatile("":"+v"(negm)); } \
    _Pragma("unroll") for(int r=0;r<16;++r)P0[r]=__builtin_amdgcn_exp2f(P0[r]); }while(0)
  #define RESC() do{ if(resc){ asm volatile("s_waitcnt lgkmcnt(0)":::"memory"); \
      _Pragma("unroll") for(int d_=0;d_<2;++d_) _Pragma("unroll") for(int r=0;r<16;++r)o[d_][r]*=wsf[crow(r,hi)]; } }while(0)
  f32x16 pA0,pA1,pB0,pB1;
  int sl_prev=0,sl_cur=0,sl_next=SLOTB;
  #define ROT() do{sl_prev=sl_cur;sl_cur=sl_next;sl_next=(sl_next==(NSLOT-1)*SLOTB)?0:sl_next+SLOTB;}while(0)
  DMA_K(2,2*SLOTB);
  WAIT_BAR(3);
  qkt(pA0,pA1,Kbase,qr,negm,r32,hi);asm volatile("s_nop 15\n\ts_nop 7":"+v"(pA0),"+v"(pA1));CMASK(pA0,pA1,0);
  START(pA0,pA1);
  _Pragma("unroll") for(int r=0;r<16;++r)pA1[r]=__builtin_amdgcn_exp2f(pA1[r]);
  WAIT_BAR(0);
  DMA_K(3,0);DMA_V(1,SLOTB);
  ROT();
  kload8(kf,kp0+sl_cur);
  WAIT_BAR(2);
  s16x4 vlo[8],vhi[8]; u32x4 pw0,pw1,pw2,pw3;
  #define PKW(P,B) cvtpk_s(P[B],P[B+1])
  #define PAF(k) __builtin_bit_cast(bf16x8,pw##k)
  #define VFR(i) (bf16x8){vlo[i][0],vlo[i][1],vlo[i][2],vlo[i][3],vhi[i][0],vhi[i][1],vhi[i][2],vhi[i][3]}
  #define PIN(x) asm volatile("":"+v"(x))
  #define MX3(a,b,c) __builtin_fmaxf(__builtin_fmaxf((a),(b)),(c))
  #define GAPA(MF,A0,A1,A2,A3,W0,W1,PW) do{ MF; sacc+=A0; sacc+=A1; sacc+=A2; sacc+=A3; PIN(sacc); W0; W1; PIN(PW); SBAR(); }while(0)
  #define EX(v) __builtin_amdgcn_exp2f(v)
  #define GAPB(MF,X,B) do{ MF; X[B]=EX(X[B]); X[B+1]=EX(X[B+1]); X[B+2]=EX(X[B+2]); X[B+3]=EX(X[B+3]); PIN(X); SBAR(); }while(0)
  #define VRD(i) do{ vlo[i]=vtr(vp_+(((i)>>2)*4096+((i)&3)*1024)); vhi[i]=vtr(vp_+(((i)>>2)*4096+((i)&3)*1024+512)); }while(0)
  #define KRD(G,j) do{ if(G){ kload2(kf,kp0+sl_next,j); SBAR(); } }while(0)
  #define STEP(C0,C1,P0,P1,t,GK,GV,GL) do{ SBAR(); \
    const lds_cptr vp_=vp0+sl_prev; \
    VRD(0); SBAR(); float sacc=(P0[0]+P0[1]); \
    GAPA(C0=__builtin_amdgcn_mfma_f32_32x32x16_bf16(kf[0],qr[0],negm,0,0,0), P0[2],P0[3],P0[4],P0[5],     pw0[0]=PKW(P0,0), pw0[1]=PKW(P0,2), pw0); \
    VRD(4); SBAR(); GAPA(C1=__builtin_amdgcn_mfma_f32_32x32x16_bf16(kf[1],qr[0],negm,0,0,0), P0[6],P0[7],P0[8],P0[9],     pw0[2]=PKW(P0,4), pw0[3]=PKW(P0,6), pw0); \
    VRD(1); SBAR(); GAPA(C0=__builtin_amdgcn_mfma_f32_32x32x16_bf16(kf[2],qr[1],C0,0,0,0),   P0[10],P0[11],P0[12],P0[13], pw1[0]=PKW(P0,8), pw1[1]=PKW(P0,10), pw1); \
    VRD(5); SBAR(); GAPA(C1=__builtin_amdgcn_mfma_f32_32x32x16_bf16(kf[3],qr[1],C1,0,0,0),   P0[14],P0[15],P1[0],P1[1],   pw1[2]=PKW(P0,12),pw1[3]=PKW(P0,14), pw1); \
    VRD(2); SBAR(); GAPA(C0=__builtin_amdgcn_mfma_f32_32x32x16_bf16(kf[4],qr[2],C0,0,0,0),   P1[2],P1[3],P1[4],P1[5],     pw2[0]=PKW(P1,0), pw2[1]=PKW(P1,2), pw2); \
    VRD(6); SBAR(); GAPA(C1=__builtin_amdgcn_mfma_f32_32x32x16_bf16(kf[5],qr[2],C1,0,0,0),   P1[6],P1[7],P1[8],P1[9],     pw2[2]=PKW(P1,4), pw2[3]=PKW(P1,6), pw2); \
    VRD(3); SBAR(); GAPA(C0=__builtin_amdgcn_mfma_f32_32x32x16_bf16(kf[6],qr[3],C0,0,0,0),   P1[10],P1[11],P1[12],P1[13], pw3[0]=PKW(P1,8), pw3[1]=PKW(P1,10), pw3); \
    VRD(7); SBAR(); GAPA(C1=__builtin_amdgcn_mfma_f32_32x32x16_bf16(kf[7],qr[3],C1,0,0,0),   P1[14],P1[15],0.f,0.f,       pw3[2]=PKW(P1,12),pw3[3]=PKW(P1,14), pw3); \
    l_reg+=sacc; \
    if(GK){DMA_K((t)+3,sl_cur);} if(GV){DMA_V((t)+1,sl_next);} \
    CMASK(C0,C1,t); \
    { float a=MX3(C0[0],C0[1],C1[0]),b=MX3(C0[2],C0[3],C1[1]); a=MX3(a,C1[2],C1[3]); \
      _Pragma("unroll") for(int r=4;r<16;r+=4){a=MX3(a,C0[r],C0[r+1]);b=MX3(b,C0[r+2],C0[r+3]);a=MX3(a,C1[r],C1[r+1]);b=MX3(b,C1[r+2],C1[r+3]);} \
      float rm=__builtin_fmaxf(a,b); { auto rr=__builtin_amdgcn_permlane32_swap(__float_as_uint(rm),__float_as_uint(rm),false,false); rm=__builtin_fmaxf(__uint_as_float(rr[0]),__uint_as_float(rr[1])); } \
      resc=false; \
      if(__builtin_expect(__any(rm>(float)THRL),0)){ const float dl=__builtin_fmaxf(rm,0.f); mhat+=dl; \
        _Pragma("unroll") for(int r=0;r<16;++r){C0[r]-=dl;C1[r]-=dl;} \
        _Pragma("unroll") for(int r=0;r<16;++r)negm[r]=-mhat; asm volatile("":"+v"(negm)); \
        const float f=__builtin_amdgcn_exp2f(-dl); l_reg*=f; if(hi==0)wsf[r32]=f; resc=true; } } \
    SBAR(); \
    GAPB(o[0]=__builtin_amdgcn_mfma_f32_32x32x16_bf16(PAF(0),VFR(0),o[0],0,0,0), C0,0); \
    GAPB(o[1]=__builtin_amdgcn_mfma_f32_32x32x16_bf16(PAF(0),VFR(4),o[1],0,0,0), C0,4); \
    KRD(GL,0); GAPB(o[0]=__builtin_amdgcn_mfma_f32_32x32x16_bf16(PAF(1),VFR(1),o[0],0,0,0), C0,8); \
    KRD(GL,1); GAPB(o[1]=__builtin_amdgcn_mfma_f32_32x32x16_bf16(PAF(1),VFR(5),o[1],0,0,0), C0,12); \
    KRD(GL,2); GAPB(o[0]=__builtin_amdgcn_mfma_f32_32x32x16_bf16(PAF(2),VFR(2),o[0],0,0,0), C1,0); \
    KRD(GL,3); GAPB(o[1]=__builtin_amdgcn_mfma_f32_32x32x16_bf16(PAF(2),VFR(6),o[1],0,0,0), C1,4); \
    GAPB(o[0]=__builtin_amdgcn_mfma_f32_32x32x16_bf16(PAF(3),VFR(3),o[0],0,0,0), C1,8); \
    GAPB(o[1]=__builtin_amdgcn_mfma_f32_32x32x16_bf16(PAF(3),VFR(7),o[1],0,0,0), C1,12); \
    }while(0)
  int t=1;
  #undef CMASK
  #define CMASK(P0,P1,t) GMASK(P0,P1,t)
  for(;t+5<NT;t+=2){
    STEP(pB0,pB1,pA0,pA1,t,true,true,true);     WAIT_BAR(2); RESC(); ROT();
    STEP(pA0,pA1,pB0,pB1,t+1,true,true,true);   WAIT_BAR(2); RESC(); ROT();
  }
  #undef CMASK
  #define CMASK(P0,P1,t) do{int jb_=(t)-(NT-4); if(MODE==1&&jb_>=0)cmask(P0,P1,jb_,qrel,hi); GMASK(P0,P1,t);}while(0)
  #define ENDW(tt) do{ if((tt)+3<NT){WAIT_BAR(2);} else if((tt)+2<NT){WAIT_BAR(1);} else {WAIT_BAR(0);} }while(0)
  for(;t+1<NT;t+=2){
    STEP(pB0,pB1,pA0,pA1,t,(t+3<NT),(t+1<NT),(t+1<NT));       ENDW(t);   RESC(); ROT();
    STEP(pA0,pA1,pB0,pB1,t+1,(t+4<NT),(t+2<NT),(t+2<NT));     ENDW(t+1); RESC(); ROT();
  }
  STEP(pB0,pB1,pA0,pA1,NT-1,false,false,false); RESC();
  { float sacc=pB0[0]+pB0[1]; _Pragma("unroll") for(int r=2;r<16;++r)sacc+=pB0[r]; _Pragma("unroll") for(int r=0;r<16;++r)sacc+=pB1[r]; l_reg+=sacc;
    pw0=(u32x4){PKW(pB0,0),PKW(pB0,2),PKW(pB0,4),PKW(pB0,6)};pw1=(u32x4){PKW(pB0,8),PKW(pB0,10),PKW(pB0,12),PKW(pB0,14)};pw2=(u32x4){PKW(pB1,0),PKW(pB1,2),PKW(pB1,4),PKW(pB1,6)};pw3=(u32x4){PKW(pB1,8),PKW(pB1,10),PKW(pB1,12),PKW(pB1,14)};
    SBAR(); pv(o,vb0+sl_cur,PAF(0),PAF(1),PAF(2),PAF(3)); }
  #undef PKW
  #undef PAF
  #undef VFR
  #undef PIN
  #undef MX3
  #undef GAPA
  #undef GAPB
  #undef EX
  #undef VRD
  #undef KRD
  #undef STEP
  #undef ENDW
  {auto rr=__builtin_amdgcn_permlane32_swap(__float_as_uint(l_reg),__float_as_uint(l_reg),false,false);l_reg=__uint_as_float(rr[0])+__uint_as_float(rr[1]);}
  if(hi==0)wsf[32+r32]=l_reg;asm volatile("s_waitcnt lgkmcnt(0)":::"memory");
  float rli[16];
  #pragma unroll
  for(int r=0;r<16;++r)rli[r]=__builtin_amdgcn_rcpf(wsf[32+crow(r,hi)]);
  if(MODE==2){ asm volatile("s_waitcnt lgkmcnt(0)\n\ts_barrier":::"memory"); }
  { bf16*stg=(bf16*)(shm+LDS_OST)+wid*2048;
    #pragma unroll
    for(int r=0;r<16;++r){const int orow=crow(r,hi);
      #pragma unroll
      for(int d0=0;d0<2;++d0)stg[orow*64+d0*32+r32]=f2bf(o[d0][r]*rli[r]);}
    asm volatile("s_waitcnt lgkmcnt(0)":::"memory");
    #pragma unroll
    for(int i=0;i<4;++i){const int row=i*8+(lane>>3),ch=lane&7; const u32x4 v=*(const u32x4*)(stg+row*64+ch*8);
      bf16*op=(MODE==2)?O+(rowbase+q0+wid*4+(row>>3))*OM+(row&7)*D+ch*8:O+(rowbase+q0+wid*QBLK+row)*OM+h*D+ch*8; ATTN_STORE16(op,v);} }
  asm volatile("s_waitcnt lgkmcnt(0)\n\ts_barrier":::"memory");
  #undef DMA_K
  #undef DMA_V
  #undef CMASK
  #undef GMASK
  #undef BMASK
  #undef START
  #undef RESC
  #undef ROT
}
constexpr int ATTN_LDS_BYTES=LDS_BYTES;
#undef SBAR
#undef WAIT_BAR
}

namespace am {
typedef bf16_t bf16;
constexpr int SEQ=S_,D=64;
constexpr int NW=8,QBLK=32,QB=QBLK*NW,KVBLK=64;
__device__ __forceinline__ int crow(int r,int hi){return (r&3)+8*(r>>2)+4*hi;}
#define SBAR() __builtin_amdgcn_sched_barrier(0)
__device__ __forceinline__ void cmask(f32x16&p0,f32x16&p1,int jb,int qrel,int hi){
  const float NEG=-INFINITY; int kb=64*jb+4*hi;
  #pragma unroll
  for(int r=0;r<16;++r){int kv=kb+(r&3)+8*(r>>2); if(kv>qrel)p0[r]=NEG; if(kv+32>qrel)p1[r]=NEG;}
}

constexpr int NSLOT=3, SLOTB=12288;
constexpr int LDS_K=0, LDS_V=NSLOT*SLOTB, LDS_WS=2*NSLOT*SLOTB, LDS_OST=LDS_WS+NW*64*4, LDS_DUMP=LDS_OST+NW*4096, LDS_BYTES=LDS_DUMP+4096;
constexpr float C2=0.10206207261596575f*1.4426950408889634f;
__device__ __forceinline__ void glds16(const void*gsrc,unsigned lds_dst){unsigned keep;
  asm volatile("s_mov_b32 %0, m0\n\ts_mov_b32 m0, %2\n\ts_nop 0\n\tglobal_load_lds_dwordx4 %1, off\n\ts_mov_b32 m0, %0":"=&s"(keep):"v"(gsrc),"s"(lds_dst):"memory");}
__device__ __forceinline__ float max3f(float a,float b,float c){float r;asm("v_max3_f32 %0, %1, %2, %3":"=v"(r):"v"(a),"v"(b),"v"(c));return r;}
__device__ __forceinline__ float max2f(float a,float b){float r;asm("v_max_f32_e32 %0, %1, %2":"=v"(r):"v"(a),"v"(b));return r;}
__device__ __forceinline__ float fadd_s(float a,float b){float r;asm("v_add_f32_e32 %0, %1, %2":"=v"(r):"v"(a),"v"(b));return r;}
__device__ __forceinline__ float fsub_s(float a,float b){float r;asm("v_sub_f32_e32 %0, %1, %2":"=v"(r):"v"(a),"v"(b));return r;}
typedef float f32x2_t __attribute__((ext_vector_type(2))); typedef __bf16 bf16x2_t __attribute__((ext_vector_type(2)));
__device__ __forceinline__ unsigned cvtpk_s(float lo,float hi){f32x2_t v={lo,hi};bf16x2_t b=__builtin_convertvector(v,bf16x2_t);return __builtin_bit_cast(unsigned,b);}
#define WAIT_BAR(N) asm volatile("s_waitcnt vmcnt(" #N ") lgkmcnt(0)\n\ts_barrier":::"memory")

__device__ __forceinline__ void qkt(f32x16&p0,f32x16&p1,const char*Kslot,const bf16x8*qr,const f32x16&negm,int r32,int hi){
  const char*kb=Kslot+hi*1024+r32*16;
  #pragma unroll
  for(int d0=0;d0<6;++d0){
    const bf16x8 b0=*reinterpret_cast<const bf16x8*>(kb+d0*2048);
    const bf16x8 b1=*reinterpret_cast<const bf16x8*>(kb+d0*2048+512);
    if(d0==0){p0=__builtin_amdgcn_mfma_f32_32x32x16_bf16(b0,qr[0],negm,0,0,0);p1=__builtin_amdgcn_mfma_f32_32x32x16_bf16(b1,qr[0],negm,0,0,0);}
    else{p0=__builtin_amdgcn_mfma_f32_32x32x16_bf16(b0,qr[d0],p0,0,0,0);p1=__builtin_amdgcn_mfma_f32_32x32x16_bf16(b1,qr[d0],p1,0,0,0);}}
}
typedef __attribute__((address_space(3))) const char* lds_cptr;
typedef short v4i16_t __attribute__((ext_vector_type(4)));
__device__ __forceinline__ void kload8(bf16x8*kf,lds_cptr kp){
  kf[0]=*(const __attribute__((address_space(3))) bf16x8*)(kp);      kf[1]=*(const __attribute__((address_space(3))) bf16x8*)(kp+512);
  kf[2]=*(const __attribute__((address_space(3))) bf16x8*)(kp+2048); kf[3]=*(const __attribute__((address_space(3))) bf16x8*)(kp+2560);
  kf[4]=*(const __attribute__((address_space(3))) bf16x8*)(kp+4096); kf[5]=*(const __attribute__((address_space(3))) bf16x8*)(kp+4608);
  kf[6]=*(const __attribute__((address_space(3))) bf16x8*)(kp+6144); kf[7]=*(const __attribute__((address_space(3))) bf16x8*)(kp+6656);
  kf[8]=*(const __attribute__((address_space(3))) bf16x8*)(kp+8192); kf[9]=*(const __attribute__((address_space(3))) bf16x8*)(kp+8704);
  kf[10]=*(const __attribute__((address_space(3))) bf16x8*)(kp+10240); kf[11]=*(const __attribute__((address_space(3))) bf16x8*)(kp+10752);
}
__device__ __forceinline__ void kload2(bf16x8*kf,lds_cptr kp,int j){ kf[2*j]=*(const __attribute__((address_space(3))) bf16x8*)(kp+j*2048); kf[2*j+1]=*(const __attribute__((address_space(3))) bf16x8*)(kp+j*2048+512); }
__device__ __forceinline__ s16x4 vtr(lds_cptr p){ return __builtin_bit_cast(s16x4,__builtin_amdgcn_ds_read_tr16_b64_v4i16((__attribute__((address_space(3))) v4i16_t*)p)); }
__device__ __forceinline__ float rowmax(const f32x16&p0,const f32x16&p1){
  float a=max3f(p0[0],p0[1],p1[0]),b=max3f(p0[2],p0[3],p1[1]);a=max3f(a,p1[2],p1[3]);
  #pragma unroll
  for(int r=4;r<16;r+=4){a=max3f(a,p0[r],p0[r+1]);b=max3f(b,p0[r+2],p0[r+3]);a=max3f(a,p1[r],p1[r+1]);b=max3f(b,p1[r+2],p1[r+3]);}
  const float m=max2f(a,b);
  auto rr=__builtin_amdgcn_permlane32_swap(__float_as_uint(m),__float_as_uint(m),false,false);
  return max2f(__uint_as_float(rr[0]),__uint_as_float(rr[1]));
}
__device__ __forceinline__ void pv(f32x16*o,int vb,bf16x8 pa0,bf16x8 pa1,bf16x8 pa2,bf16x8 pa3){
  #pragma unroll
  for(int d0=0;d0<2;++d0){s16x4 lo[4],hi[4];
    #pragma unroll
    for(int ks=0;ks<4;++ks){
      asm volatile("ds_read_b64_tr_b16 %0,%1 offset:%c2":"=&v"(lo[ks]):"v"(vb),"i"(d0*4096+ks*1024):"memory");
      asm volatile("ds_read_b64_tr_b16 %0,%1 offset:%c2":"=&v"(hi[ks]):"v"(vb),"i"(d0*4096+ks*1024+512):"memory");}
    asm volatile("s_waitcnt lgkmcnt(0)":::"memory");SBAR();
    #define PK(k) (bf16x8){lo[k][0],lo[k][1],lo[k][2],lo[k][3],hi[k][0],hi[k][1],hi[k][2],hi[k][3]}
    o[d0]=__builtin_amdgcn_mfma_f32_32x32x16_bf16(pa0,PK(0),o[d0],0,0,0);
    o[d0]=__builtin_amdgcn_mfma_f32_32x32x16_bf16(pa1,PK(1),o[d0],0,0,0);
    o[d0]=__builtin_amdgcn_mfma_f32_32x32x16_bf16(pa2,PK(2),o[d0],0,0,0);
    o[d0]=__builtin_amdgcn_mfma_f32_32x32x16_bf16(pa3,PK(3),o[d0],0,0,0);
    #undef PK
  }
}

#ifndef ATTN_STORE16
#define ATTN_STORE16(p,v) (*(u32x4*)(p)=(v))
#endif
template<int THRL> __device__ __forceinline__ void attn_unit(int b,int h,int qb,const bf16*Q,const bf16*__restrict__ KN,const bf16*__restrict__ KR,const bf16*__restrict__ V,bf16*O,char*shm,int tid){
  const int lane=tid&63,r32=lane&31,hi=lane>>5; const int wid=__builtin_amdgcn_readfirstlane(tid>>6);
  const long rowbase=(long)b*SEQ; const int q0=qb*QB;
  const bf16*Qrow=Q+(rowbase+q0+wid*QBLK+r32)*1536+h*96;
  const unsigned lds0=(unsigned)(uintptr_t)shm;
  float*wsf=(float*)(shm+LDS_WS)+wid*64;
  const bf16*ksrcA=KN+(rowbase+lane)*1024+h*64+wid*8;
  const long dKR=KR-KN;
  const bf16*ksrcB=KN+((wid<4)?dKR+(rowbase+lane)*1280+1024+wid*8:(rowbase+lane)*1024+h*64+wid*8);
  const long kstepB=(wid<4)?(long)KVBLK*1280:(long)KVBLK*1024;
  const bf16*vsrc=V+(rowbase+16*(wid&3)+(lane>>2))*1024+h*64+(wid>>2)*32+(lane&3)*8;
  const unsigned kdstA=lds0+LDS_K+wid*1024, kdstB=(wid<4)?lds0+LDS_K+(8+wid)*1024:lds0+LDS_DUMP+(wid-4)*1024, vdst=lds0+LDS_V+wid*1024;
  #define DMA_K(t,slot) do{ glds16(ksrcA+(long)(t)*KVBLK*1024,(unsigned)__builtin_amdgcn_readfirstlane(kdstA+(slot))); \
      glds16(ksrcB+(long)(t)*kstepB,(unsigned)__builtin_amdgcn_readfirstlane((wid<4)?kdstB+(slot):kdstB)); }while(0)
  #define DMA_V(t,slot) glds16(vsrc+(long)(t)*KVBLK*1024,(unsigned)__builtin_amdgcn_readfirstlane(vdst+(slot)))
  const int vb0=(int)(lds0+LDS_V)+((lane>>4)&1)*32+(lane&3)*8+(4*hi+((lane&15)>>2))*64;
  const char*Kbase=shm+LDS_K; bf16x8 kf[12];
  const lds_cptr shm3=(lds_cptr)shm; const lds_cptr kp0=shm3+LDS_K+hi*1024+r32*16; const lds_cptr vp0=shm3+LDS_V+((lane>>4)&1)*32+(lane&3)*8+(4*hi+((lane&15)>>2))*64;
  const int NT=(q0+QB)/KVBLK;
  DMA_K(0,0);DMA_V(0,0);DMA_K(1,SLOTB);
  bf16x8 qr[6];
  #pragma unroll
  for(int d0=0;d0<6;++d0)qr[d0]=*reinterpret_cast<const bf16x8*>(&Qrow[d0*16+hi*8]);
  float mhat=0.f,l_reg=0.f;f32x16 o[2];o[0]=f32x16{};o[1]=f32x16{};f32x16 negm=f32x16{};asm volatile("":"+v"(negm));
  const int qrel=wid*QBLK+r32;
  #define CMASK(P0,P1,t) do{int jb_=(t)-(NT-4); if(jb_>=0)cmask(P0,P1,jb_,qrel,hi);}while(0)
  bool resc=false;
  #define START(P0,P1) do{ const float rm=rowmax(P0,P1); resc=false; \
    { const float dl=rm; mhat=fadd_s(mhat,dl); \
      _Pragma("unroll") for(int r=0;r<16;++r){P0[r]=fsub_s(P0[r],dl);P1[r]=fsub_s(P1[r],dl);} \
      _Pragma("unroll") for(int r=0;r<16;++r)negm[r]=-mhat; asm volatile("":"+v"(negm)); } \
    _Pragma("unroll") for(int r=0;r<16;++r)P0[r]=__builtin_amdgcn_exp2f(P0[r]); }while(0)
  #define RESC() do{ if(resc){ asm volatile("s_waitcnt lgkmcnt(0)":::"memory"); \
      _Pragma("unroll") for(int d_=0;d_<2;++d_) _Pragma("unroll") for(int r=0;r<16;++r)o[d_][r]*=wsf[crow(r,hi)]; } }while(0)
  f32x16 pA0,pA1,pB0,pB1;
  int sl_prev=0,sl_cur=0,sl_next=SLOTB;
  #define ROT() do{sl_prev=sl_cur;sl_cur=sl_next;sl_next=(sl_next==(NSLOT-1)*SLOTB)?0:sl_next+SLOTB;}while(0)
  DMA_K(2,2*SLOTB);
  WAIT_BAR(5);
  qkt(pA0,pA1,Kbase,qr,negm,r32,hi);asm volatile("s_nop 15\n\ts_nop 7":"+v"(pA0),"+v"(pA1));CMASK(pA0,pA1,0);
  START(pA0,pA1);
  _Pragma("unroll") for(int r=0;r<16;++r)pA1[r]=__builtin_amdgcn_exp2f(pA1[r]);
  WAIT_BAR(0);
  DMA_K(3,0);DMA_V(1,SLOTB);
  ROT();
  kload8(kf,kp0+sl_cur);
  WAIT_BAR(3);
  s16x4 vlo[8],vhi[8]; u32x4 pw0,pw1,pw2,pw3;
  #define PKW(P,B) cvtpk_s(P[B],P[B+1])
  #define PAF(k) __builtin_bit_cast(bf16x8,pw##k)
  #define VFR(i) (bf16x8){vlo[i][0],vlo[i][1],vlo[i][2],vlo[i][3],vhi[i][0],vhi[i][1],vhi[i][2],vhi[i][3]}
  #define PIN(x) asm volatile("":"+v"(x))
  #define MX3(a,b,c) __builtin_fmaxf(__builtin_fmaxf((a),(b)),(c))
  #define GAPA(MF,A0,A1,A2,A3,W0,W1,PW) do{ MF; sacc+=A0; sacc+=A1; sacc+=A2; sacc+=A3; PIN(sacc); W0; W1; PIN(PW); SBAR(); }while(0)
  #define EX(v) __builtin_amdgcn_exp2f(v)
  #define GAPB(MF,X,B) do{ MF; X[B]=EX(X[B]); X[B+1]=EX(X[B+1]); X[B+2]=EX(X[B+2]); X[B+3]=EX(X[B+3]); PIN(X); SBAR(); }while(0)
  #define VRD(i) do{ vlo[i]=vtr(vp_+(((i)>>2)*4096+((i)&3)*1024)); vhi[i]=vtr(vp_+(((i)>>2)*4096+((i)&3)*1024+512)); }while(0)
  #define KRD(G,j) do{ if(G){ kload2(kf,kp0+sl_next,j); SBAR(); } }while(0)
  #define STEP(C0,C1,P0,P1,t,GK,GV,GL) do{ SBAR(); \
    const lds_cptr vp_=vp0+sl_prev; \
    VRD(0); SBAR(); float sacc=(P0[0]+P0[1]); \
    GAPA(C0=__builtin_amdgcn_mfma_f32_32x32x16_bf16(kf[0],qr[0],negm,0,0,0), P0[2],P0[3],P0[4],P0[5],     pw0[0]=PKW(P0,0), pw0[1]=PKW(P0,2), pw0); \
    VRD(4); SBAR(); GAPA(C1=__builtin_amdgcn_mfma_f32_32x32x16_bf16(kf[1],qr[0],negm,0,0,0), P0[6],P0[7],P0[8],P0[9],     pw0[2]=PKW(P0,4), pw0[3]=PKW(P0,6), pw0); \
    VRD(1); SBAR(); GAPA(C0=__builtin_amdgcn_mfma_f32_32x32x16_bf16(kf[2],qr[1],C0,0,0,0),   P0[10],P0[11],P0[12],P0[13], pw1[0]=PKW(P0,8), pw1[1]=PKW(P0,10), pw1); \
    VRD(5); SBAR(); GAPA(C1=__builtin_amdgcn_mfma_f32_32x32x16_bf16(kf[3],qr[1],C1,0,0,0),   P0[14],P0[15],P1[0],P1[1],   pw1[2]=PKW(P0,12),pw1[3]=PKW(P0,14), pw1); \
    VRD(2); SBAR(); GAPA(C0=__builtin_amdgcn_mfma_f32_32x32x16_bf16(kf[4],qr[2],C0,0,0,0),   P1[2],P1[3],P1[4],P1[5],     pw2[0]=PKW(P1,0), pw2[1]=PKW(P1,2), pw2); \
    VRD(6); SBAR(); GAPA(C1=__builtin_amdgcn_mfma_f32_32x32x16_bf16(kf[5],qr[2],C1,0,0,0),   P1[6],P1[7],P1[8],P1[9],     pw2[2]=PKW(P1,4), pw2[3]=PKW(P1,6), pw2); \
    VRD(3); SBAR(); GAPA(C0=__builtin_amdgcn_mfma_f32_32x32x16_bf16(kf[6],qr[3],C0,0,0,0),   P1[10],P1[11],P1[12],P1[13], pw3[0]=PKW(P1,8), pw3[1]=PKW(P1,10), pw3); \
    VRD(7); SBAR(); GAPA(C1=__builtin_amdgcn_mfma_f32_32x32x16_bf16(kf[7],qr[3],C1,0,0,0),   P1[14],P1[15],0.f,0.f,       pw3[2]=PKW(P1,12),pw3[3]=PKW(P1,14), pw3); \
    C0=__builtin_amdgcn_mfma_f32_32x32x16_bf16(kf[8],qr[4],C0,0,0,0); C1=__builtin_amdgcn_mfma_f32_32x32x16_bf16(kf[9],qr[4],C1,0,0,0); SBAR(); \
    C0=__builtin_amdgcn_mfma_f32_32x32x16_bf16(kf[10],qr[5],C0,0,0,0); C1=__builtin_amdgcn_mfma_f32_32x32x16_bf16(kf[11],qr[5],C1,0,0,0); SBAR(); \
    l_reg+=sacc; \
    if(GK){DMA_K((t)+3,sl_cur);} if(GV){DMA_V((t)+1,sl_next);} \
    CMASK(C0,C1,t); \
    { float a=MX3(C0[0],C0[1],C1[0]),b=MX3(C0[2],C0[3],C1[1]); a=MX3(a,C1[2],C1[3]); \
      _Pragma("unroll") for(int r=4;r<16;r+=4){a=MX3(a,C0[r],C0[r+1]);b=MX3(b,C0[r+2],C0[r+3]);a=MX3(a,C1[r],C1[r+1]);b=MX3(b,C1[r+2],C1[r+3]);} \
      float rm=__builtin_fmaxf(a,b); { auto rr=__builtin_amdgcn_permlane32_swap(__float_as_uint(rm),__float_as_uint(rm),false,false); rm=__builtin_fmaxf(__uint_as_float(rr[0]),__uint_as_float(rr[1])); } \
      resc=false; \
      if(__builtin_expect(__any(rm>(float)THRL),0)){ const float dl=__builtin_fmaxf(rm,0.f); mhat+=dl; \
        _Pragma("unroll") for(int r=0;r<16;++r){C0[r]-=dl;C1[r]-=dl;} \
        _Pragma("unroll") for(int r=0;r<16;++r)negm[r]=-mhat; asm volatile("":"+v"(negm)); \
        const float f=__builtin_amdgcn_exp2f(-dl); l_reg*=f; if(hi==0)wsf[r32]=f; resc=true; } } \
    SBAR(); \
    GAPB(o[0]=__builtin_amdgcn_mfma_f32_32x32x16_bf16(PAF(0),VFR(0),o[0],0,0,0), C0,0); \
    GAPB(o[1]=__builtin_amdgcn_mfma_f32_32x32x16_bf16(PAF(0),VFR(4),o[1],0,0,0), C0,4); \
    KRD(GL,0); GAPB(o[0]=__builtin_amdgcn_mfma_f32_32x32x16_bf16(PAF(1),VFR(1),o[0],0,0,0), C0,8); \
    KRD(GL,1); GAPB(o[1]=__builtin_amdgcn_mfma_f32_32x32x16_bf16(PAF(1),VFR(5),o[1],0,0,0), C0,12); \
    KRD(GL,2); GAPB(o[0]=__builtin_amdgcn_mfma_f32_32x32x16_bf16(PAF(2),VFR(2),o[0],0,0,0), C1,0); \
    KRD(GL,3); GAPB(o[1]=__builtin_amdgcn_mfma_f32_32x32x16_bf16(PAF(2),VFR(6),o[1],0,0,0), C1,4); \
    KRD(GL,4); GAPB(o[0]=__builtin_amdgcn_mfma_f32_32x32x16_bf16(PAF(3),VFR(3),o[0],0,0,0), C1,8); \
    KRD(GL,5); GAPB(o[1]=__builtin_amdgcn_mfma_f32_32x32x16_bf16(PAF(3),VFR(7),o[1],0,0,0), C1,12); \
    }while(0)
  int t=1;
  #undef CMASK
  #define CMASK(P0,P1,t) do{}while(0)
  for(;t+5<NT;t+=2){
    STEP(pB0,pB1,pA0,pA1,t,true,true,true);     WAIT_BAR(3); RESC(); ROT();
    STEP(pA0,pA1,pB0,pB1,t+1,true,true,true);   WAIT_BAR(3); RESC(); ROT();
  }
  #undef CMASK
  #define CMASK(P0,P1,t) do{int jb_=(t)-(NT-4); if(jb_>=0)cmask(P0,P1,jb_,qrel,hi);}while(0)
  #define ENDW(tt) do{ if((tt)+3<NT){WAIT_BAR(3);} else if((tt)+2<NT){WAIT_BAR(1);} else {WAIT_BAR(0);} }while(0)
  for(;t+1<NT;t+=2){
    STEP(pB0,pB1,pA0,pA1,t,(t+3<NT),(t+1<NT),(t+1<NT));       ENDW(t);   RESC(); ROT();
    STEP(pA0,pA1,pB0,pB1,t+1,(t+4<NT),(t+2<NT),(t+2<NT));     ENDW(t+1); RESC(); ROT();
  }
  STEP(pB0,pB1,pA0,pA1,NT-1,false,false,false); RESC();
  { float sacc=pB0[0]+pB0[1]; _Pragma("unroll") for(int r=2;r<16;++r)sacc+=pB0[r]; _Pragma("unroll") for(int r=0;r<16;++r)sacc+=pB1[r]; l_reg+=sacc;
    pw0=(u32x4){PKW(pB0,0),PKW(pB0,2),PKW(pB0,4),PKW(pB0,6)};pw1=(u32x4){PKW(pB0,8),PKW(pB0,10),PKW(pB0,12),PKW(pB0,14)};pw2=(u32x4){PKW(pB1,0),PKW(pB1,2),PKW(pB1,4),PKW(pB1,6)};pw3=(u32x4){PKW(pB1,8),PKW(pB1,10),PKW(pB1,12),PKW(pB1,14)};
    SBAR(); pv(o,vb0+sl_cur,PAF(0),PAF(1),PAF(2),PAF(3)); }
  #undef PKW
  #undef PAF
  #undef VFR
  #undef PIN
  #undef MX3
  #undef GAPA
  #undef GAPB
  #undef EX
  #undef VRD
  #undef KRD
  #undef STEP
  #undef ENDW
  {auto rr=__builtin_amdgcn_permlane32_swap(__float_as_uint(l_reg),__float_as_uint(l_reg),false,false);l_reg=__uint_as_float(rr[0])+__uint_as_float(rr[1]);}
  if(hi==0)wsf[32+r32]=l_reg;asm volatile("s_waitcnt lgkmcnt(0)":::"memory");
  float rli[16];
  #pragma unroll
  for(int r=0;r<16;++r)rli[r]=__builtin_amdgcn_rcpf(wsf[32+crow(r,hi)]);
  bf16*Ow=O+(rowbase+q0+wid*QBLK)*1024+h*D;
  { bf16*stg=(bf16*)(shm+LDS_OST)+wid*2048;
    #pragma unroll
    for(int r=0;r<16;++r){const int orow=crow(r,hi);
      #pragma unroll
      for(int d0=0;d0<2;++d0)stg[orow*64+d0*32+r32]=f2bf(o[d0][r]*rli[r]);}
    asm volatile("s_waitcnt lgkmcnt(0)":::"memory");
    #pragma unroll
    for(int i=0;i<4;++i){const int row=i*8+(lane>>3),ch=lane&7; const u32x4 v=*(const u32x4*)(stg+row*64+ch*8); ATTN_STORE16(Ow+(long)row*1024+ch*8,v);} }
  asm volatile("s_waitcnt lgkmcnt(0)\n\ts_barrier":::"memory");
  #undef DMA_K
  #undef DMA_V
  #undef CMASK
  #undef START
  #undef RESC
  #undef ROT
}
constexpr int ATTN_LDS_BYTES=LDS_BYTES;
#undef SBAR
#undef WAIT_BAR
}

namespace ix {
constexpr int IKROW = 144;
DI unsigned sortable(float f) { const unsigned u = __float_as_uint(f); return (u & 0x80000000u) ? ~u : (u | 0x80000000u); }

DI void indexer_unit(const bf16_t* proj, const float* iw, unsigned* mask, int b, int qt16, unsigned char* lds, int tid) {
    float* SC = (float*)lds;
    unsigned char* IK = lds + 131072;
    const int w = __builtin_amdgcn_readfirstlane(tid >> 6), lane = tid & 63, r = lane & 31, hf = lane >> 5;
    const int mtile = w & 3, par = w >> 2;
    const int q0 = qt16 * 16, nch = (q0 + 16 + 127) >> 7;
    const int qq = ((r >> 4) & 1) + 2 * ((r >> 2) & 1), hh = (r & 3) + 4 * ((r >> 3) & 1);
    const bf16_t* ap = proj + (size_t)(b * S_ + q0 + 4 * mtile + qq) * NE_IN + C_IQ + hh * 64 + hf * 8;
    bf16x8 af[4];
#pragma unroll
    for (int ks = 0; ks < 4; ++ks) af[ks] = *(const bf16x8*)(ap + ks * 16);
    const int qA = 4 * mtile + 2 * hf;
    const float* iwp = iw + (size_t)(b * S_ + q0 + qA) * 8;
    const f32x4 iwA0 = *(const f32x4*)(iwp), iwA1 = *(const f32x4*)(iwp + 4), iwB0 = *(const f32x4*)(iwp + 8), iwB1 = *(const f32x4*)(iwp + 12);
    const int kr0 = tid >> 3, kc = tid & 7;
    const bf16_t* kp = proj + (size_t)(b * S_ + kr0) * NE_IN + C_IK + kc * 8;
    u32x4 g0 = *(const u32x4*)kp, g1 = *(const u32x4*)(kp + (size_t)64 * NE_IN);
    for (int c = 0; c < nch; ++c) {
        __syncthreads();
        *(u32x4*)(IK + kr0 * IKROW + kc * 16) = g0; *(u32x4*)(IK + (kr0 + 64) * IKROW + kc * 16) = g1;
        __syncthreads();
        if (c + 1 < nch) { kp += (size_t)128 * NE_IN; g0 = *(const u32x4*)kp; g1 = *(const u32x4*)(kp + (size_t)64 * NE_IN); }
#pragma unroll
        for (int t2 = 0; t2 < 2; ++t2) {
            const int ntile = par * 2 + t2;
            f32x16 acc = zero16();
#pragma unroll
            for (int ks = 0; ks < 4; ++ks) { const bf16x8 bfr = *(const bf16x8*)(IK + (ntile * 32 + r) * IKROW + ks * 32 + hf * 16); acc = mfma32(af[ks], bfr, acc); }
            float sA = 0.f, sB = 0.f;
#pragma unroll
            for (int e = 0; e < 4; ++e) { sA += fmaxf(acc[e], 0.f) * iwA0[e] + fmaxf(acc[4 + e], 0.f) * iwA1[e]; sB += fmaxf(acc[8 + e], 0.f) * iwB0[e] + fmaxf(acc[12 + e], 0.f) * iwB1[e]; }
            const int key = c * 128 + ntile * 32 + r, qposA = q0 + qA;
            SC[qA * 2048 + key] = (key <= qposA) ? sA : NEG_INF;
            SC[(qA + 1) * 2048 + key] = (key <= qposA + 1) ? sB : NEG_INF;
        }
    }
    __syncthreads();
    const int nI = nch * 2;
    LAS unsigned* hist = (LAS unsigned*)(lds + 153600 + w * 1024);
#pragma unroll 1
    for (int qsel = 0; qsel < 2; ++qsel) {
        const int qi = 2 * w + qsel, qpos = q0 + qi;
        unsigned u[32];
#pragma unroll
        for (int i = 0; i < 32; ++i) u[i] = (i < nI) ? sortable(SC[qi * 2048 + i * 64 + lane]) : 0u;
        unsigned long long mymask = 0ull;
        if (qpos < 256) {
#pragma unroll
            for (int i = 0; i < 32; ++i) { const unsigned long long bal = __ballot((i * 64 + lane) <= qpos); if (lane == i) mymask = bal; }
        } else {
            unsigned prefix = 0u; int need = 256, shift = 24; bool whole = false;
#pragma unroll 1
            for (int pass = 0; pass < 4; ++pass) {
                shift = 24 - 8 * pass;
                { unsigned zz = 0u; asm volatile("" : "+v"(zz)); *(u32x4*)(hist + lane * 4) = (u32x4){zz, zz, zz, zz}; }
#pragma unroll
                for (int i = 0; i < 32; ++i) if (i < nI) {
                    const bool in = (pass == 0) ? (u[i] > 0x007fffffu) : ((u[i] >> (shift + 8)) == prefix);
                    if (in) __hip_atomic_fetch_add(hist + ((u[i] >> shift) & 255u), 1u, __ATOMIC_RELAXED, __HIP_MEMORY_SCOPE_WAVEFRONT);
                }
                const u32x4 hv = *(const u32x4*)(hist + (63 - lane) * 4);
                const int sl = (int)(hv[0] + hv[1] + hv[2] + hv[3]);
                int pre = sl;
                pre += __builtin_amdgcn_update_dpp(0, pre, 0x111, 0xf, 0xf, false);
                pre += __builtin_amdgcn_update_dpp(0, pre, 0x112, 0xf, 0xf, false);
                pre += __builtin_amdgcn_update_dpp(0, pre, 0x114, 0xf, 0xf, false);
                pre += __builtin_amdgcn_update_dpp(0, pre, 0x118, 0xf, 0xf, false);
                pre += __builtin_amdgcn_update_dpp(0, pre, 0x142, 0xa, 0xf, false);
                pre += __builtin_amdgcn_update_dpp(0, pre, 0x143, 0xc, 0xf, false);
                const unsigned long long mk = __ballot(pre >= need);
                const int Lsel = __builtin_ctzll(mk);
                int above = pre - sl, bin = 4 * (63 - lane), nn = need, cnt = 0;
                if (above + (int)hv[3] >= need) { bin += 3; nn = need - above; cnt = (int)hv[3]; }
                else { above += (int)hv[3];
                    if (above + (int)hv[2] >= need) { bin += 2; nn = need - above; cnt = (int)hv[2]; }
                    else { above += (int)hv[2];
                        if (above + (int)hv[1] >= need) { bin += 1; nn = need - above; cnt = (int)hv[1]; }
                        else { above += (int)hv[1]; nn = need - above; cnt = (int)hv[0]; } } }
                bin = __builtin_amdgcn_readlane(bin, Lsel); need = __builtin_amdgcn_readlane(nn, Lsel); cnt = __builtin_amdgcn_readlane(cnt, Lsel);
                prefix = (prefix << 8) | (unsigned)bin;
                if (cnt == need) { whole = true; break; }
            }
            const unsigned T = whole ? (prefix << shift) : prefix;
            int tc = 0;
#pragma unroll
            for (int i = 0; i < 32; ++i) if (i < nI) {
                bool sel;
                if (whole) sel = (u[i] >= T);
                else {
                    const unsigned long long eq = __ballot(u[i] == T);
                    const int myrank = tc + (int)__builtin_amdgcn_mbcnt_hi((unsigned)(eq >> 32), __builtin_amdgcn_mbcnt_lo((unsigned)eq, 0u));
                    sel = (u[i] > T) || (u[i] == T && myrank < need);
                    tc += __popcll(eq);
                }
                const unsigned long long bal = __ballot(sel);
                if (lane == i) mymask = bal;
            }
        }
        if (lane < 32) { u32x2 o; o[0] = (unsigned)mymask; o[1] = (unsigned)(mymask >> 32); *(u32x2*)(mask + (size_t)(b * S_ + qpos) * 64 + 2 * lane) = o; }
    }
    __syncthreads();
}
}

namespace pr {
DI void ce_desc(float& x, float& y) { const float hi = fmaxf(x, y), lo = fminf(x, y); x = hi; y = lo; }
DI void sort16_desc(float (&a)[16]) {
    ce_desc(a[0], a[13]); ce_desc(a[1], a[12]); ce_desc(a[2], a[15]); ce_desc(a[3], a[14]); ce_desc(a[4], a[8]); ce_desc(a[5], a[6]); ce_desc(a[7], a[11]); ce_desc(a[9], a[10]);
    ce_desc(a[0], a[5]); ce_desc(a[1], a[7]); ce_desc(a[2], a[9]); ce_desc(a[3], a[4]); ce_desc(a[6], a[13]); ce_desc(a[8], a[14]); ce_desc(a[10], a[15]); ce_desc(a[11], a[12]);
    ce_desc(a[0], a[1]); ce_desc(a[2], a[3]); ce_desc(a[4], a[5]); ce_desc(a[6], a[8]); ce_desc(a[7], a[9]); ce_desc(a[10], a[11]); ce_desc(a[12], a[13]); ce_desc(a[14], a[15]);
    ce_desc(a[0], a[2]); ce_desc(a[1], a[3]); ce_desc(a[4], a[10]); ce_desc(a[5], a[11]); ce_desc(a[6], a[7]); ce_desc(a[8], a[9]); ce_desc(a[12], a[14]); ce_desc(a[13], a[15]);
    ce_desc(a[1], a[2]); ce_desc(a[3], a[12]); ce_desc(a[4], a[6]); ce_desc(a[5], a[7]); ce_desc(a[8], a[10]); ce_desc(a[9], a[11]); ce_desc(a[13], a[14]);
    ce_desc(a[1], a[4]); ce_desc(a[2], a[6]); ce_desc(a[5], a[8]); ce_desc(a[7], a[10]); ce_desc(a[9], a[13]); ce_desc(a[11], a[14]);
    ce_desc(a[2], a[4]); ce_desc(a[3], a[6]); ce_desc(a[9], a[12]); ce_desc(a[11], a[13]);
    ce_desc(a[3], a[5]); ce_desc(a[6], a[8]); ce_desc(a[7], a[9]); ce_desc(a[10], a[12]);
    ce_desc(a[3], a[4]); ce_desc(a[5], a[6]); ce_desc(a[7], a[8]); ce_desc(a[9], a[10]); ce_desc(a[11], a[12]);
    ce_desc(a[6], a[7]); ce_desc(a[8], a[9]);
}
DI void merge_top16(float (&a)[16], const float (&b)[16]) {
#pragma unroll
    for (int i = 0; i < 16; ++i) a[i] = fmaxf(a[i], b[15 - i]);
#pragma unroll
    for (int j = 8; j > 0; j >>= 1)
#pragma unroll
        for (int i = 0; i < 16; ++i) if ((i & j) == 0) ce_desc(a[i], a[i + j]);
}
constexpr int SUBK_MAT = 128 * 256;
constexpr int ROUTE_SCR = 2 * SUBK_MAT;
DI void stage_subk(const bf16_t* subk, int hp0, int hp1, unsigned char* lds, int tid) {
#pragma unroll
    for (int i = 0; i < 8; ++i) {
        const int piece = i * 512 + tid, slot = piece >> 11, pp = piece & 2047, row = pp >> 4, ch = pp & 15;
        const bf16_t* src = subk + (size_t)((slot ? hp1 : hp0) * 128 + row) * 128 + ((ch ^ (row & 15)) * 8);
        __builtin_amdgcn_global_load_lds((const unsigned*)src, (unsigned*)(lds + slot * SUBK_MAT + pp * 16), 16, 0, 0);
    }
}
DI void subkey_scores(const bf16x8 (&qf)[8], const unsigned char* mat, int r, int hf, float (&c)[4][16]) {
#pragma unroll
    for (int mt = 0; mt < 4; ++mt) {
        f32x16 acc = zero16();
        const int row = mt * 32 + r;
        const unsigned char* rp = mat + row * 256;
#pragma unroll
        for (int ks = 0; ks < 8; ++ks) acc = mfma32(*(const bf16x8*)(rp + (((2 * ks + hf) ^ (row & 15)) * 16)), qf[ks], acc);
#pragma unroll
        for (int e = 0; e < 16; ++e) {
            const unsigned key = (unsigned)(mt * 32 + (e & 3) + 8 * (e >> 2)) + 4u * (unsigned)hf;
            c[mt][e] = __uint_as_float((__float_as_uint(acc[e]) & ~127u) | key);
        }
    }
}
DI void sort_top16(float (&c)[4][16], float (&V)[16]) {
#pragma unroll
    for (int mt = 0; mt < 4; ++mt) sort16_desc(c[mt]);
    merge_top16(c[0], c[1]); merge_top16(c[2], c[3]); merge_top16(c[0], c[2]);
    float pb[16];
#pragma unroll
    for (int k = 0; k < 16; ++k) pb[k] = __shfl_xor(c[0][k], 32, 64);
    merge_top16(c[0], pb);
#pragma unroll
    for (int k = 0; k < 16; ++k) V[k] = c[0][k];
}
DI void route_block(const bf16_t* qp, const bf16_t* subk, unsigned short* re, float* rg, int unit, unsigned char* lds, int tid) {
    const int w = __builtin_amdgcn_readfirstlane(tid >> 6), lane = tid & 63, r = lane & 31, hf = lane >> 5;
    const int tg = w & 3, hh = w >> 2, token = unit * 128 + tg * 32 + r;
    unsigned char* ldsw = lds + ROUTE_SCR + w * 8192;
    const unsigned char* mat = lds + hh * SUBK_MAT;
    stage_subk(subk, 0, 8, lds, tid);
    bf16x8 qn[8];
    {
        const bf16_t* qptr = qp + (size_t)token * 2048 + (hh * 8) * 128 + hf * 8;
#pragma unroll
        for (int ks = 0; ks < 8; ++ks) qn[ks] = *(const bf16x8*)(qptr + ks * 16);
    }
#pragma unroll 1
    for (int hpair = 0; hpair < 2; ++hpair) {
        const int hA = hh * 4 + hpair * 2;
        float V0[16], V1[16];
#pragma unroll
        for (int k = 0; k < 16; ++k) { V0[k] = 0.f; V1[k] = 0.f; }
#pragma unroll 1
        for (int st = 0; st < 4; ++st) {
            const int s = hpair * 4 + st;
            bf16x8 qf[8];
#pragma unroll
            for (int ks = 0; ks < 8; ++ks) qf[ks] = qn[ks];
            asm volatile("s_waitcnt vmcnt(0)" ::: "memory");
            __syncthreads();
            float c[4][16];
            subkey_scores(qf, mat, r, hf, c);
            __syncthreads();
            if (s + 1 < 8) {
                stage_subk(subk, s + 1, 8 + s + 1, lds, tid);
                const bf16_t* qptr = qp + (size_t)token * 2048 + (hh * 8 + s + 1) * 128 + hf * 8;
#pragma unroll
                for (int ks = 0; ks < 8; ++ks) qn[ks] = *(const bf16x8*)(qptr + ks * 16);
            }
            float Bt[16]; sort_top16(c, Bt);
            const bool to0 = (st == 0) || (st == 2 && hf), to1 = (st == 1) || (st == 3 && hf);
#pragma unroll
            for (int k = 0; k < 16; ++k) { V0[k] = to0 ? Bt[k] : V0[k]; V1[k] = to1 ? Bt[k] : V1[k]; }
        }
        const int head = hA + hf;
        float cv[64];
        {
            int n = 0;
#pragma unroll
            for (int i = 0; i < 16; ++i)
#pragma unroll
                for (int j = 0; j < 16; ++j) if ((i + 1) * (j + 1) <= 16) { cv[n] = V0[i] + V1[j]; ++n; }
#pragma unroll
            for (int k = 50; k < 64; ++k) cv[k] = NEG_INF;
        }
        float sv[4][16];
#pragma unroll
        for (int g = 0; g < 4; ++g) {
#pragma unroll
            for (int i = 0; i < 16; ++i) sv[g][i] = cv[g * 16 + i];
            sort16_desc(sv[g]);
        }
        merge_top16(sv[0], sv[1]); merge_top16(sv[2], sv[3]); merge_top16(sv[0], sv[2]);
        const float smax = sv[0][0], thr = sv[0][15];
        float den = 0.f;
#pragma unroll
        for (int k = 0; k < 16; ++k) den += __expf(sv[0][k] - smax);
        const float inv = 1.0f / den;
        int pos = 0;
        {
            int n = 0;
#pragma unroll
            for (int i = 0; i < 16; ++i)
#pragma unroll
                for (int j = 0; j < 16; ++j) if ((i + 1) * (j + 1) <= 16) {
                    if (cv[n] >= thr && pos < 16) {
                        u32x2 ent; ent[0] = ((__float_as_uint(V0[i]) & 127u) << 7) | (__float_as_uint(V1[j]) & 127u); ent[1] = __float_as_uint(__expf(cv[n] - smax) * inv);
                        *(u32x2*)(ldsw + pos * 512 + lane * 8) = ent; ++pos;
                    }
                    ++n;
                }
        }
        unsigned short* rep = re + (size_t)token * 128 + head * 16; float* rgp = rg + (size_t)token * 128 + head * 16;
        unsigned ev[8];
#pragma unroll
        for (int k4 = 0; k4 < 4; ++k4) {
            f32x4 gv; unsigned e4[4];
#pragma unroll
            for (int q = 0; q < 4; ++q) { const u32x2 ent = *(const u32x2*)(ldsw + (k4 * 4 + q) * 512 + lane * 8); e4[q] = ent[0]; gv[q] = __uint_as_float(ent[1]); }
            ev[2 * k4] = e4[0] | (e4[1] << 16); ev[2 * k4 + 1] = e4[2] | (e4[3] << 16);
            *(f32x4*)(rgp + 4 * k4) = gv;
        }
        *(u32x4*)rep = (u32x4){ev[0], ev[1], ev[2], ev[3]}; *(u32x4*)(rep + 8) = (u32x4){ev[4], ev[5], ev[6], ev[7]};
    }
    __syncthreads();
}

DI void fp8x16_to_f32(const u32x4 d, float (&f)[16]) {
#pragma unroll
    for (int q = 0; q < 4; ++q) {
        const f32x2 lo = __builtin_amdgcn_cvt_pk_f32_fp8((int)d[q], false), hi = __builtin_amdgcn_cvt_pk_f32_fp8((int)d[q], true);
        f[4 * q] = lo[0]; f[4 * q + 1] = lo[1]; f[4 * q + 2] = hi[0]; f[4 * q + 3] = hi[1];
    }
}
DI void ld_ids(const unsigned short* re, int t, int g, int (&ids)[16]) {
    const u32x4 a = *(const u32x4*)(re + (size_t)t * 128 + g * 16), b = *(const u32x4*)(re + (size_t)t * 128 + g * 16 + 8);
#pragma unroll
    for (int q = 0; q < 4; ++q) { ids[2 * q] = (int)(a[q] & 0xffffu); ids[2 * q + 1] = (int)(a[q] >> 16); ids[8 + 2 * q] = (int)(b[q] & 0xffffu); ids[8 + 2 * q + 1] = (int)(b[q] >> 16); }
}
DI void ld_rows(const unsigned char* tab, unsigned laneoff, const int (&ids)[16], u32x4 (&data)[16]) {
#pragma unroll
    for (int i = 0; i < 16; ++i) data[i] = *(const u32x4*)(tab + (size_t)((unsigned)ids[i] * 128u + laneoff));
}
DI void peer_u_loop(const bf16_t* h2, const unsigned char* U, const unsigned short* re, bf16_t* pd, int t0, int tstep, int slice, int lane) {
    const int g = lane >> 3, c = lane & 7;
    const unsigned laneoff = (unsigned)(slice * (NEXP * 128) + c * 16);
    const bf16_t* hb = h2 + slice * 128 + c * 16;
    if (t0 >= T_) return;
    int idsn[16]; u32x4 data[16]; u32x4 h0, h1;
    ld_ids(re, t0, g, idsn); ld_rows(U, laneoff, idsn, data);
    h0 = *(const u32x4*)(hb + (size_t)t0 * 1024); h1 = *(const u32x4*)(hb + (size_t)t0 * 1024 + 8);
    ld_ids(re, min(t0 + tstep, T_ - 1), g, idsn);
    const bool b2 = (c & 4) != 0, b1 = (c & 2) != 0, b0 = (c & 1) != 0;
#pragma unroll 1
    for (int t = t0; t < T_; t += tstep) {
        const int tnc = min(t + tstep, T_ - 1), tnn = min(t + 2 * tstep, T_ - 1);
        f32x2 hp[8];
#pragma unroll
        for (int q = 0; q < 4; ++q) { hp[q] = (f32x2){bf_lo(h0[q]), bf_hi(h0[q])}; hp[4 + q] = (f32x2){bf_lo(h1[q]), bf_hi(h1[q])}; }
        h0 = *(const u32x4*)(hb + (size_t)tnc * 1024); h1 = *(const u32x4*)(hb + (size_t)tnc * 1024 + 8);
        float part[16];
#pragma unroll
        for (int i = 0; i < 16; ++i) {
            const u32x4 d = data[i];
            data[i] = *(const u32x4*)(U + (size_t)((unsigned)idsn[i] * 128u + laneoff));
            f32x2 s2 = {0.f, 0.f};
#pragma unroll
            for (int q = 0; q < 4; ++q) {
                const f32x2 lo = __builtin_amdgcn_cvt_pk_f32_fp8((int)d[q], false), hi = __builtin_amdgcn_cvt_pk_f32_fp8((int)d[q], true);
                s2 = __builtin_elementwise_fma(lo, hp[2 * q], s2); s2 = __builtin_elementwise_fma(hi, hp[2 * q + 1], s2);
            }
            part[i] = s2[0] + s2[1];
        }
        ld_ids(re, tnn, g, idsn);
        float a8[8], a4[4], a2[2];
#pragma unroll
        for (int k = 0; k < 8; ++k) { const float keep = b2 ? part[8 + k] : part[k], send = b2 ? part[k] : part[8 + k]; a8[k] = keep + __shfl_xor(send, 4, 64); }
#pragma unroll
        for (int k = 0; k < 4; ++k) { const float keep = b1 ? a8[4 + k] : a8[k], send = b1 ? a8[k] : a8[4 + k]; a4[k] = keep + __shfl_xor(send, 2, 64); }
#pragma unroll
        for (int k = 0; k < 2; ++k) { const float keep = b0 ? a4[2 + k] : a4[k], send = b0 ? a4[k] : a4[2 + k]; a2[k] = keep + __shfl_xor(send, 1, 64); }
        *(unsigned*)(pd + (size_t)t * 1024 + slice * 128 + 2 * lane) = pk_bf16(a2[0], a2[1]);
    }
}
DI void peer_combine(const bf16_t* pd, float* wg, const float* ps, int tb, int lane) {
    const int t = tb + (lane >> 4), p0 = (lane & 15) * 8;
    const f32x4 q0 = *(const f32x4*)(ps + (size_t)t * 16), q1 = *(const f32x4*)(ps + (size_t)t * 16 + 4), q2 = *(const f32x4*)(ps + (size_t)t * 16 + 8), q3 = *(const f32x4*)(ps + (size_t)t * 16 + 12);
    const float sq = (((q0[0] + q0[1]) + (q0[2] + q0[3])) + ((q1[0] + q1[1]) + (q1[2] + q1[3]))) + (((q2[0] + q2[1]) + (q2[2] + q2[3])) + ((q3[0] + q3[1]) + (q3[2] + q3[3])));
    const float rs = (1.0f / TAB_SCALE) / sqrtf(sq * (1.0f / 1024.0f) + 1e-6f);
    u32x4 v[8];
#pragma unroll
    for (int sl = 0; sl < 8; ++sl) v[sl] = *(const u32x4*)(pd + (size_t)t * 1024 + sl * 128 + p0);
    float* gp = wg + (size_t)t * 128 + p0;
    const f32x4 g0 = *(const f32x4*)gp, g1 = *(const f32x4*)(gp + 4);
    float d[8];
#pragma unroll
    for (int k = 0; k < 8; ++k) d[k] = 0.f;
#pragma unroll
    for (int sl = 0; sl < 8; ++sl)
#pragma unroll
        for (int q = 0; q < 4; ++q) { d[2 * q] += bf_lo(v[sl][q]); d[2 * q + 1] += bf_hi(v[sl][q]); }
    f32x4 o0, o1;
#pragma unroll
    for (int k = 0; k < 8; ++k) {
        const float cc = d[k] * rs;
        const float g = (k < 4) ? g0[k & 3] : g1[k & 3];
        const float r = g * 0.5f * cc * (1.0f + erff(cc * 0.70710678118654752f)) * (1.0f / TAB_SCALE);
        if (k < 4) o0[k & 3] = r; else o1[k & 3] = r;
    }
    *(f32x4*)gp = o0; *(f32x4*)(gp + 4) = o1;
}
DI void ld_w(const float* wg, int t, int g, float (&wv)[16]) {
#pragma unroll
    for (int q = 0; q < 4; ++q) { const f32x4 wq = *(const f32x4*)(wg + (size_t)t * 128 + g * 16 + q * 4); wv[4 * q] = wq[0]; wv[4 * q + 1] = wq[1]; wv[4 * q + 2] = wq[2]; wv[4 * q + 3] = wq[3]; }
}
DI void peer_v_loop(bf16_t* xb, float* psa, const unsigned char* V, const unsigned short* re, const float* wg, int t0, int tstep, int slice, int lane) {
    const int g = lane >> 3, c = lane & 7;
    const unsigned laneoff = (unsigned)(slice * (NEXP * 128) + c * 16);
    if (t0 >= T_) return;
    int idsn[16]; u32x4 data[16]; float wv[16], wn[16];
    ld_ids(re, t0, g, idsn); ld_rows(V, laneoff, idsn, data); ld_w(wg, t0, g, wv);
    { const int tc = min(t0 + tstep, T_ - 1); ld_ids(re, tc, g, idsn); ld_w(wg, tc, g, wn); }
    const bool b5 = (lane & 32) != 0, b4 = (lane & 16) != 0, b3 = (lane & 8) != 0;
#pragma unroll 1
    for (int t = t0; t < T_; t += tstep) {
        const int tnn = min(t + 2 * tstep, T_ - 1);
        const size_t o = (size_t)t * 1024 + slice * 128 + c * 16 + 2 * g;
        const unsigned xo = *(const unsigned*)(xb + o);
        f32x2 acc2[8];
#pragma unroll
        for (int k = 0; k < 8; ++k) acc2[k] = (f32x2){0.f, 0.f};
#pragma unroll
        for (int i = 0; i < 16; ++i) {
            const u32x4 d = data[i];
            data[i] = *(const u32x4*)(V + (size_t)((unsigned)idsn[i] * 128u + laneoff));
            const f32x2 w2 = {wv[i], wv[i]};
#pragma unroll
            for (int q = 0; q < 4; ++q) {
                const f32x2 lo = __builtin_amdgcn_cvt_pk_f32_fp8((int)d[q], false), hi = __builtin_amdgcn_cvt_pk_f32_fp8((int)d[q], true);
                acc2[2 * q] = __builtin_elementwise_fma(lo, w2, acc2[2 * q]); acc2[2 * q + 1] = __builtin_elementwise_fma(hi, w2, acc2[2 * q + 1]);
            }
        }
        float acc[16];
#pragma unroll
        for (int k = 0; k < 8; ++k) { acc[2 * k] = acc2[k][0]; acc[2 * k + 1] = acc2[k][1]; }
#pragma unroll
        for (int k = 0; k < 16; ++k) wv[k] = wn[k];
        ld_ids(re, tnn, g, idsn); ld_w(wg, tnn, g, wn);
        float a8[8], a4[4], a2[2];
#pragma unroll
        for (int k = 0; k < 8; ++k) { const float keep = b5 ? acc[8 + k] : acc[k], send = b5 ? acc[k] : acc[8 + k]; a8[k] = keep + __shfl_xor(send, 32, 64); }
#pragma unroll
        for (int k = 0; k < 4; ++k) { const float keep = b4 ? a8[4 + k] : a8[k], send = b4 ? a8[k] : a8[4 + k]; a4[k] = keep + __shfl_xor(send, 16, 64); }
#pragma unroll
        for (int k = 0; k < 2; ++k) { const float keep = b3 ? a4[2 + k] : a4[k], send = b3 ? a4[k] : a4[2 + k]; a2[k] = keep + __shfl_xor(send, 8, 64); }
        const float y0 = bf_lo(xo) + a2[0], y1 = bf_hi(xo) + a2[1];
        *(unsigned*)(xb + o) = pk_bf16(y0, y1);
        const float ss = wave_sum(y0 * y0 + y1 * y1);
        if (lane == 0) psa[(size_t)t * 8 + slice] = ss;
    }
}
}

constexpr int NPHASE = 1 + 12 * DEPTH_;

#ifndef MK_ONE_LAUNCH
#define MK_ONE_LAUNCH 1
#endif

__global__ void __launch_bounds__(NTHR, 2) k_main(Params p) {
    extern __shared__ __attribute__((aligned(16))) unsigned char lds[];
    unsigned char* const ws = p.ws;
    const int bid = blockIdx.x, nblk = gridDim.x;
    const bool fused = (p.ph_hi - p.ph_lo) > 1;
    XcdBarrier bar; bar.bar = (unsigned*)(ws + WS_BAR); bar.x = 0; bar.st = (volatile LAS unsigned*)(lds + LDS_BYTES - 16);
    if (fused) {
        if (threadIdx.x == 0) *(u32x4*)(lds + LDS_BYTES - 16) = (u32x4){0u, 0u, 0u, 0u};
        __syncthreads();
        bar = xcd_barrier_post((unsigned*)(ws + WS_BAR), (volatile LAS unsigned*)(lds + LDS_BYTES - 16));
    }
#define PH_BEGIN(k) if (p.ph_lo <= (k) && (k) < p.ph_hi) { int tv = threadIdx.x; asm volatile("" : "+v"(tv)); (void)tv;
#define PH_END(k) if ((k) + 1 < p.ph_hi) xcd_barrier(bar); }
#define REPN(bit) (((DBG_REP >> (bit)) & 1) ? 2 : 1)

    float* const PSA = (float*)(ws + WS_RSTD);
    bf16_t* const H = (bf16_t*)(ws + WS_H);
    bf16_t* const O = (bf16_t*)(ws + WS_O);
    const float* const c64 = (const float*)(ws + WS_COS64); const float* const s64 = (const float*)(ws + WS_SIN64);
    const float* const c32 = (const float*)(ws + WS_COS32); const float* const s32 = (const float*)(ws + WS_SIN32);

    PH_BEGIN(0)
        int toff = 0;
        for (int rep = 0; rep < REPN(14); ++rep) {
        for (int j = 0; j < 2; ++j) {
            prep_wt<1>(p.hyb_w_in + (size_t)j * 1024 * 2760, 1024, 2760, (bf16_t*)(ws + WS_WEIN + j * SZ_WEIN), NE_IN, p.attn_norm + (2 * j) * 1024, toff, bid, nblk, tv);
            prep_wt<2>(p.hyb_w_out + (size_t)j * 1024 * 1024, 1024, 1024, (bf16_t*)(ws + WS_WEOUT + j * SZ_WSQ), 1024, nullptr, toff, bid, nblk, tv);
            prep_wt<3>(p.mla_w_in + (size_t)j * 1024 * 1056, 1024, 1056, (bf16_t*)(ws + WS_WMIN + j * SZ_WMIN), NM_IN, p.attn_norm + (2 * j + 1) * 1024, toff, bid, nblk, tv);
            prep_wt<4>(p.mla_w_uq + (size_t)j * 768 * 1536, 768, 1536, (bf16_t*)(ws + WS_WUQ + j * SZ_WUQ), 1536, p.mla_q_norm + j * 768, toff, bid, nblk, tv);
            prep_wt<2>(p.mla_w_ukv + (size_t)j * 256 * 2048, 256, 2048, (bf16_t*)(ws + WS_WUKV + j * SZ_WUKV), 2048, p.mla_kv_norm + j * 256, toff, bid, nblk, tv);
            prep_wt<2>(p.mla_w_out + (size_t)j * 1024 * 1024, 1024, 1024, (bf16_t*)(ws + WS_WMOUT + j * SZ_WSQ), 1024, nullptr, toff, bid, nblk, tv);
        }
        for (int j = 0; j < 4; ++j) prep_wt<2>(p.peer_w_q + (size_t)j * 1024 * 2048, 1024, 2048, (bf16_t*)(ws + WS_WPQ + j * SZ_WPQ), 2048, p.ffn_norm + j * 1024, toff, bid, nblk, tv);
        cvt_bf16(p.peer_sub_keys, (bf16_t*)(ws + WS_SUBK), (size_t)4 * 16 * 128 * 128, bid, nblk, tv);
        cvt_fp8(p.peer_u, ws + WS_U16, (size_t)4 * NEXP * 1024, TAB_SCALE, p.ffn_norm, bid, nblk, tv);
        cvt_fp8(p.peer_v, ws + WS_V16, (size_t)4 * NEXP * 1024, TAB_SCALE, nullptr, bid, nblk, tv);
        rope_tables(p.pos, (float*)(ws + WS_COS64), (float*)(ws + WS_SIN64), (float*)(ws + WS_COS32), (float*)(ws + WS_SIN32), bid, nblk, tv);
        x_to_stream(p.x, H, PSA, bid, nblk, tv);
        }
    PH_END(0)

#pragma unroll 1
    for (int L = 0; L < DEPTH_; ++L) {
        const int base = 1 + 12 * L, j = L >> 1;
        if ((L & 1) == 0) {
            bf16_t* PROJ = (bf16_t*)(ws + WS_P); bf16_t* vaT = (bf16_t*)(ws + WS_VT); bf16_t* vbT = (bf16_t*)(ws + WS_VT + 4 * MiB);
            float* IW = (float*)(ws + WS_IW); unsigned* MASK = (unsigned*)(ws + WS_MASK);
            PH_BEGIN(base + 0)
                gm::EpiEvenIn e{PROJ, vaT, vbT, IW, c64, s64, PSA};
                for (int rep = 0; rep < REPN(0); ++rep)
                gm::gemm_phase(H, 1024, (const bf16_t*)(ws + WS_WEIN + j * SZ_WEIN), T_, NE_IN, 1024, e, lds, bid, nblk);
            PH_END(base + 0)
            PH_BEGIN(base + 1)
                const at::Args aB{PROJ, PROJ, nullptr, vbT, nullptr, O};
                for (int rep = 0; rep < REPN(1); ++rep) {
                int kbh = -1;
                for (int u = bid; u < 1024; u += nblk) {
                    int tw = threadIdx.x; asm volatile("" : "+v"(tw));
                    const int i = u >> 7, bh = u & 127;
                    const int qt = (0x32451067 >> (4 * i)) & 7;
                    if (bh != kbh) { ab::moba_kmean(bh >> 3, bh & 7, 7, PROJ + C_KB, (char*)lds, tw); kbh = bh; }
                    ab::attn_unit<8, 1>(bh >> 3, bh & 7, qt, PROJ + C_QB, PROJ + C_KB, PROJ + C_VB, O + 512, nullptr, (char*)lds, tw);
                }
                }
                for (int rep = 0; rep < REPN(2); ++rep)
                for (int u = bid; u < 2048; u += nblk) {
                    int tw = threadIdx.x; asm volatile("" : "+v"(tw));
                    const int b = u & 15, g = u >> 4, k = g >> 4, gl = g & 15;
                    const int qt16 = 16 * (7 - k) + ((k & 1) ? gl : 15 - gl);
                    ix::indexer_unit(PROJ, IW, MASK, b, qt16, lds, tw);
                }
            PH_END(base + 1)
            PH_BEGIN(base + 2)
                const at::Args aA{PROJ, PROJ, nullptr, vaT, MASK, O};
                for (int rep = 0; rep < REPN(3); ++rep)
                for (int u = bid; u < 1024; u += nblk) {
                    int tw = threadIdx.x; asm volatile("" : "+v"(tw));
                    const int k = u >> 8, c = u & 255, b = c >> 4, jj = c & 15;
                    const int qt = (k == 0) ? 63 - jj : (k == 1) ? 32 + jj : (k == 2) ? 31 - jj : jj;
                    ab::attn_unit<8, 2>(b, 0, qt, PROJ + C_QA, PROJ + C_KA, PROJ + C_VA, O, MASK, (char*)lds, tw);
                }
            PH_END(base + 2)
            PH_BEGIN(base + 4)
                {
                gm::EpiResid e{H, (float*)(ws + WS_PSF), nullptr};
                gm::gemm_phase(O, 1024, (const bf16_t*)(ws + WS_WEOUT + j * SZ_WSQ), T_, 1024, 1024, e, lds, bid, nblk); }
            PH_END(base + 4)
        } else {
            bf16_t* CIN = (bf16_t*)(ws + WS_P_CIN); bf16_t* QM = (bf16_t*)(ws + WS_P_QM); bf16_t* KN = (bf16_t*)(ws + WS_P_KN); bf16_t* vT = (bf16_t*)(ws + WS_VT);
            float* RSTD = (float*)(ws + WS_MASK);
            PH_BEGIN(base + 0)
                gm::EpiMlaIn e{CIN, c32, s32, RSTD, PSA};
                for (int rep = 0; rep < REPN(0); ++rep)
                gm::gemm_phase(H, 1024, (const bf16_t*)(ws + WS_WMIN + j * SZ_WMIN), T_, 1024, 1024, e, lds, bid, nblk);
            PH_END(base + 0)
            PH_BEGIN(base + 2)
                for (int rep = 0; rep < REPN(5); ++rep) {
                mla_krope_units(H, (const bf16_t*)(ws + WS_WMIN + j * SZ_WMIN) + (size_t)1024 * 1024, PSA, c32, s32, CIN, bid, nblk, tv);
                { gm::EpiQup e{QM, RSTD, c32, s32, RSTD};
                  gm::gemm_phase(CIN, NM_IN, (const bf16_t*)(ws + WS_WUQ + j * SZ_WUQ), T_, 1536, 768, e, lds, bid, nblk); }
                { gm::EpiKVup e{KN, vT, RSTD, RSTD};
                  gm::gemm_phase(CIN + 768, NM_IN, (const bf16_t*)(ws + WS_WUKV + j * SZ_WUKV), T_, 2048, 256, e, lds, bid, nblk); } }
            PH_END(base + 2)
            PH_BEGIN(base + 3)
                const at::Args aC{QM, KN, CIN, vT, nullptr, O};
                for (int rep = 0; rep < REPN(6); ++rep)
                for (int u = bid; u < 2048; u += nblk) {
                    int tw = threadIdx.x; asm volatile("" : "+v"(tw));
                    const int i = u >> 8, bh = u & 255;
                    am::attn_unit<8>(bh >> 4, bh & 15, 7 - i, QM, KN, CIN, vT, O, (char*)lds, tw);
                }
            PH_END(base + 3)
            PH_BEGIN(base + 4)
                {
                gm::EpiResid e{H, (float*)(ws + WS_PSF), nullptr};
                gm::gemm_phase(O, 1024, (const bf16_t*)(ws + WS_WMOUT + j * SZ_WSQ), T_, 1024, 1024, e, lds, bid, nblk); }
            PH_END(base + 4)
        }
        bf16_t* QP = (bf16_t*)(ws + WS_P);
        unsigned short* RE = (unsigned short*)(ws + WS_RE); float* RG = (float*)(ws + WS_RG);
        PH_BEGIN(base + 6)
            gm::EpiBf16 e{QP, 2048, (const float*)(ws + WS_PSF)};
            for (int rep = 0; rep < REPN(9); ++rep)
            gm::gemm_phase(H, 1024, (const bf16_t*)(ws + WS_WPQ + L * SZ_WPQ), T_, 2048, 1024, e, lds, bid, nblk);
        PH_END(base + 6)
        PH_BEGIN(base + 7)
            const int w = tv >> 6;
            for (int rep = 0; rep < REPN(10); ++rep)
            for (int u = bid; u < T_ / 128; u += nblk) { int tw = threadIdx.x; asm volatile("" : "+v"(tw)); pr::route_block(QP, (const bf16_t*)(ws + WS_SUBK + L * SZ_SUBK), RE, RG, u, lds, tw); }
        PH_END(base + 7)
        bf16_t* PD = (bf16_t*)(ws + WS_P);
        PH_BEGIN(base + 8)
            const int w = tv >> 6, ngrp = nblk >> 3, slice = bid & 7, rank = bid >> 3;
            if (rank < ngrp)
            for (int rep = 0; rep < REPN(11); ++rep)
            pr::peer_u_loop(H, ws + WS_U16 + L * SZ_TAB, RE, PD, rank * 8 + w, ngrp * 8, slice, tv & 63);
        PH_END(base + 8)
        PH_BEGIN(base + 9)
            const int w = tv >> 6;
            for (int t = (bid * 8 + w) * 4; t < T_; t += nblk * 32) pr::peer_combine(PD, RG, (const float*)(ws + WS_PSF), t, tv & 63);
        PH_END(base + 9)
        PH_BEGIN(base + 10)
            const int w = tv >> 6, ngrp = nblk >> 3, slice = bid & 7, rank = bid >> 3;
            if (rank < ngrp)
            pr::peer_v_loop(H, PSA, ws + WS_V16 + L * SZ_TAB, RE, RG, rank * 8 + w, ngrp * 8, slice, tv & 63);
        PH_END(base + 10)
        if (L + 1 == DEPTH_) {
        PH_BEGIN(base + 11)
            final_norm_rows(H, p.final_norm, p.out, bid, nblk, tv);
        PH_END(base + 11)
        }
    }
#undef PH_BEGIN
#undef PH_END
}

extern "C" void kernel_launch(void* const* d_in, const int* in_sizes, int n_in, void* d_out, int out_size, void* d_ws, size_t ws_size, hipStream_t stream) {
    static int grid = 0;
    if (grid == 0) {
        if (n_in != 17 || out_size != T_ * D_ || ws_size < WS_END) { fprintf(stderr, "kernel_launch: unexpected shapes (n_in %d out %d ws %zu need %zu)\n", n_in, out_size, ws_size, (size_t)WS_END); grid = -1; return; }
        int dev = 0, cus = 0, per_cu = 0;
        if (hipGetDevice(&dev) != hipSuccess || hipDeviceGetAttribute(&cus, hipDeviceAttributeMultiprocessorCount, dev) != hipSuccess) { grid = -1; return; }
        if (hipFuncSetAttribute((const void*)k_main, hipFuncAttributeMaxDynamicSharedMemorySize, LDS_BYTES) != hipSuccess) { fprintf(stderr, "kernel_launch: hipFuncSetAttribute failed\n"); grid = -1; return; }
        if (hipOccupancyMaxActiveBlocksPerMultiprocessor(&per_cu, (const void*)k_main, NTHR, LDS_BYTES) != hipSuccess || per_cu < 1) { fprintf(stderr, "kernel_launch: occupancy query says %d\n", per_cu); per_cu = 1; }
        (void)hipGetLastError();
        grid = cus;
    }
    if (grid < 0) return;
    (void)hipMemsetAsync((char*)d_ws + WS_BAR, 0, XCD_BAR_WORDS * sizeof(unsigned), stream);
    Params p{};
    p.x = (const float*)d_in[0]; p.pos = (const int*)d_in[1]; p.attn_norm = (const float*)d_in[2]; p.ffn_norm = (const float*)d_in[3]; p.final_norm = (const float*)d_in[4];
    p.hyb_w_in = (const float*)d_in[5]; p.hyb_w_out = (const float*)d_in[6]; p.mla_w_in = (const float*)d_in[7]; p.mla_q_norm = (const float*)d_in[8]; p.mla_kv_norm = (const float*)d_in[9];
    p.mla_w_uq = (const float*)d_in[10]; p.mla_w_ukv = (const float*)d_in[11]; p.mla_w_out = (const float*)d_in[12]; p.peer_w_q = (const float*)d_in[13]; p.peer_sub_keys = (const float*)d_in[14];
    p.peer_u = (const float*)d_in[15]; p.peer_v = (const float*)d_in[16];
    p.out = (float*)d_out; p.ws = (unsigned char*)d_ws;
#if MK_ONE_LAUNCH
    p.ph_lo = 0; p.ph_hi = NPHASE;
    hipLaunchKernelGGL(k_main, dim3(grid), dim3(NTHR), LDS_BYTES, stream, p);
#else
    for (int ph = 0; ph < NPHASE; ++ph) {
        if (ph > 0) { const int L = (ph - 1) / 12, slot = (ph - 1) % 12; if ((slot == 3 && (L & 1) == 0) || (slot == 1 && (L & 1) == 1) || slot == 5 || (slot == 11 && L + 1 < DEPTH_)) continue; }
        p.ph_lo = ph; p.ph_hi = ph + 1;
        hipLaunchKernelGGL(k_main, dim3(grid), dim3(NTHR), LDS_BYTES, stream, p);
    }
#endif
}
```

```cpp
#include <hip/hip_runtime.h>
#include <stdint.h>
#include <stdio.h>
#include <cmath>

#define DI __device__ __forceinline__
#ifndef DBG_REP
#define DBG_REP 0
#endif
#ifndef DBG_SKIP
#define DBG_SKIP 0
#endif
#define LAS __attribute__((address_space(3)))
typedef unsigned short bf16_t;
typedef short bf16x8 __attribute__((ext_vector_type(8)));
typedef short s16x4 __attribute__((ext_vector_type(4)));
typedef float f32x2 __attribute__((ext_vector_type(2)));
typedef float f32x4 __attribute__((ext_vector_type(4)));
typedef float f32x16 __attribute__((ext_vector_type(16)));
typedef unsigned u32x2 __attribute__((ext_vector_type(2)));
typedef unsigned u32x4 __attribute__((ext_vector_type(4)));
typedef __bf16 bf2_t __attribute__((ext_vector_type(2)));

constexpr int T_ = 32768, D_ = 1024, S_ = 2048, NB_ = 16, DEPTH_ = 4;
constexpr int NE_IN = 2816;
constexpr int NM_IN = 1280;
constexpr int NEXP = 16384;
constexpr int NTHR = 512;
constexpr int LDS_BYTES = 163840;
constexpr float LOG2E = 1.4426950408889634f;
constexpr float NEG_INF = -__builtin_inff();
constexpr float TAB_SCALE = 64.0f;

constexpr int C_QA = 0, C_KA = 512, C_VA = 576, C_IQ = 640, C_IK = 1152, C_QB = 1216, C_KB = 1728, C_VB = 2240, C_IW = 2752;

constexpr size_t MiB = 1024 * 1024;
constexpr size_t WS_BAR = 0;
constexpr size_t WS_COS64 = 64 * 1024;
constexpr size_t WS_SIN64 = WS_COS64 + 4 * MiB;
constexpr size_t WS_COS32 = WS_SIN64 + 4 * MiB;
constexpr size_t WS_SIN32 = WS_COS32 + 2 * MiB;
constexpr size_t WS_WEIN = WS_SIN32 + 2 * MiB;
constexpr size_t SZ_WEIN = (size_t)NE_IN * 1024 * 2;
constexpr size_t WS_WEOUT = WS_WEIN + 2 * SZ_WEIN;
constexpr size_t SZ_WSQ = (size_t)1024 * 1024 * 2;
constexpr size_t WS_WMIN = WS_WEOUT + 2 * SZ_WSQ;
constexpr size_t SZ_WMIN = (size_t)NM_IN * 1024 * 2;
constexpr size_t WS_WUQ = WS_WMIN + 2 * SZ_WMIN;
constexpr size_t SZ_WUQ = (size_t)1536 * 768 * 2;
constexpr size_t WS_WUKV = WS_WUQ + 2 * SZ_WUQ;
constexpr size_t SZ_WUKV = (size_t)2048 * 256 * 2;
constexpr size_t WS_WMOUT = WS_WUKV + 2 * SZ_WUKV;
constexpr size_t WS_WPQ = WS_WMOUT + 2 * SZ_WSQ;
constexpr size_t SZ_WPQ = (size_t)2048 * 1024 * 2;
constexpr size_t WS_SUBK = WS_WPQ + 4 * SZ_WPQ;
constexpr size_t SZ_SUBK = (size_t)16 * 128 * 128 * 2;
constexpr size_t WS_U16 = WS_SUBK + 4 * SZ_SUBK;
constexpr size_t SZ_TAB = (size_t)NEXP * 1024;
constexpr size_t WS_V16 = WS_U16 + 4 * SZ_TAB;
constexpr size_t WS_X = WS_V16 + 4 * SZ_TAB;
constexpr size_t WS_H = WS_X + 128 * MiB;
constexpr size_t WS_O = WS_H + 64 * MiB;
constexpr size_t WS_P = WS_O + 64 * MiB;
constexpr size_t WS_P_CIN = WS_P;
constexpr size_t WS_P_QM = WS_P + 80 * MiB;
constexpr size_t WS_P_KN = WS_P + 176 * MiB;
constexpr size_t WS_VT = WS_P + 240 * MiB;
constexpr size_t WS_MASK = WS_VT + 64 * MiB;
constexpr size_t WS_IW = WS_MASK + 8 * MiB;
constexpr size_t WS_RSTD = WS_IW + 1 * MiB;
constexpr size_t WS_RE = WS_RSTD + 1 * MiB;
constexpr size_t WS_RG = WS_RE + 16 * MiB;
constexpr size_t WS_PSF = WS_RG + 16 * MiB;
constexpr size_t WS_END = WS_PSF + 2 * MiB;

struct Params {
    const float* x; const int* pos; const float* attn_norm; const float* ffn_norm; const float* final_norm;
    const float* hyb_w_in; const float* hyb_w_out; const float* mla_w_in; const float* mla_q_norm; const float* mla_kv_norm;
    const float* mla_w_uq; const float* mla_w_ukv; const float* mla_w_out; const float* peer_w_q; const float* peer_sub_keys;
    const float* peer_u; const float* peer_v;
    float* out; unsigned char* ws;
    int ph_lo, ph_hi;
};

DI unsigned pk_bf16(float lo, float hi) { f32x2 v = {lo, hi}; bf2_t b = __builtin_convertvector(v, bf2_t); return __builtin_bit_cast(unsigned, b); }
DI bf16_t f2bf(float x) { return (bf16_t)(pk_bf16(x, 0.f) & 0xffffu); }
DI float bf_lo(unsigned u) { return __uint_as_float(u << 16); }
DI float bf_hi(unsigned u) { return __uint_as_float(u & 0xffff0000u); }
DI float wave_sum(float v) {
#pragma unroll
    for (int o = 32; o > 0; o >>= 1) v += __shfl_xor(v, o, 64);
    return v;
}
DI f32x16 mfma32(bf16x8 a, bf16x8 b, f32x16 c) { return __builtin_amdgcn_mfma_f32_32x32x16_bf16(a, b, c, 0, 0, 0); }
DI f32x16 zero16() { f32x16 z;
#pragma unroll
    for (int i = 0; i < 16; ++i) z[i] = 0.f; return z; }

#define XB_TMO      128
#define XB_XCNT(j)  (256  + 64 * (j))
#define XB_XSUB(j)  (1280 + 64 * (j))
#define XB_XGEN(j)  (2304 + 64 * (j))
#define XB_TOP      3328
#define XB_TOPGEN   3392
#define XCD_BAR_WORDS 3456
#define XB_SPIN_CAP (1u << 25)

DI unsigned xb_ld(unsigned* p)              { return __hip_atomic_load(p, __ATOMIC_RELAXED, __HIP_MEMORY_SCOPE_AGENT); }
DI unsigned xb_add(unsigned* p, unsigned v) { return __hip_atomic_fetch_add(p, v, __ATOMIC_RELAXED, __HIP_MEMORY_SCOPE_AGENT); }
DI unsigned xb_xcc_id() { return (unsigned)__builtin_amdgcn_s_getreg((3 << 11) | 20) & 0xFu; }
#define XB_SPIN(cond, bar) do { unsigned _sp = 0; while (cond) { __builtin_amdgcn_s_sleep(1); \
    if ((++_sp & 255u) == 0u) { if (xb_ld(&(bar)[XB_TMO])) break; if (_sp > XB_SPIN_CAP) { atomicAdd(&(bar)[XB_TMO], 1u); break; } } } } while (0)

struct XcdBarrier { unsigned* bar; unsigned x; volatile LAS unsigned* st; };

DI XcdBarrier xcd_barrier_post(unsigned* bar, volatile LAS unsigned* st) {
    XcdBarrier b; b.bar = bar; b.x = xb_xcc_id(); b.st = st;
    if (threadIdx.x == 0) (void)xb_add(&bar[XB_XCNT(b.x)], 1u);
    return b;
}
DI void xcd_barrier_complete(unsigned* bar, unsigned x, unsigned& nloc, unsigned& nx) {
    const unsigned G = gridDim.x * gridDim.y * gridDim.z;
    unsigned sum, cnt, mine, sp = 0u;
    for (;;) {
        sum = 0u; cnt = 0u; mine = 0u;
#pragma unroll
        for (unsigned j = 0; j < 16; ++j) { const unsigned c = xb_ld(&bar[XB_XCNT(j)]); sum += c; cnt += (c > 0u) ? 1u : 0u; mine = (j == x) ? c : mine; }
        if (sum == G) break;
        __builtin_amdgcn_s_sleep(1);
        if ((++sp & 255u) == 0u) { if (xb_ld(&bar[XB_TMO])) break; if (sp > XB_SPIN_CAP) { atomicAdd(&bar[XB_TMO], 1u); break; } }
    }
    nloc = mine > 0u ? mine : 1u; nx = cnt > 0u ? cnt : 1u;
}
DI void xcd_barrier(const XcdBarrier& b) {
    asm volatile("s_waitcnt vmcnt(0)" ::: "memory");
    __syncthreads();
    if (threadIdx.x == 0) {
        unsigned* bar = b.bar;
        __builtin_amdgcn_s_waitcnt(0);
        unsigned nloc = b.st[0], nx = b.st[1];
        if (nloc == 0u) { xcd_barrier_complete(bar, b.x, nloc, nx); b.st[0] = nloc; b.st[1] = nx; }
        const unsigned old = xb_add(&bar[XB_XSUB(b.x)], 1u);
        const unsigned gen = old / nloc;
        if (old + 1u == (gen + 1u) * nloc) {
            __builtin_amdgcn_fence(__ATOMIC_RELEASE, "agent");
            asm volatile("s_waitcnt vmcnt(0)" ::: "memory");
            const unsigned og = xb_add(&bar[XB_TOP], 1u);
            const unsigned tg = og / nx;
            if (og + 1u == (tg + 1u) * nx) xb_add(&bar[XB_TOPGEN], 1u);
            else XB_SPIN(xb_ld(&bar[XB_TOPGEN]) == tg, bar);
            __builtin_amdgcn_fence(__ATOMIC_ACQUIRE, "agent");
            xb_add(&bar[XB_XGEN(b.x)], 1u);
            asm volatile("s_waitcnt vmcnt(0)" ::: "memory");
        } else {
            XB_SPIN(xb_ld(&bar[XB_XGEN(b.x)]) == gen, bar);
            __builtin_amdgcn_fence(__ATOMIC_ACQUIRE, "agent");
            asm volatile("s_waitcnt vmcnt(0)" ::: "memory");
        }
    }
    __syncthreads();
}

DI int perm32(int rho) { return 8 * ((rho & 15) >> 2) + 4 * (rho >> 4) + (rho & 3); }
template <int MODE> DI int src_col(int np, int N) {
    if (MODE == 0) return np < N ? np : -1;
    if (MODE == 2) { const int c = (np & ~31) + perm32(np & 31); return c < N ? c : -1; }
    if (MODE == 3) { const int c = (np < 1024) ? (np & ~31) + perm32(np & 31) : np; return c < N ? c : -1; }
    if (MODE == 4) { const int c = (((np >> 5) % 3) == 2) ? np : (np & ~31) + perm32(np & 31); return c < N ? c : -1; }
    if (MODE == 5) { const int c = ((np >> 6) & 1) ? np : (np & ~31) + perm32(np & 31); return c < N ? c : -1; }
    const int tile = np >> 8, loc = np & 255, bj = loc >> 7, wc = (loc >> 5) & 3, n = (loc >> 4) & 1, ip = loc & 15;
    const int nat = tile * 256 + wc * 64 + bj * 32 + 8 * (ip >> 2) + 4 * n + (ip & 3);
    if (nat < 1216) return nat;
    if (nat < 2752) return nat + 8;
    if (nat < 2760) return nat - 2752 + 1216;
    return -1;
}
template <int MODE> DI void prep_wt(const float* W, int K, int N, bf16_t* WT, int Npad, const float* kscale, int& toff, int bid, int nblk, int tid) {
    const int tx = tid & 63, w = __builtin_amdgcn_readfirstlane(tid >> 6);
    const int ntn = Npad / 256, ntk = K / 16, nw = nblk * 8;
    int t = (bid * 8 + w - toff) % nw; if (t < 0) t += nw;
    toff = (toff + ntn * ntk) % nw;
    for (; t < ntn * ntk; t += nw) {
        const int n0 = (t % ntn) * 256 + 4 * tx, k0 = (t / ntn) * 16;
        const int sn = src_col<MODE>(n0, N);
        const float keep = (sn >= 0) ? 1.f : 0.f;
        const float* src = W + (size_t)k0 * N + (sn >= 0 ? sn : 0);
        f32x4 v[16];
#pragma unroll
        for (int kk = 0; kk < 16; ++kk) v[kk] = *(const f32x4*)(src + (size_t)kk * N);
#pragma unroll
        for (int kk = 0; kk < 16; ++kk) v[kk] *= (kscale ? kscale[k0 + kk] : 1.f) * keep;
#pragma unroll
        for (int r = 0; r < 4; ++r) {
            bf16_t* dst = WT + (size_t)(n0 + r) * K + k0;
#pragma unroll
            for (int h = 0; h < 2; ++h) {
                u32x4 o;
#pragma unroll
                for (int q = 0; q < 4; ++q) o[q] = pk_bf16(v[8 * h + 2 * q][r], v[8 * h + 2 * q + 1][r]);
                *(u32x4*)(dst + 8 * h) = o;
            }
        }
    }
}
DI void cvt_bf16(const float* src, bf16_t* dst, size_t n, int bid, int nblk, int tid) {
    const size_t n8 = n / 8;
    for (size_t i = (size_t)bid * NTHR + tid; i < n8; i += (size_t)nblk * NTHR) {
        const f32x4 a = *(const f32x4*)(src + i * 8), b = *(const f32x4*)(src + i * 8 + 4);
        u32x4 o; o[0] = pk_bf16(a[0], a[1]); o[1] = pk_bf16(a[2], a[3]); o[2] = pk_bf16(b[0], b[1]); o[3] = pk_bf16(b[2], b[3]);
        *(u32x4*)(dst + i * 8) = o;
    }
}
DI void cvt_fp8(const float* src, unsigned char* dst, size_t n, float scale, const float* colscale  , int bid, int nblk, int tid) {
    const size_t n16 = n / 16;
    for (size_t i = (size_t)bid * NTHR + tid; i < n16; i += (size_t)nblk * NTHR) {
        u32x4 o;
#pragma unroll
        for (int q = 0; q < 4; ++q) {
            f32x4 a = *(const f32x4*)(src + i * 16 + q * 4) * scale;
            if (colscale) a *= *(const f32x4*)(colscale + (i / ((size_t)NEXP * 64)) * 1024 + (i & 63) * 16 + q * 4);
            int w = 0;
            w = __builtin_amdgcn_cvt_pk_fp8_f32(a[0], a[1], w, false);
            w = __builtin_amdgcn_cvt_pk_fp8_f32(a[2], a[3], w, true);
            o[q] = (unsigned)w;
        }
        const size_t lay = i / ((size_t)NEXP * 64), rem = i % ((size_t)NEXP * 64), e = rem >> 6, ch = rem & 63;
        *(u32x4*)(dst + lay * ((size_t)NEXP * 1024) + (ch >> 3) * ((size_t)NEXP * 128) + e * 128 + (ch & 7) * 16) = o;
    }
}
DI void rope_tables(const int* pos, float* c64, float* s64, float* c32, float* s32, int bid, int nblk, int tid) {
    for (int i = bid * NTHR + tid; i < T_ * 48; i += nblk * NTHR) {
        const int t = i / 48, j = i % 48;
        const float p = (float)pos[t];
        const int k = (j < 32) ? j : j - 32;
        const float inv = exp2f(-(float)(2 * k) * ((j < 32) ? (13.287712379549449f / 64.0f) : (13.287712379549449f / 32.0f)));
        float sv, cv; sincosf(p * inv, &sv, &cv);
        if (j < 32) { c64[t * 32 + k] = cv; s64[t * 32 + k] = sv; } else { c32[t * 16 + k] = cv; s32[t * 16 + k] = sv; }
    }
}

DI void rmsnorm_rows(const float* x, const float* g, bf16_t* outb, float* outf, int bid, int nblk, int tid) {
    const int lane = tid & 63, w = tid >> 6;
    f32x4 gv[4];
#pragma unroll
    for (int i = 0; i < 4; ++i) gv[i] = *(const f32x4*)(g + i * 256 + lane * 4);
    for (int row = bid * 8 + w; row < T_; row += nblk * 8) {
        const float* xr = x + (size_t)row * 1024;
        f32x4 v[4]; float ss = 0.f;
#pragma unroll
        for (int i = 0; i < 4; ++i) { v[i] = *(const f32x4*)(xr + i * 256 + lane * 4); ss += v[i][0] * v[i][0] + v[i][1] * v[i][1] + v[i][2] * v[i][2] + v[i][3] * v[i][3]; }
        ss = wave_sum(ss);
        const float rs = 1.0f / sqrtf(ss * (1.0f / 1024.0f) + 1e-6f);
#pragma unroll
        for (int i = 0; i < 4; ++i) {
            const f32x4 y = v[i] * rs * gv[i];
            if (outb) { u32x2 o; o[0] = pk_bf16(y[0], y[1]); o[1] = pk_bf16(y[2], y[3]); *(u32x2*)(outb + (size_t)row * 1024 + i * 256 + lane * 4) = o; }
            else *(f32x4*)(outf + (size_t)row * 1024 + i * 256 + lane * 4) = y;
        }
    }
}
DI void x_to_stream(const float* x, bf16_t* xb, float* psa, int bid, int nblk, int tid) {
    const int lane = tid & 63, w = tid >> 6;
    for (int row = bid * 8 + w; row < T_; row += nblk * 8) {
        const float* xr = x + (size_t)row * 1024 + lane * 16;
        f32x4 v[4]; float ss = 0.f;
#pragma unroll
        for (int i = 0; i < 4; ++i) { v[i] = *(const f32x4*)(xr + i * 4); ss += (v[i][0] * v[i][0] + v[i][1] * v[i][1]) + (v[i][2] * v[i][2] + v[i][3] * v[i][3]); }
        ss += __shfl_xor(ss, 1, 64); ss += __shfl_xor(ss, 2, 64); ss += __shfl_xor(ss, 4, 64);
        u32x4 o0, o1;
        o0[0] = pk_bf16(v[0][0], v[0][1]); o0[1] = pk_bf16(v[0][2], v[0][3]); o0[2] = pk_bf16(v[1][0], v[1][1]); o0[3] = pk_bf16(v[1][2], v[1][3]);
        o1[0] = pk_bf16(v[2][0], v[2][1]); o1[1] = pk_bf16(v[2][2], v[2][3]); o1[2] = pk_bf16(v[3][0], v[3][1]); o1[3] = pk_bf16(v[3][2], v[3][3]);
        bf16_t* dst = xb + (size_t)row * 1024 + lane * 16;
        *(u32x4*)dst = o0; *(u32x4*)(dst + 8) = o1;
        if ((lane & 7) == 0) psa[(size_t)row * 8 + (lane >> 3)] = ss;
    }
}
DI void final_norm_rows(const bf16_t* xb, const float* g, float* out, int bid, int nblk, int tid) {
    const int lane = tid & 63, w = tid >> 6;
    f32x4 gv[4];
#pragma unroll
    for (int i = 0; i < 4; ++i) gv[i] = *(const f32x4*)(g + lane * 16 + i * 4);
    for (int row = bid * 8 + w; row < T_; row += nblk * 8) {
        const bf16_t* xr = xb + (size_t)row * 1024 + lane * 16;
        const u32x4 a = *(const u32x4*)xr, b = *(const u32x4*)(xr + 8);
        f32x4 v[4];
#pragma unroll
        for (int q = 0; q < 2; ++q) { v[0][2 * q] = bf_lo(a[q]); v[0][2 * q + 1] = bf_hi(a[q]); v[1][2 * q] = bf_lo(a[2 + q]); v[1][2 * q + 1] = bf_hi(a[2 + q]);
                                      v[2][2 * q] = bf_lo(b[q]); v[2][2 * q + 1] = bf_hi(b[q]); v[3][2 * q] = bf_lo(b[2 + q]); v[3][2 * q + 1] = bf_hi(b[2 + q]); }
        float ss = 0.f;
#pragma unroll
        for (int i = 0; i < 4; ++i) ss += (v[i][0] * v[i][0] + v[i][1] * v[i][1]) + (v[i][2] * v[i][2] + v[i][3] * v[i][3]);
        ss = wave_sum(ss);
        const float rs = 1.0f / sqrtf(ss * (1.0f / 1024.0f) + 1e-6f);
#pragma unroll
        for (int i = 0; i < 4; ++i) *(f32x4*)(out + (size_t)row * 1024 + lane * 16 + i * 4) = v[i] * rs * gv[i];
    }
}
DI void mla_stats(const bf16_t* cin, float* rstd, int bid, int nblk, int tid) {
    const int lane = tid & 63, w = tid >> 6;
    for (int row = bid * 8 + w; row < T_; row += nblk * 8) {
        const bf16_t* r = cin + (size_t)row * NM_IN;
        const u32x4 a = *(const u32x4*)(r + lane * 8), b = *(const u32x4*)(r + 512 + lane * 8);
        float sa = 0.f, sb = 0.f;
#pragma unroll
        for (int i = 0; i < 4; ++i) { float lo = bf_lo(a[i]), hi = bf_hi(a[i]); sa += lo * lo + hi * hi; lo = bf_lo(b[i]); hi = bf_hi(b[i]); sb += lo * lo + hi * hi; }
        float sq = sa + (lane < 32 ? sb : 0.f), skv = (lane < 32 ? 0.f : sb);
        sq = wave_sum(sq); skv = wave_sum(skv);
        if (lane == 0) { rstd[row * 2] = 1.0f / sqrtf(sq * (1.0f / 768.0f) + 1e-6f); rstd[row * 2 + 1] = 1.0f / sqrtf(skv * (1.0f / 256.0f) + 1e-6f); }
    }
}

DI void gm_st_bf4(bf16_t* p, f32x4 v) { u32x2 o; o[0] = pk_bf16(v[0], v[1]); o[1] = pk_bf16(v[2], v[3]); *(u32x2*)p = o; }
DI void mla_krope_units(const bf16_t* xb, const bf16_t* wkr  , const float* psa, const float* c32, const float* s32, bf16_t* cin, int bid, int nblk, int tid) {
    const int w = __builtin_amdgcn_readfirstlane(tid >> 6), lane = tid & 63, r = lane & 31, hf = lane >> 5;
    for (int u = bid + w * nblk; u < T_ / 32; u += 8 * nblk) {
        const int t = u * 32 + r;
        const bf16_t* xp = xb + (size_t)t * 1024 + hf * 8;
        const bf16_t* wp = wkr + (size_t)r * 1024 + hf * 8;
        f32x16 acc = zero16(), acc2 = zero16();
#pragma unroll 1
        for (int k8 = 0; k8 < 8; ++k8) {
            bf16x8 xa[8], wa[8];
#pragma unroll
            for (int ks = 0; ks < 8; ++ks) { xa[ks] = *(const bf16x8*)(xp + (k8 * 8 + ks) * 16); wa[ks] = *(const bf16x8*)(wp + (k8 * 8 + ks) * 16); }
#pragma unroll
            for (int ks = 0; ks < 8; ++ks) { if (ks & 1) acc2 = mfma32(wa[ks], xa[ks], acc2); else acc = mfma32(wa[ks], xa[ks], acc); }
        }
        const f32x4 p0 = *(const f32x4*)(psa + (size_t)t * 8), p1 = *(const f32x4*)(psa + (size_t)t * 8 + 4);
        const float rs = 1.0f / sqrtf((((p0[0] + p0[1]) + (p0[2] + p0[3])) + ((p1[0] + p1[1]) + (p1[2] + p1[3]))) * (1.0f / 1024.0f) + 1e-6f);
#pragma unroll
        for (int q = 0; q < 2; ++q) {
            const int c0 = 8 * q + 4 * hf;
            const f32x4 cs = *(const f32x4*)(c32 + (size_t)t * 16 + c0), sn = *(const f32x4*)(s32 + (size_t)t * 16 + c0);
            f32x4 a, b;
#pragma unroll
            for (int jj = 0; jj < 4; ++jj) { a[jj] = (acc[4 * q + jj] + acc2[4 * q + jj]) * rs; b[jj] = (acc[8 + 4 * q + jj] + acc2[8 + 4 * q + jj]) * rs; }
            bf16_t* dst = cin + (size_t)t * NM_IN + 1024 + c0;
            gm_st_bf4(dst, a * cs - b * sn); gm_st_bf4(dst + 16, a * sn + b * cs);
        }
    }
}

namespace gm {
constexpr int BM = 256, BK = 64, HALF = 128, NXCD = 8, WGM = 8, HT = HALF * BK;
DI int lds_byte(int r, int c) { int st = (r >> 4) * 2 + (c >> 5), rr = r & 15, cc = c & 31, ob = rr * 64 + cc * 2; return st * 1024 + (ob ^ (((ob >> 9) & 1) << 5)); }
DI void stage_rc(int b, int& R, int& C) { int st = b / 1024, sb = b % 1024, swz = sb ^ (((sb >> 9) & 1) << 5); R = (st >> 1) * 16 + swz / 64; C = (st & 1) * 32 + (swz % 64) / 2; }

template <class Epi>
DI void gemm_phase(const bf16_t* A, int lda, const bf16_t* Bt, int M, int N, int K, const Epi& epi, unsigned char* ldsraw, int bid, int nblk) {
    bf16_t* shm = (bf16_t*)ldsraw;
#define SA(b, h) (shm + ((b) * 2 + (h)) * HT)
#define SB(b, h) (shm + (4 + (b) * 2 + (h)) * HT)
#define STAGE_X(T, P, BASE, LD, br, kt) do { long _g = (long)(br) * (LD) + (long)(kt) * BK; \
    for (int _i = 0; _i < 2; ++_i) { int _b = (T) * 16 + _i * 8192; int _r, _c; stage_rc(_b, _r, _c); \
      __builtin_amdgcn_global_load_lds((const unsigned*)((BASE) + _g + (long)_r * (LD) + _c), \
        (unsigned*)((char*)(P) + _b), 16, 0, 0); } } while (0)
#define STAGE_A(P, br, kt) STAGE_X(tv, P, A, lda, br, kt)
#define STAGE_B(P, br, kt) STAGE_X(tv, P, Bt, K, br, kt)
#define LDA(dst, b, h) for (int m = 0; m < 4; ++m) for (int k = 0; k < 2; ++k) \
    dst[m][k] = *reinterpret_cast<const bf16x8*>((char*)SA(b, h) + lds_byte(wr * 64 + m * 16 + fr, k * 32 + fq * 8))
#define LDB(dst, b, h) for (int n = 0; n < 2; ++n) for (int k = 0; k < 2; ++k) \
    dst[n][k] = *reinterpret_cast<const bf16x8*>((char*)SB(b, h) + lds_byte(wc * 32 + n * 16 + fr, k * 32 + fq * 8))
#define MMA(ai, bj, At_, Bt_) do { __builtin_amdgcn_s_setprio(1); \
    for (int m = 0; m < 4; ++m) for (int n = 0; n < 2; ++n) for (int k = 0; k < 2; ++k) \
      acc[ai][bj][m][n] = __builtin_amdgcn_mfma_f32_16x16x32_bf16(Bt_[n][k], At_[m][k], acc[ai][bj][m][n], 0, 0, 0); \
    __builtin_amdgcn_s_setprio(0); } while (0)
#define WAIT_V(n) asm volatile("s_waitcnt vmcnt(" #n ")" ::: "memory")
#define WAIT_L(n) asm volatile("s_waitcnt lgkmcnt(" #n ")" ::: "memory")
#define BAR __builtin_amdgcn_s_barrier()
#define SCHED __builtin_amdgcn_sched_barrier(0)
    const int nM = M / BM, nN = N / BM, nwg = nM * nN, nt = K / BK;
    for (int it = 0;; ++it) {
        const long L = (long)it * nblk + bid;
        if (L >= nwg) break;
        int wgid = (int)L;
        { int q = nwg / NXCD, r = nwg % NXCD, xcd = wgid % NXCD, off = wgid / NXCD; wgid = (xcd < r ? xcd * (q + 1) : r * (q + 1) + (xcd - r) * q) + off; }
        const int nig = WGM * nN, gid = wgid / nig, fm = gid * WGM, gsz = min(nM - fm, WGM);
        const int pm = fm + ((wgid % nig) % gsz), pn = (wgid % nig) / gsz, brow = pm * BM, bcol = pn * BM;
        int tv = threadIdx.x; asm volatile("" : "+v"(tv));
        int wid = tv >> 6, lane = tv & 63, wr = wid >> 2, wc = wid & 3, fr = lane & 15, fq = lane >> 4;
        f32x4 acc[2][2][4][2] = {};
        bf16x8 At[4][2], B0[2][2], B1[2][2];
        f32x4 q0 = {0.f, 0.f, 0.f, 0.f}, q1 = {0.f, 0.f, 0.f, 0.f};
        if (epi.psa && tv < 256) {
            const float* pp = epi.psa + ((size_t)brow + tv) * Epi::PS_STRIDE + Epi::PS_FIRST;
            q0 = *(const f32x4*)pp;
            if (Epi::PS_COUNT >= 8) q1 = *(const f32x4*)(pp + 4);
            if (Epi::PS_COUNT >= 12) q0 += *(const f32x4*)(pp + 8);
            if (Epi::PS_COUNT >= 16) q1 += *(const f32x4*)(pp + 12);
        }
        STAGE_B(SB(0, 0), bcol, 0); STAGE_A(SA(0, 0), brow, 0);
        STAGE_B(SB(0, 1), bcol + HALF, 0); STAGE_A(SA(0, 1), brow + HALF, 0);
        if (wr == 1) BAR;
        WAIT_V(4); BAR;
        STAGE_B(SB(1, 0), bcol, 1); STAGE_A(SA(1, 0), brow, 1); STAGE_B(SB(1, 1), bcol + HALF, 1);
        WAIT_V(6); BAR;
        if (epi.psa && tv < 256)
            *(LAS float*)((LAS unsigned char*)ldsraw + 131072 + (it & 1) * 1024 + tv * 4) = 1.0f / sqrtf((((q0[0] + q0[1]) + (q0[2] + q0[3])) + ((q1[0] + q1[1]) + (q1[2] + q1[3]))) * (1.0f / (float)Epi::PS_DIV) + 1e-6f);
        for (int t = 0; t < nt - 2; t += 2) {
            LDB(B0, 0, 0); SCHED; LDA(At, 0, 0); STAGE_A(SA(1, 1), brow + HALF, t + 1);
            WAIT_L(8); BAR; WAIT_L(0); MMA(0, 0, At, B0); BAR; SCHED;
            LDB(B1, 0, 1); STAGE_B(SB(0, 0), bcol, t + 2);
            BAR; WAIT_L(0); MMA(0, 1, At, B1); BAR;
            LDA(At, 0, 1); STAGE_A(SA(0, 0), brow, t + 2);
            BAR; WAIT_L(0); MMA(1, 0, At, B0); BAR; SCHED;
            STAGE_B(SB(0, 1), bcol + HALF, t + 2);
            WAIT_V(6); BAR; MMA(1, 1, At, B1); BAR;
            LDB(B0, 1, 0); SCHED; LDA(At, 1, 0); STAGE_A(SA(0, 1), brow + HALF, t + 2);
            WAIT_L(8); BAR; WAIT_L(0); MMA(0, 0, At, B0); BAR; SCHED;
            LDB(B1, 1, 1); STAGE_B(SB(1, 0), bcol, t + 3);
            BAR; WAIT_L(0); MMA(0, 1, At, B1); BAR;
            LDA(At, 1, 1); STAGE_A(SA(1, 0), brow, t + 3);
            BAR; WAIT_L(0); MMA(1, 0, At, B0); BAR; SCHED;
            STAGE_B(SB(1, 1), bcol + HALF, t + 3);
            WAIT_V(6); BAR; MMA(1, 1, At, B1); BAR;
        }
        int tz = threadIdx.x; asm volatile("" : "+v"(tz)); wid = tz >> 6; lane = tz & 63; wr = wid >> 2; wc = wid & 3; fr = lane & 15; fq = lane >> 4;
        { LDB(B0, 0, 0); WAIT_V(0); LDA(At, 0, 0); STAGE_X(tz, SA(1, 1), A, lda, brow + HALF, nt - 1);
          BAR; WAIT_L(0); MMA(0, 0, At, B0); BAR;
          LDB(B1, 0, 1); BAR; WAIT_L(0); MMA(0, 1, At, B1); BAR;
          LDA(At, 0, 1); WAIT_V(4); BAR; WAIT_L(0); MMA(1, 0, At, B0); MMA(1, 1, At, B1); BAR; }
        { LDB(B0, 1, 0); LDA(At, 1, 0); WAIT_V(2); BAR; WAIT_L(0); MMA(0, 0, At, B0); BAR;
          LDB(B1, 1, 1); WAIT_V(0); BAR; WAIT_L(0); MMA(0, 1, At, B1); BAR;
          LDA(At, 1, 1); BAR; WAIT_L(0); MMA(1, 0, At, B0); MMA(1, 1, At, B1); BAR; }
        if (wr == 0) BAR;
        { int ty = threadIdx.x; asm volatile("" : "+v"(ty)); const int wid2 = ty >> 6, lane2 = ty & 63;
          if (epi.psa) {
#pragma unroll
              for (int ai = 0; ai < 2; ++ai)
#pragma unroll
                  for (int m = 0; m < 4; ++m) {
                      const float rs = *(const LAS float*)((LAS unsigned char*)ldsraw + 131072 + (it & 1) * 1024 + (ai * 128 + (wid2 >> 2) * 64 + m * 16 + (lane2 & 15)) * 4);
#pragma unroll
                      for (int bj = 0; bj < 2; ++bj)
#pragma unroll
                          for (int n = 0; n < 2; ++n) acc[ai][bj][m][n] *= rs;
                  }
          }
          epi(acc, pm, pn, wid2 >> 2, wid2 & 3, lane2 & 15, lane2 >> 4); }
    }
#undef SA
#undef SB
#undef STAGE_X
#undef STAGE_A
#undef STAGE_B
#undef LDA
#undef LDB
#undef MMA
#undef WAIT_V
#undef WAIT_L
#undef BAR
#undef SCHED
}

DI void st_bf4(bf16_t* p, f32x4 v) { u32x2 o; o[0] = pk_bf16(v[0], v[1]); o[1] = pk_bf16(v[2], v[3]); *(u32x2*)p = o; }
DI void st_bf8(bf16_t* p, f32x4 a, f32x4 b) { u32x4 o; o[0] = pk_bf16(a[0], a[1]); o[1] = pk_bf16(a[2], a[3]); o[2] = pk_bf16(b[0], b[1]); o[3] = pk_bf16(b[2], b[3]); *(u32x4*)p = o; }

struct EpiEvenIn {
    static constexpr int PS_STRIDE = 8, PS_FIRST = 0, PS_COUNT = 8, PS_DIV = 1024;
    bf16_t* proj; bf16_t* vaT; bf16_t* vbT; float* iw; const float* c64; const float* s64; const float* psa;
    DI void operator()(const f32x4 (&acc)[2][2][4][2], int pm, int pn, int wr, int wc, int fr, int fq) const {
        const float qscale = 0.125f * LOG2E;
        const int g = pn * 4 + wc, d0 = 8 * fq;
        const int kind = (g < 8 || (g >= 19 && g < 27)) ? 0 : (g == 9) ? 2 : (g >= 35 && g < 43) ? 3 : (g == 43) ? 4 : (g > 43) ? 5 : 1;
#pragma unroll
        for (int ai = 0; ai < 2; ++ai)
#pragma unroll
            for (int m = 0; m < 4; ++m) {
                const int t = pm * 256 + ai * 128 + wr * 64 + m * 16 + fr;
                if (kind <= 1) {
                    f32x4 y0[2], y1[2];
#pragma unroll
                    for (int n = 0; n < 2; ++n) {
                        const f32x4 c = *(const f32x4*)(c64 + (size_t)t * 32 + d0 + 4 * n), sn = *(const f32x4*)(s64 + (size_t)t * 32 + d0 + 4 * n);
                        const f32x4 v0 = acc[ai][0][m][n], v1 = acc[ai][1][m][n];
                        y0[n] = v0 * c - v1 * sn; y1[n] = v0 * sn + v1 * c;
                        if (kind == 0) { y0[n] *= qscale; y1[n] *= qscale; }
                    }
                    bf16_t* dst = proj + (size_t)t * NE_IN + g * 64 + d0;
                    st_bf8(dst, y0[0], y0[1]); st_bf8(dst + 32, y1[0], y1[1]);
                } else if (kind == 2 || kind == 3) {
                    bf16_t* dst = proj + (size_t)t * NE_IN + g * 64 + d0;
                    st_bf8(dst, acc[ai][0][m][0], acc[ai][0][m][1]); st_bf8(dst + 32, acc[ai][1][m][0], acc[ai][1][m][1]);
                } else if (kind == 4) {
                    if (fq == 0) { *(f32x4*)(iw + (size_t)t * 8) = acc[ai][0][m][0]; *(f32x4*)(iw + (size_t)t * 8 + 4) = acc[ai][0][m][1]; }
                }
            }
    }
};
struct EpiMlaIn {
    static constexpr int PS_STRIDE = 8, PS_FIRST = 0, PS_COUNT = 8, PS_DIV = 1024;
    bf16_t* cin; const float* c32; const float* s32; float* ps; const float* psa;
    DI void operator()(const f32x4 (&acc)[2][2][4][2], int pm, int pn, int wr, int wc, int fr, int fq) const {
        if (pn < 4) {
#pragma unroll
            for (int ai = 0; ai < 2; ++ai)
#pragma unroll
                for (int m = 0; m < 4; ++m) {
                    float ss = 0.f;
#pragma unroll
                    for (int bj = 0; bj < 2; ++bj)
#pragma unroll
                        for (int n = 0; n < 2; ++n) { const f32x4 a = acc[ai][bj][m][n]; ss += a[0] * a[0] + a[1] * a[1] + a[2] * a[2] + a[3] * a[3]; }
                    ss += __shfl_xor(ss, 16, 64); ss += __shfl_xor(ss, 32, 64);
                    const int t = pm * 256 + ai * 128 + wr * 64 + m * 16 + fr;
                    if (fq == 0) ps[(size_t)t * 16 + pn * 4 + wc] = ss;
                }
        }
#pragma unroll
        for (int bj = 0; bj < 2; ++bj) {
            const int colbase = pn * 256 + bj * 128 + wc * 32;
            if (colbase > 1024) continue;
#pragma unroll
            for (int ai = 0; ai < 2; ++ai)
#pragma unroll
                for (int m = 0; m < 4; ++m) {
                    const int t = pm * 256 + ai * 128 + wr * 64 + m * 16 + fr;
                    if (colbase == 1024) {
                        const f32x4 c = *(const f32x4*)(c32 + (size_t)t * 16 + 4 * fq), sn = *(const f32x4*)(s32 + (size_t)t * 16 + 4 * fq);
                        const f32x4 a = acc[ai][bj][m][0], b = acc[ai][bj][m][1];
                        bf16_t* dst = cin + (size_t)t * NM_IN + colbase + 4 * fq;
                        st_bf4(dst, a * c - b * sn); st_bf4(dst + 16, a * sn + b * c);
                    } else st_bf8(cin + (size_t)t * NM_IN + colbase + 8 * fq, acc[ai][bj][m][0], acc[ai][bj][m][1]);
                }
        }
    }
};
struct EpiQup {
    static constexpr int PS_STRIDE = 16, PS_FIRST = 0, PS_COUNT = 12, PS_DIV = 768;
    bf16_t* qm; const float* rstd; const float* c32; const float* s32; const float* psa;
    DI void operator()(const f32x4 (&acc)[2][2][4][2], int pm, int pn, int wr, int wc, int fr, int fq) const {
        const float qscale = 0.10206207261596575f * LOG2E;
#pragma unroll
        for (int bj = 0; bj < 2; ++bj) {
            const int colbase = pn * 256 + bj * 128 + wc * 32;
            const bool rope = ((colbase >> 5) % 3) == 2;
#pragma unroll
            for (int ai = 0; ai < 2; ++ai)
#pragma unroll
                for (int m = 0; m < 4; ++m) {
                    const int t = pm * 256 + ai * 128 + wr * 64 + m * 16 + fr;
                    const float rs = qscale;
                    const f32x4 a = acc[ai][bj][m][0] * rs, b = acc[ai][bj][m][1] * rs;
                    if (rope) {
                        const f32x4 c = *(const f32x4*)(c32 + (size_t)t * 16 + 4 * fq), sn = *(const f32x4*)(s32 + (size_t)t * 16 + 4 * fq);
                        bf16_t* dst = qm + (size_t)t * 1536 + colbase + 4 * fq;
                        st_bf4(dst, a * c - b * sn); st_bf4(dst + 16, a * sn + b * c);
                    } else st_bf8(qm + (size_t)t * 1536 + colbase + 8 * fq, a, b);
                }
        }
    }
};
struct EpiKVup {
    static constexpr int PS_STRIDE = 16, PS_FIRST = 12, PS_COUNT = 4, PS_DIV = 256;
    bf16_t* kn; bf16_t* vn; const float* rstd; const float* psa;
    DI void operator()(const f32x4 (&acc)[2][2][4][2], int pm, int pn, int wr, int wc, int fr, int fq) const {
#pragma unroll
        for (int bj = 0; bj < 2; ++bj) {
            const int colbase = pn * 256 + bj * 128 + wc * 32;
            const int g = colbase >> 6, h = g >> 1, within = colbase & 63;
            const long dv = vn - kn;
            bf16_t* const dstb = kn + ((g & 1) ? dv : 0L) + h * 64 + within + 8 * fq;
#pragma unroll
            for (int ai = 0; ai < 2; ++ai)
#pragma unroll
                for (int m = 0; m < 4; ++m) {
                    const int t = pm * 256 + ai * 128 + wr * 64 + m * 16 + fr;
                    st_bf8(dstb + (size_t)t * 1024, acc[ai][bj][m][0], acc[ai][bj][m][1]);
                }
        }
    }
};
struct EpiResid {
    static constexpr int PS_STRIDE = 8, PS_FIRST = 0, PS_COUNT = 8, PS_DIV = 1024;
    bf16_t* xb; float* ps; const float* psa;
    DI void operator()(const f32x4 (&acc)[2][2][4][2], int pm, int pn, int wr, int wc, int fr, int fq) const {
#pragma unroll
        for (int ai = 0; ai < 2; ++ai)
#pragma unroll
            for (int m = 0; m < 4; ++m) {
                const size_t t = pm * 256 + ai * 128 + wr * 64 + m * 16 + fr;
                float ss = 0.f;
#pragma unroll
                for (int bj = 0; bj < 2; ++bj) {
                    bf16_t* px = xb + t * 1024 + pn * 256 + bj * 128 + wc * 32 + 8 * fq;
                    const u32x4 xo = *(const u32x4*)px;
                    const f32x4 a0 = acc[ai][bj][m][0], a1 = acc[ai][bj][m][1];
                    const f32x4 y0 = {bf_lo(xo[0]) + a0[0], bf_hi(xo[0]) + a0[1], bf_lo(xo[1]) + a0[2], bf_hi(xo[1]) + a0[3]};
                    const f32x4 y1 = {bf_lo(xo[2]) + a1[0], bf_hi(xo[2]) + a1[1], bf_lo(xo[3]) + a1[2], bf_hi(xo[3]) + a1[3]};
                    st_bf8(px, y0, y1);
                    ss += (y0[0] * y0[0] + y0[1] * y0[1]) + (y0[2] * y0[2] + y0[3] * y0[3]) + (y1[0] * y1[0] + y1[1] * y1[1]) + (y1[2] * y1[2] + y1[3] * y1[3]);
                }
                ss += __shfl_xor(ss, 16, 64); ss += __shfl_xor(ss, 32, 64);
                if (fq == 0) ps[t * 16 + pn * 4 + wc] = ss;
            }
    }
};
struct EpiBf16 {
    static constexpr int PS_STRIDE = 16, PS_FIRST = 0, PS_COUNT = 16, PS_DIV = 1024;
    bf16_t* out; int ld; const float* psa;
    DI void operator()(const f32x4 (&acc)[2][2][4][2], int pm, int pn, int wr, int wc, int fr, int fq) const {
#pragma unroll
        for (int ai = 0; ai < 2; ++ai)
#pragma unroll
            for (int m = 0; m < 4; ++m) {
                const size_t t = pm * 256 + ai * 128 + wr * 64 + m * 16 + fr;
#pragma unroll
                for (int bj = 0; bj < 2; ++bj) st_bf8(out + t * ld + pn * 256 + bj * 128 + wc * 32 + 8 * fq, acc[ai][bj][m][0], acc[ai][bj][m][1]);
            }
    }
};
}

namespace at {
constexpr int KT = 128, VROW = KT * 2 + 16;
template <int MODE> struct Cfg { static constexpr int DQK = (MODE == 0) ? 96 : 64, NKS = DQK / 16, KROW = DQK * 2 + 16, NCH = DQK / 8, NKL = KT * NCH / 512, KBYTES = KT * KROW, BUFSZ = KBYTES + 64 * VROW; };
struct Args { const bf16_t* q; const bf16_t* k; const bf16_t* k2; const bf16_t* vT; const unsigned* mask; bf16_t* o; };

template <int MODE>
DI void attn_unit(const Args& a, int b, int h, int qt, unsigned char* lds, int tid) {
    constexpr int DQK = Cfg<MODE>::DQK, NKS = Cfg<MODE>::NKS, KROW = Cfg<MODE>::KROW, NCH = Cfg<MODE>::NCH, NKL = Cfg<MODE>::NKL, KBYTES = Cfg<MODE>::KBYTES, BUFSZ = Cfg<MODE>::BUFSZ;
    const int w = __builtin_amdgcn_readfirstlane(tid >> 6), lane = tid & 63, r = lane & 31, hf = lane >> 5;
    int tq, qpos, wmin, wlast, nt;
    const bf16_t* qptr; bf16_t* optr;
    if (MODE == 2) {
        const int qloc = w * 4 + (r >> 3), head = r & 7;
        qpos = qt * 32 + qloc; tq = b * S_ + qpos; wmin = qt * 32 + w * 4; wlast = (qt * 32 + w * 4 + 3) >> 7; nt = ((qt * 32 + 31) >> 7) + 1;
        qptr = a.q + (size_t)tq * NE_IN + C_QA + head * 64; optr = a.o + (size_t)tq * 1024 + head * 64;
    } else {
        qpos = qt * 256 + w * 32 + r; tq = b * S_ + qpos; wmin = qt * 256 + w * 32; wlast = 2 * qt + (w >> 2); nt = 2 * (qt + 1);
        if (MODE == 0) { qptr = a.q + (size_t)tq * 1536 + h * 96; optr = a.o + (size_t)tq * 1024 + h * 64; }
        else { qptr = a.q + (size_t)tq * NE_IN + C_QB + h * 64; optr = a.o + (size_t)tq * 1024 + 512 + h * 64; }
    }
    bf16x8 qf[NKS];
#pragma unroll
    for (int ks = 0; ks < NKS; ++ks) qf[ks] = *(const bf16x8*)(qptr + ks * 16 + hf * 8);

    const bf16_t* kp[NKL]; size_t kstep[NKL]; int kdst[NKL];
#pragma unroll
    for (int j = 0; j < NKL; ++j) {
        const int idx = tid + 512 * j, kr = idx / NCH, kc = idx % NCH;
        kdst[j] = kr * KROW + kc * 16;
        if (MODE == 0) {
            if (kc < 8) { kp[j] = a.k + (size_t)(b * S_ + kr) * 1024 + h * 64 + kc * 8; kstep[j] = (size_t)KT * 1024; }
            else { kp[j] = a.k2 + (size_t)(b * S_ + kr) * NM_IN + 1024 + (kc - 8) * 8; kstep[j] = (size_t)KT * NM_IN; }
        } else { kp[j] = a.k + (size_t)(b * S_ + kr) * NE_IN + (MODE == 1 ? C_KB + h * 64 : C_KA) + kc * 8; kstep[j] = (size_t)KT * NE_IN; }
    }
    const bf16_t* vp[2]; int vdst[2];
#pragma unroll
    for (int j = 0; j < 2; ++j) {
        const int idx = tid + 512 * j, vd = idx >> 4, vc = idx & 15;
        vp[j] = a.vT + ((size_t)((MODE == 0) ? (b * 16 + h) : (MODE == 1) ? (b * 8 + h) : b) * 64 + vd) * S_ + vc * 8;
        vdst[j] = KBYTES + vd * VROW + (vc >> 1) * 32 + (vc & 1) * 8;
    }
    const unsigned* mp = (MODE == 2) ? a.mask + (size_t)tq * 64 : nullptr;

    unsigned blkmask = 0xffu;
    if (MODE == 1) {
        const int own = qt;
        float* kmw = (float*)(lds + 2 * BUFSZ); float* km = kmw + 7 * 8 * 64;
        {
            const int kc = lane & 7, kg = tid >> 3;
            const bf16_t* kb = a.k + (size_t)(b * S_ + kg * 4) * NE_IN + C_KB + h * 64 + kc * 8;
            u32x4 kv[7][4];
#pragma unroll
            for (int n = 0; n < 7; ++n) if (n < own) {
#pragma unroll
                for (int kk = 0; kk < 4; ++kk) kv[n][kk] = *(const u32x4*)(kb + (size_t)(n * 256 + kk) * NE_IN);
            }
#pragma unroll
            for (int n = 0; n < 7; ++n) if (n < own) {
                float sa[8];
#pragma unroll
                for (int e = 0; e < 8; ++e) sa[e] = 0.f;
#pragma unroll
                for (int kk = 0; kk < 4; ++kk)
#pragma unroll
                    for (int q = 0; q < 4; ++q) { sa[2 * q] += bf_lo(kv[n][kk][q]); sa[2 * q + 1] += bf_hi(kv[n][kk][q]); }
#pragma unroll
                for (int e = 0; e < 8; ++e) { sa[e] += __shfl_xor(sa[e], 8, 64); sa[e] += __shfl_xor(sa[e], 16, 64); sa[e] += __shfl_xor(sa[e], 32, 64); }
                if (lane < 8) { float* dst = kmw + (n * 8 + w) * 64 + kc * 8; *(f32x4*)dst = (f32x4){sa[0], sa[1], sa[2], sa[3]}; *(f32x4*)(dst + 4) = (f32x4){sa[4], sa[5], sa[6], sa[7]}; }
            }
        }
        __syncthreads();
        if (tid < own * 64) { const int n = tid >> 6, d = tid & 63; float sacc = 0.f;
#pragma unroll
            for (int ww = 0; ww < 8; ++ww) sacc += kmw[(n * 8 + ww) * 64 + d];
            km[n * 64 + d] = sacc * (1.0f / 256.0f); }
        __syncthreads();
        float gt[7];
#pragma unroll
        for (int n = 0; n < 7; ++n) {
            float g = 0.f;
            if (n < own) {
#pragma unroll
                for (int ks = 0; ks < NKS; ++ks)
#pragma unroll
                    for (int j = 0; j < 8; ++j) g += __uint_as_float((unsigned)(unsigned short)qf[ks][j] << 16) * km[n * 64 + ks * 16 + hf * 8 + j];
                g += __shfl_xor(g, 32, 64);
            }
            gt[n] = g;
        }
        blkmask = 1u << own;
#pragma unroll
        for (int n = 0; n < 7; ++n) {
            int rank = 0;
#pragma unroll
            for (int n2 = 0; n2 < 7; ++n2) if (n2 != n) rank += (n2 < own && (gt[n2] > gt[n] || (gt[n2] == gt[n] && n2 < n))) ? 1 : 0;
            if (n < own && rank < 3) blkmask |= 1u << n;
        }
    }

    u32x4 kreg[NKL], vreg[2]; u32x4 mw = {0u, 0u, 0u, 0u}, mwn = {0u, 0u, 0u, 0u};
#pragma unroll
    for (int j = 0; j < NKL; ++j) kreg[j] = *(const u32x4*)kp[j];
#pragma unroll
    for (int j = 0; j < 2; ++j) vreg[j] = *(const u32x4*)vp[j];
    if (MODE == 2) mw = *(const u32x4*)mp;
#pragma unroll
    for (int j = 0; j < NKL; ++j) *(u32x4*)(lds + kdst[j]) = kreg[j];
#pragma unroll
    for (int j = 0; j < 2; ++j) { *(u32x2*)(lds + vdst[j]) = (u32x2){vreg[j][0], vreg[j][1]}; *(u32x2*)(lds + vdst[j] + 16) = (u32x2){vreg[j][2], vreg[j][3]}; }
    __syncthreads();

    float m = NEG_INF, lsum = 0.f;
    f32x16 o0 = zero16(), o1 = zero16();
    if (w >= 4) __builtin_amdgcn_s_setprio(1);
    for (int i = 0; i < nt; ++i) {
        const bool more = (i + 1 < nt);
        if (more) {
#pragma unroll
            for (int j = 0; j < NKL; ++j) { kp[j] += kstep[j]; kreg[j] = *(const u32x4*)kp[j]; }
#pragma unroll
            for (int j = 0; j < 2; ++j) { vp[j] += KT; vreg[j] = *(const u32x4*)vp[j]; }
            if (MODE == 2) mwn = *(const u32x4*)(mp + 4 * (i + 1));
        }
        const unsigned char* Kb = lds + (i & 1) * BUFSZ; const unsigned char* Vb = Kb + KBYTES;
        bool active = (i <= wlast);
        if (MODE == 1) active = active && (__ballot((blkmask >> (i >> 1)) & 1u) != 0ull);
        if (active) {
            f32x16 s[4];
#pragma unroll
            for (int mt = 0; mt < 4; ++mt) {
                s[mt] = zero16();
#pragma unroll
                for (int ks = 0; ks < NKS; ++ks) s[mt] = mfma32(*(const bf16x8*)(Kb + (mt * 32 + r) * KROW + ks * 32 + hf * 16), qf[ks], s[mt]);
            }
            if (MODE == 2) {
#pragma unroll
                for (int mt = 0; mt < 4; ++mt) { const unsigned wd = mw[mt] >> (4 * hf);
#pragma unroll
                    for (int e = 0; e < 16; ++e) { const int bit = (e & 3) + 8 * (e >> 2); s[mt][e] = ((wd >> bit) & 1u) ? s[mt][e] : NEG_INF; } }
            } else {
                if (MODE == 1) { const bool allowed = (blkmask >> (i >> 1)) & 1u;
                    if (!allowed) {
#pragma unroll
                        for (int mt = 0; mt < 4; ++mt)
#pragma unroll
                            for (int e = 0; e < 16; ++e) s[mt][e] = NEG_INF; } }
                if (i * KT + KT - 1 > wmin) {
#pragma unroll
                    for (int mt = 0; mt < 4; ++mt) { const int kb0 = i * KT + mt * 32 + 4 * hf;
#pragma unroll
                        for (int e = 0; e < 16; ++e) { const int key = kb0 + (e & 3) + 8 * (e >> 2); s[mt][e] = (key <= qpos) ? s[mt][e] : NEG_INF; } }
                }
            }
            float mx4[4];
#pragma unroll
            for (int mt = 0; mt < 4; ++mt) { mx4[mt] = s[mt][0];
#pragma unroll
                for (int e = 1; e < 16; ++e) mx4[mt] = fmaxf(mx4[mt], s[mt][e]); }
            float mx = fmaxf(fmaxf(mx4[0], mx4[1]), fmaxf(mx4[2], mx4[3]));
            mx = fmaxf(mx, __shfl_xor(mx, 32, 64));
            const float mnew = fmaxf(m, mx), muse = (mnew == NEG_INF) ? 0.f : mnew;
            const float alpha = __builtin_amdgcn_exp2f(m - muse);
            float rs4[4];
#pragma unroll
            for (int mt = 0; mt < 4; ++mt) { rs4[mt] = 0.f;
#pragma unroll
                for (int e = 0; e < 16; ++e) { s[mt][e] = __builtin_amdgcn_exp2f(s[mt][e] - muse); rs4[mt] += s[mt][e]; } }
            lsum = lsum * alpha + ((rs4[0] + rs4[1]) + (rs4[2] + rs4[3])); m = mnew;
#pragma unroll
            for (int e = 0; e < 16; ++e) { o0[e] *= alpha; o1[e] *= alpha; }
#pragma unroll
            for (int mt = 0; mt < 4; ++mt)
#pragma unroll
                for (int sp = 0; sp < 2; ++sp) {
                    u32x4 pp;
#pragma unroll
                    for (int j = 0; j < 4; ++j) pp[j] = pk_bf16(s[mt][8 * sp + 2 * j], s[mt][8 * sp + 2 * j + 1]);
                    const bf16x8 pb = __builtin_bit_cast(bf16x8, pp);
                    const int koff = (mt * 32 + 16 * sp) * 2 + hf * 16;
                    o0 = mfma32(*(const bf16x8*)(Vb + r * VROW + koff), pb, o0);
                    o1 = mfma32(*(const bf16x8*)(Vb + (32 + r) * VROW + koff), pb, o1);
                }
        }
        if (more) {
            unsigned char* Nb = lds + ((i + 1) & 1) * BUFSZ;
#pragma unroll
            for (int j = 0; j < NKL; ++j) *(u32x4*)(Nb + kdst[j]) = kreg[j];
#pragma unroll
            for (int j = 0; j < 2; ++j) { *(u32x2*)(Nb + vdst[j]) = (u32x2){vreg[j][0], vreg[j][1]}; *(u32x2*)(Nb + vdst[j] + 16) = (u32x2){vreg[j][2], vreg[j][3]}; }
            if (MODE == 2) mw = mwn;
        }
        __syncthreads();
    }
    __builtin_amdgcn_s_setprio(0);
    const float ltot = lsum + __shfl_xor(lsum, 32, 64);
    float inv = 1.0f / ltot;
    if ((DBG_SKIP >> (MODE == 2 ? 1 : MODE == 1 ? 2 : 3)) & 1) inv = 0.f;
#pragma unroll
    for (int g4 = 0; g4 < 4; ++g4) {
        f32x4 v0 = {o0[4 * g4] * inv, o0[4 * g4 + 1] * inv, o0[4 * g4 + 2] * inv, o0[4 * g4 + 3] * inv};
        f32x4 v1 = {o1[4 * g4] * inv, o1[4 * g4 + 1] * inv, o1[4 * g4 + 2] * inv, o1[4 * g4 + 3] * inv};
        gm::st_bf4(optr + 8 * g4 + 4 * hf, v0); gm::st_bf4(optr + 32 + 8 * g4 + 4 * hf, v1);
    }
}
}

namespace ab {
typedef bf16_t bf16;
constexpr int SEQ=S_,D=64,DM=NE_IN,OM=1024;
constexpr int NW=8,QBLK=32,QB=QBLK*NW,KVBLK=64;
__device__ __forceinline__ int crow(int r,int hi){return (r&3)+8*(r>>2)+4*hi;}
#define SBAR() __builtin_amdgcn_sched_barrier(0)
__device__ __forceinline__ void cmask(f32x16&p0,f32x16&p1,int jb,int qrel,int hi){
  const float NEG=-INFINITY; int kb=64*jb+4*hi;
  #pragma unroll
  for(int r=0;r<16;++r){int kv=kb+(r&3)+8*(r>>2); if(kv>qrel)p0[r]=NEG; if(kv+32>qrel)p1[r]=NEG;}
}

constexpr int NSLOT=3, SLOTB=8192;
constexpr int LDS_K=0, LDS_V=NSLOT*SLOTB, LDS_WS=2*NSLOT*SLOTB, LDS_OST=LDS_WS+NW*64*4, LDS_BYTES=LDS_OST+NW*4096;
constexpr float C2=0.125f*1.4426950408889634f;
__device__ __forceinline__ void glds16(const void*gsrc,unsigned lds_dst){unsigned keep;
  asm volatile("s_mov_b32 %0, m0\n\ts_mov_b32 m0, %2\n\ts_nop 0\n\tglobal_load_lds_dwordx4 %1, off\n\ts_mov_b32 m0, %0":"=&s"(keep):"v"(gsrc),"s"(lds_dst):"memory");}
__device__ __forceinline__ float max3f(float a,float b,float c){float r;asm("v_max3_f32 %0, %1, %2, %3":"=v"(r):"v"(a),"v"(b),"v"(c));return r;}
__device__ __forceinline__ float max2f(float a,float b){float r;asm("v_max_f32_e32 %0, %1, %2":"=v"(r):"v"(a),"v"(b));return r;}
__device__ __forceinline__ float fadd_s(float a,float b){float r;asm("v_add_f32_e32 %0, %1, %2":"=v"(r):"v"(a),"v"(b));return r;}
__device__ __forceinline__ float fsub_s(float a,float b){float r;asm("v_sub_f32_e32 %0, %1, %2":"=v"(r):"v"(a),"v"(b));return r;}
typedef float f32x2_t __attribute__((ext_vector_type(2))); typedef __bf16 bf16x2_t __attribute__((ext_vector_type(2)));
__device__ __forceinline__ unsigned cvtpk_s(float lo,float hi){f32x2_t v={lo,hi};bf16x2_t b=__builtin_convertvector(v,bf16x2_t);return __builtin_bit_cast(unsigned,b);}
#define WAIT_BAR(N) asm volatile("s_waitcnt vmcnt(" #N ") lgkmcnt(0)\n\ts_barrier":::"memory")

__device__ __forceinline__ void qkt(f32x16&p0,f32x16&p1,const char*Kslot,const bf16x8*qr,const f32x16&negm,int r32,int hi){
  const char*kb=Kslot+hi*1024+r32*16;
  #pragma unroll
  for(int d0=0;d0<4;++d0){
    const bf16x8 b0=*reinterpret_cast<const bf16x8*>(kb+d0*2048);
    const bf16x8 b1=*reinterpret_cast<const bf16x8*>(kb+d0*2048+512);
    if(d0==0){p0=__builtin_amdgcn_mfma_f32_32x32x16_bf16(b0,qr[0],negm,0,0,0);p1=__builtin_amdgcn_mfma_f32_32x32x16_bf16(b1,qr[0],negm,0,0,0);}
    else{p0=__builtin_amdgcn_mfma_f32_32x32x16_bf16(b0,qr[d0],p0,0,0,0);p1=__builtin_amdgcn_mfma_f32_32x32x16_bf16(b1,qr[d0],p1,0,0,0);}}
}
typedef __attribute__((address_space(3))) const char* lds_cptr;
typedef short v4i16_t __attribute__((ext_vector_type(4)));
__device__ __forceinline__ void kload8(bf16x8*kf,lds_cptr kp){
  kf[0]=*(const __attribute__((address_space(3))) bf16x8*)(kp);      kf[1]=*(const __attribute__((address_space(3))) bf16x8*)(kp+512);
  kf[2]=*(const __attribute__((address_space(3))) bf16x8*)(kp+2048); kf[3]=*(const __attribute__((address_space(3))) bf16x8*)(kp+2560);
  kf[4]=*(const __attribute__((address_space(3))) bf16x8*)(kp+4096); kf[5]=*(const __attribute__((address_space(3))) bf16x8*)(kp+4608);
  kf[6]=*(const __attribute__((address_space(3))) bf16x8*)(kp+6144); kf[7]=*(const __attribute__((address_space(3))) bf16x8*)(kp+6656);
}
__device__ __forceinline__ void kload2(bf16x8*kf,lds_cptr kp,int j){ kf[2*j]=*(const __attribute__((address_space(3))) bf16x8*)(kp+j*2048); kf[2*j+1]=*(const __attribute__((address_space(3))) bf16x8*)(kp+j*2048+512); }
__device__ __forceinline__ s16x4 vtr(lds_cptr p){ return __builtin_bit_cast(s16x4,__builtin_amdgcn_ds_read_tr16_b64_v4i16((__attribute__((address_space(3))) v4i16_t*)p)); }
__device__ __forceinline__ float rowmax(const f32x16&p0,const f32x16&p1){
  float a=max3f(p0[0],p0[1],p1[0]),b=max3f(p0[2],p0[3],p1[1]);a=max3f(a,p1[2],p1[3]);
  #pragma unroll
  for(int r=4;r<16;r+=4){a=max3f(a,p0[r],p0[r+1]);b=max3f(b,p0[r+2],p0[r+3]);a=max3f(a,p1[r],p1[r+1]);b=max3f(b,p1[r+2],p1[r+3]);}
  const float m=max2f(a,b);
  auto rr=__builtin_amdgcn_permlane32_swap(__float_as_uint(m),__float_as_uint(m),false,false);
  return max2f(__uint_as_float(rr[0]),__uint_as_float(rr[1]));
}
__device__ __forceinline__ void pv(f32x16*o,int vb,bf16x8 pa0,bf16x8 pa1,bf16x8 pa2,bf16x8 pa3){
  #pragma unroll
  for(int d0=0;d0<2;++d0){s16x4 lo[4],hi[4];
    #pragma unroll
    for(int ks=0;ks<4;++ks){
      asm volatile("ds_read_b64_tr_b16 %0,%1 offset:%c2":"=&v"(lo[ks]):"v"(vb),"i"(d0*4096+ks*1024):"memory");
      asm volatile("ds_read_b64_tr_b16 %0,%1 offset:%c2":"=&v"(hi[ks]):"v"(vb),"i"(d0*4096+ks*1024+512):"memory");}
    asm volatile("s_waitcnt lgkmcnt(0)":::"memory");SBAR();
    #define PK(k) (bf16x8){lo[k][0],lo[k][1],lo[k][2],lo[k][3],hi[k][0],hi[k][1],hi[k][2],hi[k][3]}
    o[d0]=__builtin_amdgcn_mfma_f32_32x32x16_bf16(pa0,PK(0),o[d0],0,0,0);
    o[d0]=__builtin_amdgcn_mfma_f32_32x32x16_bf16(pa1,PK(1),o[d0],0,0,0);
    o[d0]=__builtin_amdgcn_mfma_f32_32x32x16_bf16(pa2,PK(2),o[d0],0,0,0);
    o[d0]=__builtin_amdgcn_mfma_f32_32x32x16_bf16(pa3,PK(3),o[d0],0,0,0);
    #undef PK
  }
}

constexpr int LDS_KM=LDS_BYTES;
__device__ __forceinline__ void moba_kmean(int b,int h,int nmax,const bf16*__restrict__ K,char*shm,int tid){
  const int lane=tid&63,wid=__builtin_amdgcn_readfirstlane(tid>>6);
  float*km=(float*)(shm+LDS_KM); float*kmw=km+7*64;
  const bf16*Kh=K+(long)b*SEQ*DM+h*D;
  { const int kc=lane&7,kg=tid>>3;
    const bf16*kb=Kh+(long)(kg*4)*DM+kc*8;
    u32x4 kv[7][4];
    #pragma unroll
    for(int n=0;n<7;++n) if(n<nmax){
      #pragma unroll
      for(int kk=0;kk<4;++kk)kv[n][kk]=*(const u32x4*)(kb+(long)(n*256+kk)*DM); }
    #pragma unroll
    for(int n=0;n<7;++n) if(n<nmax){ float sa[8];
      #pragma unroll
      for(int e=0;e<8;++e)sa[e]=0.f;
      #pragma unroll
      for(int kk=0;kk<4;++kk)
        #pragma unroll
        for(int q=0;q<4;++q){sa[2*q]+=bf_lo(kv[n][kk][q]);sa[2*q+1]+=bf_hi(kv[n][kk][q]);}
      #pragma unroll
      for(int e=0;e<8;++e){sa[e]+=__shfl_xor(sa[e],8,64);sa[e]+=__shfl_xor(sa[e],16,64);sa[e]+=__shfl_xor(sa[e],32,64);}
      if(lane<8){float*dst=kmw+(n*8+wid)*64+kc*8;*(f32x4*)dst=(f32x4){sa[0],sa[1],sa[2],sa[3]};*(f32x4*)(dst+4)=(f32x4){sa[4],sa[5],sa[6],sa[7]};} } }
  __syncthreads();
  if(tid<nmax*64){const int n=tid>>6,d=tid&63;float sacc=0.f;
    #pragma unroll
    for(int ww=0;ww<8;++ww)sacc+=kmw[(n*8+ww)*64+d];
    km[n*64+d]=sacc*(1.0f/256.0f);}
  __syncthreads();
}
#ifndef ATTN_STORE16
#define ATTN_STORE16(p,v) (*(u32x4*)(p)=(v))
#endif
template<int THRL,int MODE> __device__ __forceinline__ void attn_unit(int b,int h,int qb,const bf16*Q,const bf16*__restrict__ K,const bf16*__restrict__ V,bf16*O,const unsigned*msk,char*shm,int tid){
  const int lane=tid&63,r32=lane&31,hi=lane>>5; const int wid=__builtin_amdgcn_readfirstlane(tid>>6);
  const long rowbase=(long)b*SEQ; const int q0=(MODE==2)?qb*32:qb*QB;
  const bf16*Qrow=(MODE==2)?Q+(rowbase+q0+wid*4+(r32>>3))*DM+(r32&7)*D:Q+(rowbase+q0+wid*QBLK+r32)*DM+h*D;
  const bf16*Kh=K+rowbase*DM+((MODE==2)?0:h*D),*Vh=V+rowbase*DM+((MODE==2)?0:h*D);
  const unsigned lds0=(unsigned)(uintptr_t)shm;
  float*wsf=(float*)(shm+LDS_WS)+wid*64;
  const bf16*ksrc=Kh+(long)lane*DM+wid*8;
  const bf16*vsrc=Vh+(long)(16*(wid&3)+(lane>>2))*DM+(wid>>2)*32+(lane&3)*8;
  const unsigned kdst=lds0+LDS_K+wid*1024, vdst=lds0+LDS_V+wid*1024;
  #define DMA_K(t,slot) glds16(ksrc+(long)(t)*KVBLK*DM,(unsigned)__builtin_amdgcn_readfirstlane(kdst+(slot)))
  #define DMA_V(t,slot) glds16(vsrc+(long)(t)*KVBLK*DM,(unsigned)__builtin_amdgcn_readfirstlane(vdst+(slot)))
  const int vb0=(int)(lds0+LDS_V)+((lane>>4)&1)*32+(lane&3)*8+(4*hi+((lane&15)>>2))*64;
  const char*Kbase=shm+LDS_K; bf16x8 kf[8];
  const lds_cptr shm3=(lds_cptr)shm; const lds_cptr kp0=shm3+LDS_K+hi*1024+r32*16; const lds_cptr vp0=shm3+LDS_V+((lane>>4)&1)*32+(lane&3)*8+(4*hi+((lane&15)>>2))*64;
  const int NTr=(MODE==2)?((q0+31)>>6)+1:(q0+QB)/KVBLK; const int NT=(MODE==2)?((NTr<4)?4:((NTr+1)&~1)):NTr;
  bf16x8 qr[4];
  #pragma unroll
  for(int d0=0;d0<4;++d0)qr[d0]=*reinterpret_cast<const bf16x8*>(&Qrow[d0*16+hi*8]);
  unsigned blkmask=0xffffffffu;
  if(MODE==2){
    const u32x4 mv=*(const u32x4*)(msk+(size_t)(rowbase+q0+(tid>>4))*64+(tid&15)*4);
    *(u32x4*)(shm+LDS_OST+tid*16)=mv;
    __syncthreads();
  }
  if(MODE==1){
    const int own=qb;
    const float*km=(const float*)(shm+LDS_KM);
    float gt[7];
    #pragma unroll
    for(int n=0;n<7;++n){float g=0.f;
      if(n<own){
        #pragma unroll
        for(int ks=0;ks<4;++ks)
          #pragma unroll
          for(int j=0;j<8;++j)g+=__uint_as_float((unsigned)(unsigned short)qr[ks][j]<<16)*km[n*64+ks*16+hi*8+j];
        g+=__shfl_xor(g,32,64);}
      gt[n]=g;}
    blkmask=1u<<own;
    #pragma unroll
    for(int n=0;n<7;++n){int rank=0;
      #pragma unroll
      for(int n2=0;n2<7;++n2)if(n2!=n)rank+=(n2<own&&(gt[n2]>gt[n]||(gt[n2]==gt[n]&&n2<n)))?1:0;
      if(n<own&&rank<3)blkmask|=1u<<n;}
  }
  DMA_K(0,0);DMA_V(0,0);DMA_K(1,SLOTB);
  float mhat=0.f,l_reg=0.f;f32x16 o[2];o[0]=f32x16{};o[1]=f32x16{};f32x16 negm=f32x16{};asm volatile("":"+v"(negm));
  const int qrel=wid*QBLK+r32;
  const unsigned*mrow=(const unsigned*)(shm+LDS_OST)+(wid*4+(r32>>3))*64;
  #define BMASK(P0,P1,t) do{ const u32x2 mw_=*(const u32x2*)(mrow+2*(t)); const unsigned w0_=mw_[0]>>(4*hi),w1_=mw_[1]>>(4*hi); \
      _Pragma("unroll") for(int r_=0;r_<16;++r_){ const int bit_=(r_&3)+8*(r_>>2); P0[r_]=((w0_>>bit_)&1u)?P0[r_]:-INFINITY; P1[r_]=((w1_>>bit_)&1u)?P1[r_]:-INFINITY; } }while(0)
  #define GMASK(P0,P1,t) do{ if(MODE==2){BMASK(P0,P1,t);} else if(!((blkmask>>((t)>>2))&1u)){ _Pragma("unroll") for(int r_=0;r_<16;++r_){P0[r_]=-INFINITY;P1[r_]=-INFINITY;} } }while(0)
  #define CMASK(P0,P1,t) do{int jb_=(t)-(NT-4); if(MODE==1&&jb_>=0)cmask(P0,P1,jb_,qrel,hi); GMASK(P0,P1,t);}while(0)
  bool resc=false;
  #define START(P0,P1) do{ const float rm=rowmax(P0,P1); resc=false; \
    { const float dl=(rm==-INFINITY)?0.f:rm; mhat=fadd_s(mhat,dl); \
      _Pragma("unroll") for(int r=0;r<16;++r){P0[r]=fsub_s(P0[r],dl);P1[r]=fsub_s(P1[r],dl);} \
      _Pragma("unroll") for(int r=0;r<16;++r)negm[r]=-mhat; asm volatile("":"+v"(negm)); } \
    _Pragma("unroll") for(int r=0;r<16;++r)P0[r]=__builtin_amdgcn_exp2f(P0[r]); }while(0)
  #define RESC() do{ if(resc){ asm volatile("s_waitcnt lgkmcnt(0)":::"memory"); \
      _Pragma("unroll") for(int d_=0;d_<2;++d_) _Pragma("unroll") for(int r=0;r<16;++r)o[d_][r]*=wsf[crow(r,hi)]; } }while(0)
  f32x16 pA0,pA1,pB0,pB1;
  int sl_prev=0,sl_cur=0,sl_next=SLOTB;
  #define ROT() do{sl_prev=sl_cur;sl_cur=sl_next;sl_next=(sl_next==(NSLOT-1)*SLOTB)?0:sl_next+SLOTB;}while(0)
  DMA_K(2,2*SLOTB);
  WAIT_BAR(3);
  qkt(pA0,pA1,Kbase,qr,negm,r32,hi);asm volatile("s_nop 15\n\ts_nop 7":"+v"(pA0),"+v"(pA1));CMASK(pA0,pA1,0);
  START(pA0,pA1);
  _Pragma("unroll") for(int r=0;r<16;++r)pA1[r]=__builtin_amdgcn_exp2f(pA1[r]);
  WAIT_BAR(0);
  DMA_K(3,0);DMA_V(1,SLOTB);
  ROT();
  kload8(kf,kp0+sl_cur);
  WAIT_BAR(2);
  s16x4 vlo[8],vhi[8]; u32x4 pw0,pw1,pw2,pw3;
  #define PKW(P,B) cvtpk_s(P[B],P[B+1])
  #define PAF(k) __builtin_bit_cast(bf16x8,pw##k)
  #define VFR(i) (bf16x8){vlo[i][0],vlo[i][1],vlo[i][2],vlo[i][3],vhi[i][0],vhi[i][1],vhi[i][2],vhi[i][3]}
  #define PIN(x) asm volatile("":"+v"(x))
  #define MX3(a,b,c) __builtin_fmaxf(__builtin_fmaxf((a),(b)),(c))
  #define GAPA(MF,A0,A1,A2,A3,W0,W1,PW) do{ MF; sacc+=A0; sacc+=A1; sacc+=A2; sacc+=A3; PIN(sacc); W0; W1; PIN(PW); SBAR(); }while(0)
  #define EX(v) __builtin_amdgcn_exp2f(v)
  #define GAPB(MF,X,B) do{ MF; X[B]=EX(X[B]); X[B+1]=EX(X[B+1]); X[B+2]=EX(X[B+2]); X[B+3]=EX(X[B+3]); PIN(X); SBAR(); }while(0)
  #define VRD(i) do{ vlo[i]=vtr(vp_+(((i)>>2)*4096+((i)&3)*1024)); vhi[i]=vtr(vp_+(((i)>>2)*4096+((i)&3)*1024+512)); }while(0)
  #define KRD(G,j) do{ if(G){ kload2(kf,kp0+sl_next,j); SBAR(); } }while(0)
  #define STEP(C0,C1,P0,P1,t,GK,GV,GL) do{ SBAR(); \
    const lds_cptr vp_=vp0+sl_prev; \
    VRD(0); SBAR(); float sacc=(P0[0]+P0[1]); \
    GAPA(C0=__builtin_amdgcn_mfma_f32_32x32x16_bf16(kf[0],qr[0],negm,0,0,0), P0[2],P0[3],P0[4],P0[5],     pw0[0]=PKW(P0,0), pw0[1]=PKW(P0,2), pw0); \
    VRD(4); SBAR(); GAPA(C1=__builtin_amdgcn_mfma_f32_32x32x16_bf16(kf[1],qr[0],negm,0,0,0), P0[6],P0[7],P0[8],P0[9],     pw0[2]=PKW(P0,4), pw0[3]=PKW(P0,6), pw0); \
    VRD(1); SBAR(); GAPA(C0=__builtin_amdgcn_mfma_f32_32x32x16_bf16(kf[2],qr[1],C0,0,0,0),   P0[10],P0[11],P0[12],P0[13], pw1[0]=PKW(P0,8), pw1[1]=PKW(P0,10), pw1); \
    VRD(5); SBAR(); GAPA(C1=__builtin_amdgcn_mfma_f32_32x32x16_bf16(kf[3],qr[1],C1,0,0,0),   P0[14],P0[15],P1[0],P1[1],   pw1[2]=PKW(P0,12),pw1[3]=PKW(P0,14), pw1); \
    VRD(2); SBAR(); GAPA(C0=__builtin_amdgcn_mfma_f32_32x32x16_bf16(kf[4],qr[2],C0,0,0,0),   P1[2],P1[3],P1[4],P1[5],     pw2[0]=PKW(P1,0), pw2[1]=PKW(P1,2), pw2); \
    VRD(6); SBAR(); GAPA(C1=__builtin_amdgcn_mfma_f32_32x32x16_bf16(kf[5],qr[2],C1,0,0,0),   P1[6],P1[7],P1[8],P1[9],     pw2[2]=PKW(P1,4), pw2[3]=PKW(P1,6), pw2); \
    VRD(3); SBAR(); GAPA(C0=__builtin_amdgcn_mfma_f32_32x32x16_bf16(kf[6],qr[3],C0,0,0,0),   P1[10],P1[11],P1[12],P1[13], pw3[0]=PKW(P1,8), pw3[1]=PKW(P1,10), pw3); \
    VRD(7); SBAR(); GAPA(C1=__builtin_amdgcn_mfma_f32_32x32x16_bf16(kf[7],qr[3],C1,0,0,0),   P1[14],P1[15],0.f,0.f,       pw3[2]=PKW(P1,12),pw3[3]=PKW(P1,14), pw3); \
    l_reg+=sacc; \
    if(GK){DMA_K((t)+3,sl_cur);} if(GV){DMA_V((t)+1,sl_next);} \
    CMASK(C0,C1,t); \
    { float a=MX3(C0[0],C0[1],C1[0]),b=MX3(C0[2],C0[3],C1[1]); a=MX3(a,C1[2],C1[3]); \
      _Pragma("unroll") for(int r=4;r<16;r+=4){a=MX3(a,C0[r],C0[r+1]);b=MX3(b,C0[r+2],C0[r+3]);a=MX3(a,C1[r],C1[r+1]);b=MX3(b,C1[r+2],C1[r+3]);} \
      float rm=__builtin_fmaxf(a,b); { auto rr=__builtin_amdgcn_permlane32_swap(__float_as_uint(rm),__float_as_uint(rm),false,false); rm=__builtin_fmaxf(__uint_as_float(rr[0]),__uint_as_float(rr[1])); } \
      resc=false; \
      if(__builtin_expect(__any(rm>(float)THRL),0)){ const float dl=__builtin_fmaxf(rm,0.f); mhat+=dl; \
        _Pragma("unroll") for(int r=0;r<16;++r){C0[r]-=dl;C1[r]-=dl;} \
        _Pragma("unroll") for(int r=0;r<16;++r)negm[r]=-mhat; asm volatile("":"+v"(negm)); \
        const float f=__builtin_amdgcn_exp2f(-dl); l_reg*=f; if(hi==0)wsf[r32]=f; resc=true; } } \
    SBAR(); \
    GAPB(o[0]=__builtin_amdgcn_mfma_f32_32x32x16_bf16(PAF(0),VFR(0),o[0],0,0,0), C0,0); \
    GAPB(o[1]=__builtin_amdgcn_mfma_f32_32x32x16_bf16(PAF(0),VFR(4),o[1],0,0,0), C0,4); \
    KRD(GL,0); GAPB(o[0]=__builtin_amdgcn_mfma_f32_32x32x16_bf16(PAF(1),VFR(1),o[0],0,0,0), C0,8); \
    KRD(GL,1); GAPB(o[1]=__builtin_amdgcn_mfma_f32_32x32x16_bf16(PAF(1),VFR(5),o[1],0,0,0), C0,12); \
    KRD(GL,2); GAPB(o[0]=__builtin_amdgcn_mfma_f32_32x32x16_bf16(PAF(2),VFR(2),o[0],0,0,0), C1,0); \
    KRD(GL,3); GAPB(o[1]=__builtin_amdgcn_mfma_f32_32x32x16_bf16(PAF(2),VFR(6),o[1],0,0,0), C1,4); \
    GAPB(o[0]=__builtin_amdgcn_mfma_f32_32x32x16_bf16(PAF(3),VFR(3),o[0],0,0,0), C1,8); \
    GAPB(o[1]=__builtin_amdgcn_mfma_f32_32x32x16_bf16(PAF(3),VFR(7),o[1],0,0,0), C1,12); \
    }while(0)
  int t=1;
  #undef CMASK
  #define CMASK(P0,P1,t) GMASK(P0,P1,t)
  for(;t+5<NT;t+=2){
    STEP(pB0,pB1,pA0,pA1,t,true,true,true);     WAIT_BAR(2); RESC(); ROT();
    STEP(pA0,pA1,pB0,pB1,t+1,true,true,true);   WAIT_BAR(2); RESC(); ROT();
  }
  #undef CMASK
  #define CMASK(P0,P1,t) do{int jb_=(t)-(NT-4); if(MODE==1&&jb_>=0)cmask(P0,P1,jb_,qrel,hi); GMASK(P0,P1,t);}while(0)
  #define ENDW(tt) do{ if((tt)+3<NT){WAIT_BAR(2);} else if((tt)+2<NT){WAIT_BAR(1);} else {WAIT_BAR(0);} }while(0)
  for(;t+1<NT;t+=2){
    STEP(pB0,pB1,pA0,pA1,t,(t+3<NT),(t+1<NT),(t+1<NT));       ENDW(t);   RESC(); ROT();
    STEP(pA0,pA1,pB0,pB1,t+1,(t+4<NT),(t+2<NT),(t+2<NT));     ENDW(t+1); RESC(); ROT();
  }
  STEP(pB0,pB1,pA0,pA1,NT-1,false,false,false); RESC();
  { float sacc=pB0[0]+pB0[1]; _Pragma("unroll") for(int r=2;r<16;++r)sacc+=pB0[r]; _Pragma("unroll") for(int r=0;r<16;++r)sacc+=pB1[r]; l_reg+=sacc;
    pw0=(u32x4){PKW(pB0,0),PKW(pB0,2),PKW(pB0,4),PKW(pB0,6)};pw1=(u32x4){PKW(pB0,8),PKW(pB0,10),PKW(pB0,12),PKW(pB0,14)};pw2=(u32x4){PKW(pB1,0),PKW(pB1,2),PKW(pB1,4),PKW(pB1,6)};pw3=(u32x4){PKW(pB1,8),PKW(pB1,10),PKW(pB1,12),PKW(pB1,14)};
    SBAR(); pv(o,vb0+sl_cur,PAF(0),PAF(1),PAF(2),PAF(3)); }
  #undef PKW
  #undef PAF
  #undef VFR
  #undef PIN
  #undef MX3
  #undef GAPA
  #undef GAPB
  #undef EX
  #undef VRD
  #undef KRD
  #undef STEP
  #undef ENDW
  {auto rr=__builtin_amdgcn_permlane32_swap(__float_as_uint(l_reg),__float_as_uint(l_reg),false,false);l_reg=__uint_as_float(rr[0])+__uint_as_float(rr[1]);}
  if(hi==0)wsf[32+r32]=l_reg;asm volatile("s_waitcnt lgkmcnt(0)":::"memory");
  float rli[16];
  #pragma unroll
  for(int r=0;r<16;++r)rli[r]=__builtin_amdgcn_rcpf(wsf[32+crow(r,hi)]);
  if(MODE==2){ asm volatile("s_waitcnt lgkmcnt(0)\n\ts_barrier":::"memory"); }
  { bf16*stg=(bf16*)(shm+LDS_OST)+wid*2048;
    #pragma unroll
    for(int r=0;r<16;++r){const int orow=crow(r,hi);
      #pragma unroll
      for(int d0=0;d0<2;++d0)stg[orow*64+d0*32+r32]=f2bf(o[d0][r]*rli[r]);}
    asm volatile("s_waitcnt lgkmcnt(0)":::"memory");
    #pragma unroll
    for(int i=0;i<4;++i){const int row=i*8+(lane>>3),ch=lane&7; const u32x4 v=*(const u32x4*)(stg+row*64+ch*8);
      bf16*op=(MODE==2)?O+(rowbase+q0+wid*4+(row>>3))*OM+(row&7)*D+ch*8:O+(rowbase+q0+wid*QBLK+row)*OM+h*D+ch*8; ATTN_STORE16(op,v);} }
  asm volatile("s_waitcnt lgkmcnt(0)\n\ts_barrier":::"memory");
  #undef DMA_K
  #undef DMA_V
  #undef CMASK
  #undef GMASK
  #undef BMASK
  #undef START
  #undef RESC
  #undef ROT
}
constexpr int ATTN_LDS_BYTES=LDS_BYTES;
#undef SBAR
#undef WAIT_BAR
}

namespace am {
typedef bf16_t bf16;
constexpr int SEQ=S_,D=64;
constexpr int NW=8,QBLK=32,QB=QBLK*NW,KVBLK=64;
__device__ __forceinline__ int crow(int r,int hi){return (r&3)+8*(r>>2)+4*hi;}
#define SBAR() __builtin_amdgcn_sched_barrier(0)
__device__ __forceinline__ void cmask(f32x16&p0,f32x16&p1,int jb,int qrel,int hi){
  const float NEG=-INFINITY; int kb=64*jb+4*hi;
  #pragma unroll
  for(int r=0;r<16;++r){int kv=kb+(r&3)+8*(r>>2); if(kv>qrel)p0[r]=NEG; if(kv+32>qrel)p1[r]=NEG;}
}

constexpr int NSLOT=3, SLOTB=12288;
constexpr int LDS_K=0, LDS_V=NSLOT*SLOTB, LDS_WS=2*NSLOT*SLOTB, LDS_OST=LDS_WS+NW*64*4, LDS_DUMP=LDS_OST+NW*4096, LDS_BYTES=LDS_DUMP+4096;
constexpr float C2=0.10206207261596575f*1.4426950408889634f;
__device__ __forceinline__ void glds16(const void*gsrc,unsigned lds_dst){unsigned keep;
  asm volatile("s_mov_b32 %0, m0\n\ts_mov_b32 m0, %2\n\ts_nop 0\n\tglobal_load_lds_dwordx4 %1, off\n\ts_mov_b32 m0, %0":"=&s"(keep):"v"(gsrc),"s"(lds_dst):"memory");}
__device__ __forceinline__ float max3f(float a,float b,float c){float r;asm("v_max3_f32 %0, %1, %2, %3":"=v"(r):"v"(a),"v"(b),"v"(c));return r;}
__device__ __forceinline__ float max2f(float a,float b){float r;asm("v_max_f32_e32 %0, %1, %2":"=v"(r):"v"(a),"v"(b));return r;}
__device__ __forceinline__ float fadd_s(float a,float b){float r;asm("v_add_f32_e32 %0, %1, %2":"=v"(r):"v"(a),"v"(b));return r;}
__device__ __forceinline__ float fsub_s(float a,float b){float r;asm("v_sub_f32_e32 %0, %1, %2":"=v"(r):"v"(a),"v"(b));return r;}
typedef float f32x2_t __attribute__((ext_vector_type(2))); typedef __bf16 bf16x2_t __attribute__((ext_vector_type(2)));
__device__ __forceinline__ unsigned cvtpk_s(float lo,float hi){f32x2_t v={lo,hi};bf16x2_t b=__builtin_convertvector(v,bf16x2_t);return __builtin_bit_cast(unsigned,b);}
#define WAIT_BAR(N) asm volatile("s_waitcnt vmcnt(" #N ") lgkmcnt(0)\n\ts_barrier":::"memory")

__device__ __forceinline__ void qkt(f32x16&p0,f32x16&p1,const char*Kslot,const bf16x8*qr,const f32x16&negm,int r32,int hi){
  const char*kb=Kslot+hi*1024+r32*16;
  #pragma unroll
  for(int d0=0;d0<6;++d0){
    const bf16x8 b0=*reinterpret_cast<const bf16x8*>(kb+d0*2048);
    const bf16x8 b1=*reinterpret_cast<const bf16x8*>(kb+d0*2048+512);
    if(d0==0){p0=__builtin_amdgcn_mfma_f32_32x32x16_bf16(b0,qr[0],negm,0,0,0);p1=__builtin_amdgcn_mfma_f32_32x32x16_bf16(b1,qr[0],negm,0,0,0);}
    else{p0=__builtin_amdgcn_mfma_f32_32x32x16_bf16(b0,qr[d0],p0,0,0,0);p1=__builtin_amdgcn_mfma_f32_32x32x16_bf16(b1,qr[d0],p1,0,0,0);}}
}
typedef __attribute__((address_space(3))) const char* lds_cptr;
typedef short v4i16_t __attribute__((ext_vector_type(4)));
__device__ __forceinline__ void kload8(bf16x8*kf,lds_cptr kp){
  kf[0]=*(const __attribute__((address_space(3))) bf16x8*)(kp);      kf[1]=*(const __attribute__((address_space(3))) bf16x8*)(kp+512);
  kf[2]=*(const __attribute__((address_space(3))) bf16x8*)(kp+2048); kf[3]=*(const __attribute__((address_space(3))) bf16x8*)(kp+2560);
  kf[4]=*(const __attribute__((address_space(3))) bf16x8*)(kp+4096); kf[5]=*(const __attribute__((address_space(3))) bf16x8*)(kp+4608);
  kf[6]=*(const __attribute__((address_space(3))) bf16x8*)(kp+6144); kf[7]=*(const __attribute__((address_space(3))) bf16x8*)(kp+6656);
  kf[8]=*(const __attribute__((address_space(3))) bf16x8*)(kp+8192); kf[9]=*(const __attribute__((address_space(3))) bf16x8*)(kp+8704);
  kf[10]=*(const __attribute__((address_space(3))) bf16x8*)(kp+10240); kf[11]=*(const __attribute__((address_space(3))) bf16x8*)(kp+10752);
}
__device__ __forceinline__ void kload2(bf16x8*kf,lds_cptr kp,int j){ kf[2*j]=*(const __attribute__((address_space(3))) bf16x8*)(kp+j*2048); kf[2*j+1]=*(const __attribute__((address_space(3))) bf16x8*)(kp+j*2048+512); }
__device__ __forceinline__ s16x4 vtr(lds_cptr p){ return __builtin_bit_cast(s16x4,__builtin_amdgcn_ds_read_tr16_b64_v4i16((__attribute__((address_space(3))) v4i16_t*)p)); }
__device__ __forceinline__ float rowmax(const f32x16&p0,const f32x16&p1){
  float a=max3f(p0[0],p0[1],p1[0]),b=max3f(p0[2],p0[3],p1[1]);a=max3f(a,p1[2],p1[3]);
  #pragma unroll
  for(int r=4;r<16;r+=4){a=max3f(a,p0[r],p0[r+1]);b=max3f(b,p0[r+2],p0[r+3]);a=max3f(a,p1[r],p1[r+1]);b=max3f(b,p1[r+2],p1[r+3]);}
  const float m=max2f(a,b);
  auto rr=__builtin_amdgcn_permlane32_swap(__float_as_uint(m),__float_as_uint(m),false,false);
  return max2f(__uint_as_float(rr[0]),__uint_as_float(rr[1]));
}
__device__ __forceinline__ void pv(f32x16*o,int vb,bf16x8 pa0,bf16x8 pa1,bf16x8 pa2,bf16x8 pa3){
  #pragma unroll
  for(int d0=0;d0<2;++d0){s16x4 lo[4],hi[4];
    #pragma unroll
    for(int ks=0;ks<4;++ks){
      asm volatile("ds_read_b64_tr_b16 %0,%1 offset:%c2":"=&v"(lo[ks]):"v"(vb),"i"(d0*4096+ks*1024):"memory");
      asm volatile("ds_read_b64_tr_b16 %0,%1 offset:%c2":"=&v"(hi[ks]):"v"(vb),"i"(d0*4096+ks*1024+512):"memory");}
    asm volatile("s_waitcnt lgkmcnt(0)":::"memory");SBAR();
    #define PK(k) (bf16x8){lo[k][0],lo[k][1],lo[k][2],lo[k][3],hi[k][0],hi[k][1],hi[k][2],hi[k][3]}
    o[d0]=__builtin_amdgcn_mfma_f32_32x32x16_bf16(pa0,PK(0),o[d0],0,0,0);
    o[d0]=__builtin_amdgcn_mfma_f32_32x32x16_bf16(pa1,PK(1),o[d0],0,0,0);
    o[d0]=__builtin_amdgcn_mfma_f32_32x32x16_bf16(pa2,PK(2),o[d0],0,0,0);
    o[d0]=__builtin_amdgcn_mfma_f32_32x32x16_bf16(pa3,PK(3),o[d0],0,0,0);
    #undef PK
  }
}

#ifndef ATTN_STORE16
#define ATTN_STORE16(p,v) (*(u32x4*)(p)=(v))
#endif
template<int THRL> __device__ __forceinline__ void attn_unit(int b,int h,int qb,const bf16*Q,const bf16*__restrict__ KN,const bf16*__restrict__ KR,const bf16*__restrict__ V,bf16*O,char*shm,int tid){
  const int lane=tid&63,r32=lane&31,hi=lane>>5; const int wid=__builtin_amdgcn_readfirstlane(tid>>6);
  const long rowbase=(long)b*SEQ; const int q0=qb*QB;
  const bf16*Qrow=Q+(rowbase+q0+wid*QBLK+r32)*1536+h*96;
  const unsigned lds0=(unsigned)(uintptr_t)shm;
  float*wsf=(float*)(shm+LDS_WS)+wid*64;
  const bf16*ksrcA=KN+(rowbase+lane)*1024+h*64+wid*8;
  const long dKR=KR-KN;
  const bf16*ksrcB=KN+((wid<4)?dKR+(rowbase+lane)*1280+1024+wid*8:(rowbase+lane)*1024+h*64+wid*8);
  const long kstepB=(wid<4)?(long)KVBLK*1280:(long)KVBLK*1024;
  const bf16*vsrc=V+(rowbase+16*(wid&3)+(lane>>2))*1024+h*64+(wid>>2)*32+(lane&3)*8;
  const unsigned kdstA=lds0+LDS_K+wid*1024, kdstB=(wid<4)?lds0+LDS_K+(8+wid)*1024:lds0+LDS_DUMP+(wid-4)*1024, vdst=lds0+LDS_V+wid*1024;
  #define DMA_K(t,slot) do{ glds16(ksrcA+(long)(t)*KVBLK*1024,(unsigned)__builtin_amdgcn_readfirstlane(kdstA+(slot))); \
      glds16(ksrcB+(long)(t)*kstepB,(unsigned)__builtin_amdgcn_readfirstlane((wid<4)?kdstB+(slot):kdstB)); }while(0)
  #define DMA_V(t,slot) glds16(vsrc+(long)(t)*KVBLK*1024,(unsigned)__builtin_amdgcn_readfirstlane(vdst+(slot)))
  const int vb0=(int)(lds0+LDS_V)+((lane>>4)&1)*32+(lane&3)*8+(4*hi+((lane&15)>>2))*64;
  const char*Kbase=shm+LDS_K; bf16x8 kf[12];
  const lds_cptr shm3=(lds_cptr)shm; const lds_cptr kp0=shm3+LDS_K+hi*1024+r32*16; const lds_cptr vp0=shm3+LDS_V+((lane>>4)&1)*32+(lane&3)*8+(4*hi+((lane&15)>>2))*64;
  const int NT=(q0+QB)/KVBLK;
  DMA_K(0,0);DMA_V(0,0);DMA_K(1,SLOTB);
  bf16x8 qr[6];
  #pragma unroll
  for(int d0=0;d0<6;++d0)qr[d0]=*reinterpret_cast<const bf16x8*>(&Qrow[d0*16+hi*8]);
  float mhat=0.f,l_reg=0.f;f32x16 o[2];o[0]=f32x16{};o[1]=f32x16{};f32x16 negm=f32x16{};asm volatile("":"+v"(negm));
  const int qrel=wid*QBLK+r32;
  #define CMASK(P0,P1,t) do{int jb_=(t)-(NT-4); if(jb_>=0)cmask(P0,P1,jb_,qrel,hi);}while(0)
  bool resc=false;
  #define START(P0,P1) do{ const float rm=rowmax(P0,P1); resc=false; \
    { const float dl=rm; mhat=fadd_s(mhat,dl); \
      _Pragma("unroll") for(int r=0;r<16;++r){P0[r]=fsub_s(P0[r],dl);P1[r]=fsub_s(P1[r],dl);} \
      _Pragma("unroll") for(int r=0;r<16;++r)negm[r]=-mhat; asm volatile("":"+v"(negm)); } \
    _Pragma("unroll") for(int r=0;r<16;++r)P0[r]=__builtin_amdgcn_exp2f(P0[r]); }while(0)
  #define RESC() do{ if(resc){ asm volatile("s_waitcnt lgkmcnt(0)":::"memory"); \
      _Pragma("unroll") for(int d_=0;d_<2;++d_) _Pragma("unroll") for(int r=0;r<16;++r)o[d_][r]*=wsf[crow(r,hi)]; } }while(0)
  f32x16 pA0,pA1,pB0,pB1;
  int sl_prev=0,sl_cur=0,sl_next=SLOTB;
  #define ROT() do{sl_prev=sl_cur;sl_cur=sl_next;sl_next=(sl_next==(NSLOT-1)*SLOTB)?0:sl_next+SLOTB;}while(0)
  DMA_K(2,2*SLOTB);
  WAIT_BAR(5);
  qkt(pA0,pA1,Kbase,qr,negm,r32,hi);asm volatile("s_nop 15\n\ts_nop 7":"+v"(pA0),"+v"(pA1));CMASK(pA0,pA1,0);
  START(pA0,pA1);
  _Pragma("unroll") for(int r=0;r<16;++r)pA1[r]=__builtin_amdgcn_exp2f(pA1[r]);
  WAIT_BAR(0);
  DMA_K(3,0);DMA_V(1,SLOTB);
  ROT();
  kload8(kf,kp0+sl_cur);
  WAIT_BAR(3);
  s16x4 vlo[8],vhi[8]; u32x4 pw0,pw1,pw2,pw3;
  #define PKW(P,B) cvtpk_s(P[B],P[B+1])
  #define PAF(k) __builtin_bit_cast(bf16x8,pw##k)
  #define VFR(i) (bf16x8){vlo[i][0],vlo[i][1],vlo[i][2],vlo[i][3],vhi[i][0],vhi[i][1],vhi[i][2],vhi[i][3]}
  #define PIN(x) asm volatile("":"+v"(x))
  #define MX3(a,b,c) __builtin_fmaxf(__builtin_fmaxf((a),(b)),(c))
  #define GAPA(MF,A0,A1,A2,A3,W0,W1,PW) do{ MF; sacc+=A0; sacc+=A1; sacc+=A2; sacc+=A3; PIN(sacc); W0; W1; PIN(PW); SBAR(); }while(0)
  #define EX(v) __builtin_amdgcn_exp2f(v)
  #define GAPB(MF,X,B) do{ MF; X[B]=EX(X[B]); X[B+1]=EX(X[B+1]); X[B+2]=EX(X[B+2]); X[B+3]=EX(X[B+3]); PIN(X); SBAR(); }while(0)
  #define VRD(i) do{ vlo[i]=vtr(vp_+(((i)>>2)*4096+((i)&3)*1024)); vhi[i]=vtr(vp_+(((i)>>2)*4096+((i)&3)*1024+512)); }while(0)
  #define KRD(G,j) do{ if(G){ kload2(kf,kp0+sl_next,j); SBAR(); } }while(0)
  #define STEP(C0,C1,P0,P1,t,GK,GV,GL) do{ SBAR(); \
    const lds_cptr vp_=vp0+sl_prev; \
    VRD(0); SBAR(); float sacc=(P0[0]+P0[1]); \
    GAPA(C0=__builtin_amdgcn_mfma_f32_32x32x16_bf16(kf[0],qr[0],negm,0,0,0), P0[2],P0[3],P0[4],P0[5],     pw0[0]=PKW(P0,0), pw0[1]=PKW(P0,2), pw0); \
    VRD(4); SBAR(); GAPA(C1=__builtin_amdgcn_mfma_f32_32x32x16_bf16(kf[1],qr[0],negm,0,0,0), P0[6],P0[7],P0[8],P0[9],     pw0[2]=PKW(P0,4), pw0[3]=PKW(P0,6), pw0); \
    VRD(1); SBAR(); GAPA(C0=__builtin_amdgcn_mfma_f32_32x32x16_bf16(kf[2],qr[1],C0,0,0,0),   P0[10],P0[11],P0[12],P0[13], pw1[0]=PKW(P0,8), pw1[1]=PKW(P0,10), pw1); \
    VRD(5); SBAR(); GAPA(C1=__builtin_amdgcn_mfma_f32_32x32x16_bf16(kf[3],qr[1],C1,0,0,0),   P0[14],P0[15],P1[0],P1[1],   pw1[2]=PKW(P0,12),pw1[3]=PKW(P0,14), pw1); \
    VRD(2); SBAR(); GAPA(C0=__builtin_amdgcn_mfma_f32_32x32x16_bf16(kf[4],qr[2],C0,0,0,0),   P1[2],P1[3],P1[4],P1[5],     pw2[0]=PKW(P1,0), pw2[1]=PKW(P1,2), pw2); \
    VRD(6); SBAR(); GAPA(C1=__builtin_amdgcn_mfma_f32_32x32x16_bf16(kf[5],qr[2],C1,0,0,0),   P1[6],P1[7],P1[8],P1[9],     pw2[2]=PKW(P1,4), pw2[3]=PKW(P1,6), pw2); \
    VRD(3); SBAR(); GAPA(C0=__builtin_amdgcn_mfma_f32_32x32x16_bf16(kf[6],qr[3],C0,0,0,0),   P1[10],P1[11],P1[12],P1[13], pw3[0]=PKW(P1,8), pw3[1]=PKW(P1,10), pw3); \
    VRD(7); SBAR(); GAPA(C1=__builtin_amdgcn_mfma_f32_32x32x16_bf16(kf[7],qr[3],C1,0,0,0),   P1[14],P1[15],0.f,0.f,       pw3[2]=PKW(P1,12),pw3[3]=PKW(P1,14), pw3); \
    C0=__builtin_amdgcn_mfma_f32_32x32x16_bf16(kf[8],qr[4],C0,0,0,0); C1=__builtin_amdgcn_mfma_f32_32x32x16_bf16(kf[9],qr[4],C1,0,0,0); SBAR(); \
    C0=__builtin_amdgcn_mfma_f32_32x32x16_bf16(kf[10],qr[5],C0,0,0,0); C1=__builtin_amdgcn_mfma_f32_32x32x16_bf16(kf[11],qr[5],C1,0,0,0); SBAR(); \
    l_reg+=sacc; \
    if(GK){DMA_K((t)+3,sl_cur);} if(GV){DMA_V((t)+1,sl_next);} \
    CMASK(C0,C1,t); \
    { float a=MX3(C0[0],C0[1],C1[0]),b=MX3(C0[2],C0[3],C1[1]); a=MX3(a,C1[2],C1[3]); \
      _Pragma("unroll") for(int r=4;r<16;r+=4){a=MX3(a,C0[r],C0[r+1]);b=MX3(b,C0[r+2],C0[r+3]);a=MX3(a,C1[r],C1[r+1]);b=MX3(b,C1[r+2],C1[r+3]);} \
      float rm=__builtin_fmaxf(a,b); { auto rr=__builtin_amdgcn_permlane32_swap(__float_as_uint(rm),__float_as_uint(rm),false,false); rm=__builtin_fmaxf(__uint_as_float(rr[0]),__uint_as_float(rr[1])); } \
      resc=false; \
      if(__builtin_expect(__any(rm>(float)THRL),0)){ const float dl=__builtin_fmaxf(rm,0.f); mhat+=dl; \
        _Pragma("unroll") for(int r=0;r<16;++r){C0[r]-=dl;C1[r]-=dl;} \
        _Pragma("unroll") for(int r=0;r<16;++r)negm[r]=-mhat; asm volatile("":"+v"(negm)); \
        const float f=__builtin_amdgcn_exp2f(-dl); l_reg*=f; if(hi==0)wsf[r32]=f; resc=true; } } \
    SBAR(); \
    GAPB(o[0]=__builtin_amdgcn_mfma_f32_32x32x16_bf16(PAF(0),VFR(0),o[0],0,0,0), C0,0); \
    GAPB(o[1]=__builtin_amdgcn_mfma_f32_32x32x16_bf16(PAF(0),VFR(4),o[1],0,0,0), C0,4); \
    KRD(GL,0); GAPB(o[0]=__builtin_amdgcn_mfma_f32_32x32x16_bf16(PAF(1),VFR(1),o[0],0,0,0), C0,8); \
    KRD(GL,1); GAPB(o[1]=__builtin_amdgcn_mfma_f32_32x32x16_bf16(PAF(1),VFR(5),o[1],0,0,0), C0,12); \
    KRD(GL,2); GAPB(o[0]=__builtin_amdgcn_mfma_f32_32x32x16_bf16(PAF(2),VFR(2),o[0],0,0,0), C1,0); \
    KRD(GL,3); GAPB(o[1]=__builtin_amdgcn_mfma_f32_32x32x16_bf16(PAF(2),VFR(6),o[1],0,0,0), C1,4); \
    KRD(GL,4); GAPB(o[0]=__builtin_amdgcn_mfma_f32_32x32x16_bf16(PAF(3),VFR(3),o[0],0,0,0), C1,8); \
    KRD(GL,5); GAPB(o[1]=__builtin_amdgcn_mfma_f32_32x32x16_bf16(PAF(3),VFR(7),o[1],0,0,0), C1,12); \
    }while(0)
  int t=1;
  #undef CMASK
  #define CMASK(P0,P1,t) do{}while(0)
  for(;t+5<NT;t+=2){
    STEP(pB0,pB1,pA0,pA1,t,true,true,true);     WAIT_BAR(3); RESC(); ROT();
    STEP(pA0,pA1,pB0,pB1,t+1,true,true,true);   WAIT_BAR(3); RESC(); ROT();
  }
  #undef CMASK
  #define CMASK(P0,P1,t) do{int jb_=(t)-(NT-4); if(jb_>=0)cmask(P0,P1,jb_,qrel,hi);}while(0)
  #define ENDW(tt) do{ if((tt)+3<NT){WAIT_BAR(3);} else if((tt)+2<NT){WAIT_BAR(1);} else {WAIT_BAR(0);} }while(0)
  for(;t+1<NT;t+=2){
    STEP(pB0,pB1,pA0,pA1,t,(t+3<NT),(t+1<NT),(t+1<NT));       ENDW(t);   RESC(); ROT();
    STEP(pA0,pA1,pB0,pB1,t+1,(t+4<NT),(t+2<NT),(t+2<NT));     ENDW(t+1); RESC(); ROT();
  }
  STEP(pB0,pB1,pA0,pA1,NT-1,false,false,false); RESC();
  { float sacc=pB0[0]+pB0[1]; _Pragma("unroll") for(int r=2;r<16;++r)sacc+=pB0[r]; _Pragma("unroll") for(int r=0;r<16;++r)sacc+=pB1[r]; l_reg+=sacc;
    pw0=(u32x4){PKW(pB0,0),PKW(pB0,2),PKW(pB0,4),PKW(pB0,6)};pw1=(u32x4){PKW(pB0,8),PKW(pB0,10),PKW(pB0,12),PKW(pB0,14)};pw2=(u32x4){PKW(pB1,0),PKW(pB1,2),PKW(pB1,4),PKW(pB1,6)};pw3=(u32x4){PKW(pB1,8),PKW(pB1,10),PKW(pB1,12),PKW(pB1,14)};
    SBAR(); pv(o,vb0+sl_cur,PAF(0),PAF(1),PAF(2),PAF(3)); }
  #undef PKW
  #undef PAF
  #undef VFR
  #undef PIN
  #undef MX3
  #undef GAPA
  #undef GAPB
  #undef EX
  #undef VRD
  #undef KRD
  #undef STEP
  #undef ENDW
  {auto rr=__builtin_amdgcn_permlane32_swap(__float_as_uint(l_reg),__float_as_uint(l_reg),false,false);l_reg=__uint_as_float(rr[0])+__uint_as_float(rr[1]);}
  if(hi==0)wsf[32+r32]=l_reg;asm volatile("s_waitcnt lgkmcnt(0)":::"memory");
  float rli[16];
  #pragma unroll
  for(int r=0;r<16;++r)rli[r]=__builtin_amdgcn_rcpf(wsf[32+crow(r,hi)]);
  bf16*Ow=O+(rowbase+q0+wid*QBLK)*1024+h*D;
  { bf16*stg=(bf16*)(shm+LDS_OST)+wid*2048;
    #pragma unroll
    for(int r=0;r<16;++r){const int orow=crow(r,hi);
      #pragma unroll
      for(int d0=0;d0<2;++d0)stg[orow*64+d0*32+r32]=f2bf(o[d0][r]*rli[r]);}
    asm volatile("s_waitcnt lgkmcnt(0)":::"memory");
    #pragma unroll
    for(int i=0;i<4;++i){const int row=i*8+(lane>>3),ch=lane&7; const u32x4 v=*(const u32x4*)(stg+row*64+ch*8); ATTN_STORE16(Ow+(long)row*1024+ch*8,v);} }
  asm volatile("s_waitcnt lgkmcnt(0)\n\ts_barrier":::"memory");
  #undef DMA_K
  #undef DMA_V
  #undef CMASK
  #undef START
  #undef RESC
  #undef ROT
}
constexpr int ATTN_LDS_BYTES=LDS_BYTES;
#undef SBAR
#undef WAIT_BAR
}

namespace ix {
constexpr int IKROW = 144;
DI unsigned sortable(float f) { const unsigned u = __float_as_uint(f); return (u & 0x80000000u) ? ~u : (u | 0x80000000u); }

DI void indexer_unit(const bf16_t* proj, const float* iw, unsigned* mask, int b, int qt16, unsigned char* lds, int tid) {
    float* SC = (float*)lds;
    unsigned char* IK = lds + 131072;
    const int w = __builtin_amdgcn_readfirstlane(tid >> 6), lane = tid & 63, r = lane & 31, hf = lane >> 5;
    const int mtile = w & 3, par = w >> 2;
    const int q0 = qt16 * 16, nch = (q0 + 16 + 127) >> 7;
    const int qq = ((r >> 4) & 1) + 2 * ((r >> 2) & 1), hh = (r & 3) + 4 * ((r >> 3) & 1);
    const bf16_t* ap = proj + (size_t)(b * S_ + q0 + 4 * mtile + qq) * NE_IN + C_IQ + hh * 64 + hf * 8;
    bf16x8 af[4];
#pragma unroll
    for (int ks = 0; ks < 4; ++ks) af[ks] = *(const bf16x8*)(ap + ks * 16);
    const int qA = 4 * mtile + 2 * hf;
    const float* iwp = iw + (size_t)(b * S_ + q0 + qA) * 8;
    const f32x4 iwA0 = *(const f32x4*)(iwp), iwA1 = *(const f32x4*)(iwp + 4), iwB0 = *(const f32x4*)(iwp + 8), iwB1 = *(const f32x4*)(iwp + 12);
    const int kr0 = tid >> 3, kc = tid & 7;
    const bf16_t* kp = proj + (size_t)(b * S_ + kr0) * NE_IN + C_IK + kc * 8;
    u32x4 g0 = *(const u32x4*)kp, g1 = *(const u32x4*)(kp + (size_t)64 * NE_IN);
    for (int c = 0; c < nch; ++c) {
        __syncthreads();
        *(u32x4*)(IK + kr0 * IKROW + kc * 16) = g0; *(u32x4*)(IK + (kr0 + 64) * IKROW + kc * 16) = g1;
        __syncthreads();
        if (c + 1 < nch) { kp += (size_t)128 * NE_IN; g0 = *(const u32x4*)kp; g1 = *(const u32x4*)(kp + (size_t)64 * NE_IN); }
#pragma unroll
        for (int t2 = 0; t2 < 2; ++t2) {
            const int ntile = par * 2 + t2;
            f32x16 acc = zero16();
#pragma unroll
            for (int ks = 0; ks < 4; ++ks) { const bf16x8 bfr = *(const bf16x8*)(IK + (ntile * 32 + r) * IKROW + ks * 32 + hf * 16); acc = mfma32(af[ks], bfr, acc); }
            float sA = 0.f, sB = 0.f;
#pragma unroll
            for (int e = 0; e < 4; ++e) { sA += fmaxf(acc[e], 0.f) * iwA0[e] + fmaxf(acc[4 + e], 0.f) * iwA1[e]; sB += fmaxf(acc[8 + e], 0.f) * iwB0[e] + fmaxf(acc[12 + e], 0.f) * iwB1[e]; }
            const int key = c * 128 + ntile * 32 + r, qposA = q0 + qA;
            SC[qA * 2048 + key] = (key <= qposA) ? sA : NEG_INF;
            SC[(qA + 1) * 2048 + key] = (key <= qposA + 1) ? sB : NEG_INF;
        }
    }
    __syncthreads();
    const int nI = nch * 2;
    LAS unsigned* hist = (LAS unsigned*)(lds + 153600 + w * 1024);
#pragma unroll 1
    for (int qsel = 0; qsel < 2; ++qsel) {
        const int qi = 2 * w + qsel, qpos = q0 + qi;
        unsigned u[32];
#pragma unroll
        for (int i = 0; i < 32; ++i) u[i] = (i < nI) ? sortable(SC[qi * 2048 + i * 64 + lane]) : 0u;
        unsigned long long mymask = 0ull;
        if (qpos < 256) {
#pragma unroll
            for (int i = 0; i < 32; ++i) { const unsigned long long bal = __ballot((i * 64 + lane) <= qpos); if (lane == i) mymask = bal; }
        } else {
            unsigned prefix = 0u; int need = 256, shift = 24; bool whole = false;
#pragma unroll 1
            for (int pass = 0; pass < 4; ++pass) {
                shift = 24 - 8 * pass;
                { unsigned zz = 0u; asm volatile("" : "+v"(zz)); *(u32x4*)(hist + lane * 4) = (u32x4){zz, zz, zz, zz}; }
#pragma unroll
                for (int i = 0; i < 32; ++i) if (i < nI) {
                    const bool in = (pass == 0) ? (u[i] > 0x007fffffu) : ((u[i] >> (shift + 8)) == prefix);
                    if (in) __hip_atomic_fetch_add(hist + ((u[i] >> shift) & 255u), 1u, __ATOMIC_RELAXED, __HIP_MEMORY_SCOPE_WAVEFRONT);
                }
                const u32x4 hv = *(const u32x4*)(hist + (63 - lane) * 4);
                const int sl = (int)(hv[0] + hv[1] + hv[2] + hv[3]);
                int pre = sl;
                pre += __builtin_amdgcn_update_dpp(0, pre, 0x111, 0xf, 0xf, false);
                pre += __builtin_amdgcn_update_dpp(0, pre, 0x112, 0xf, 0xf, false);
                pre += __builtin_amdgcn_update_dpp(0, pre, 0x114, 0xf, 0xf, false);
                pre += __builtin_amdgcn_update_dpp(0, pre, 0x118, 0xf, 0xf, false);
                pre += __builtin_amdgcn_update_dpp(0, pre, 0x142, 0xa, 0xf, false);
                pre += __builtin_amdgcn_update_dpp(0, pre, 0x143, 0xc, 0xf, false);
                const unsigned long long mk = __ballot(pre >= need);
                const int Lsel = __builtin_ctzll(mk);
                int above = pre - sl, bin = 4 * (63 - lane), nn = need, cnt = 0;
                if (above + (int)hv[3] >= need) { bin += 3; nn = need - above; cnt = (int)hv[3]; }
                else { above += (int)hv[3];
                    if (above + (int)hv[2] >= need) { bin += 2; nn = need - above; cnt = (int)hv[2]; }
                    else { above += (int)hv[2];
                        if (above + (int)hv[1] >= need) { bin += 1; nn = need - above; cnt = (int)hv[1]; }
                        else { above += (int)hv[1]; nn = need - above; cnt = (int)hv[0]; } } }
                bin = __builtin_amdgcn_readlane(bin, Lsel); need = __builtin_amdgcn_readlane(nn, Lsel); cnt = __builtin_amdgcn_readlane(cnt, Lsel);
                prefix = (prefix << 8) | (unsigned)bin;
                if (cnt == need) { whole = true; break; }
            }
            const unsigned T = whole ? (prefix << shift) : prefix;
            int tc = 0;
#pragma unroll
            for (int i = 0; i < 32; ++i) if (i < nI) {
                bool sel;
                if (whole) sel = (u[i] >= T);
                else {
                    const unsigned long long eq = __ballot(u[i] == T);
                    const int myrank = tc + (int)__builtin_amdgcn_mbcnt_hi((unsigned)(eq >> 32), __builtin_amdgcn_mbcnt_lo((unsigned)eq, 0u));
                    sel = (u[i] > T) || (u[i] == T && myrank < need);
                    tc += __popcll(eq);
                }
                const unsigned long long bal = __ballot(sel);
                if (lane == i) mymask = bal;
            }
        }
        if (lane < 32) { u32x2 o; o[0] = (unsigned)mymask; o[1] = (unsigned)(mymask >> 32); *(u32x2*)(mask + (size_t)(b * S_ + qpos) * 64 + 2 * lane) = o; }
    }
    __syncthreads();
}
}

namespace pr {
DI void ce_desc(float& x, float& y) { const float hi = fmaxf(x, y), lo = fminf(x, y); x = hi; y = lo; }
DI void sort16_desc(float (&a)[16]) {
    ce_desc(a[0], a[13]); ce_desc(a[1], a[12]); ce_desc(a[2], a[15]); ce_desc(a[3], a[14]); ce_desc(a[4], a[8]); ce_desc(a[5], a[6]); ce_desc(a[7], a[11]); ce_desc(a[9], a[10]);
    ce_desc(a[0], a[5]); ce_desc(a[1], a[7]); ce_desc(a[2], a[9]); ce_desc(a[3], a[4]); ce_desc(a[6], a[13]); ce_desc(a[8], a[14]); ce_desc(a[10], a[15]); ce_desc(a[11], a[12]);
    ce_desc(a[0], a[1]); ce_desc(a[2], a[3]); ce_desc(a[4], a[5]); ce_desc(a[6], a[8]); ce_desc(a[7], a[9]); ce_desc(a[10], a[11]); ce_desc(a[12], a[13]); ce_desc(a[14], a[15]);
    ce_desc(a[0], a[2]); ce_desc(a[1], a[3]); ce_desc(a[4], a[10]); ce_desc(a[5], a[11]); ce_desc(a[6], a[7]); ce_desc(a[8], a[9]); ce_desc(a[12], a[14]); ce_desc(a[13], a[15]);
    ce_desc(a[1], a[2]); ce_desc(a[3], a[12]); ce_desc(a[4], a[6]); ce_desc(a[5], a[7]); ce_desc(a[8], a[10]); ce_desc(a[9], a[11]); ce_desc(a[13], a[14]);
    ce_desc(a[1], a[4]); ce_desc(a[2], a[6]); ce_desc(a[5], a[8]); ce_desc(a[7], a[10]); ce_desc(a[9], a[13]); ce_desc(a[11], a[14]);
    ce_desc(a[2], a[4]); ce_desc(a[3], a[6]); ce_desc(a[9], a[12]); ce_desc(a[11], a[13]);
    ce_desc(a[3], a[5]); ce_desc(a[6], a[8]); ce_desc(a[7], a[9]); ce_desc(a[10], a[12]);
    ce_desc(a[3], a[4]); ce_desc(a[5], a[6]); ce_desc(a[7], a[8]); ce_desc(a[9], a[10]); ce_desc(a[11], a[12]);
    ce_desc(a[6], a[7]); ce_desc(a[8], a[9]);
}
DI void merge_top16(float (&a)[16], const float (&b)[16]) {
#pragma unroll
    for (int i = 0; i < 16; ++i) a[i] = fmaxf(a[i], b[15 - i]);
#pragma unroll
    for (int j = 8; j > 0; j >>= 1)
#pragma unroll
        for (int i = 0; i < 16; ++i) if ((i & j) == 0) ce_desc(a[i], a[i + j]);
}
constexpr int SUBK_MAT = 128 * 256;
constexpr int ROUTE_SCR = 2 * SUBK_MAT;
DI void stage_subk(const bf16_t* subk, int hp0, int hp1, unsigned char* lds, int tid) {
#pragma unroll
    for (int i = 0; i < 8; ++i) {
        const int piece = i * 512 + tid, slot = piece >> 11, pp = piece & 2047, row = pp >> 4, ch = pp & 15;
        const bf16_t* src = subk + (size_t)((slot ? hp1 : hp0) * 128 + row) * 128 + ((ch ^ (row & 15)) * 8);
        __builtin_amdgcn_global_load_lds((const unsigned*)src, (unsigned*)(lds + slot * SUBK_MAT + pp * 16), 16, 0, 0);
    }
}
DI void subkey_scores(const bf16x8 (&qf)[8], const unsigned char* mat, int r, int hf, float (&c)[4][16]) {
#pragma unroll
    for (int mt = 0; mt < 4; ++mt) {
        f32x16 acc = zero16();
        const int row = mt * 32 + r;
        const unsigned char* rp = mat + row * 256;
#pragma unroll
        for (int ks = 0; ks < 8; ++ks) acc = mfma32(*(const bf16x8*)(rp + (((2 * ks + hf) ^ (row & 15)) * 16)), qf[ks], acc);
#pragma unroll
        for (int e = 0; e < 16; ++e) {
            const unsigned key = (unsigned)(mt * 32 + (e & 3) + 8 * (e >> 2)) + 4u * (unsigned)hf;
            c[mt][e] = __uint_as_float((__float_as_uint(acc[e]) & ~127u) | key);
        }
    }
}
DI void sort_top16(float (&c)[4][16], float (&V)[16]) {
#pragma unroll
    for (int mt = 0; mt < 4; ++mt) sort16_desc(c[mt]);
    merge_top16(c[0], c[1]); merge_top16(c[2], c[3]); merge_top16(c[0], c[2]);
    float pb[16];
#pragma unroll
    for (int k = 0; k < 16; ++k) pb[k] = __shfl_xor(c[0][k], 32, 64);
    merge_top16(c[0], pb);
#pragma unroll
    for (int k = 0; k < 16; ++k) V[k] = c[0][k];
}
DI void route_block(const bf16_t* qp, const bf16_t* subk, unsigned short* re, float* rg, int unit, unsigned char* lds, int tid) {
    const int w = __builtin_amdgcn_readfirstlane(tid >> 6), lane = tid & 63, r = lane & 31, hf = lane >> 5;
    const int tg = w & 3, hh = w >> 2, token = unit * 128 + tg * 32 + r;
    unsigned char* ldsw = lds + ROUTE_SCR + w * 8192;
    const unsigned char* mat = lds + hh * SUBK_MAT;
    stage_subk(subk, 0, 8, lds, tid);
    bf16x8 qn[8];
    {
        const bf16_t* qptr = qp + (size_t)token * 2048 + (hh * 8) * 128 + hf * 8;
#pragma unroll
        for (int ks = 0; ks < 8; ++ks) qn[ks] = *(const bf16x8*)(qptr + ks * 16);
    }
#pragma unroll 1
    for (int hpair = 0; hpair < 2; ++hpair) {
        const int hA = hh * 4 + hpair * 2;
        float V0[16], V1[16];
#pragma unroll
        for (int k = 0; k < 16; ++k) { V0[k] = 0.f; V1[k] = 0.f; }
#pragma unroll 1
        for (int st = 0; st < 4; ++st) {
            const int s = hpair * 4 + st;
            bf16x8 qf[8];
#pragma unroll
            for (int ks = 0; ks < 8; ++ks) qf[ks] = qn[ks];
            asm volatile("s_waitcnt vmcnt(0)" ::: "memory");
            __syncthreads();
            float c[4][16];
            subkey_scores(qf, mat, r, hf, c);
            __syncthreads();
            if (s + 1 < 8) {
                stage_subk(subk, s + 1, 8 + s + 1, lds, tid);
                const bf16_t* qptr = qp + (size_t)token * 2048 + (hh * 8 + s + 1) * 128 + hf * 8;
#pragma unroll
                for (int ks = 0; ks < 8; ++ks) qn[ks] = *(const bf16x8*)(qptr + ks * 16);
            }
            float Bt[16]; sort_top16(c, Bt);
            const bool to0 = (st == 0) || (st == 2 && hf), to1 = (st == 1) || (st == 3 && hf);
#pragma unroll
            for (int k = 0; k < 16; ++k) { V0[k] = to0 ? Bt[k] : V0[k]; V1[k] = to1 ? Bt[k] : V1[k]; }
        }
        const int head = hA + hf;
        float cv[64];
        {
            int n = 0;
#pragma unroll
            for (int i = 0; i < 16; ++i)
#pragma unroll
                for (int j = 0; j < 16; ++j) if ((i + 1) * (j + 1) <= 16) { cv[n] = V0[i] + V1[j]; ++n; }
#pragma unroll
            for (int k = 50; k < 64; ++k) cv[k] = NEG_INF;
        }
        float sv[4][16];
#pragma unroll
        for (int g = 0; g < 4; ++g) {
#pragma unroll
            for (int i = 0; i < 16; ++i) sv[g][i] = cv[g * 16 + i];
            sort16_desc(sv[g]);
        }
        merge_top16(sv[0], sv[1]); merge_top16(sv[2], sv[3]); merge_top16(sv[0], sv[2]);
        const float smax = sv[0][0], thr = sv[0][15];
        float den = 0.f;
#pragma unroll
        for (int k = 0; k < 16; ++k) den += __expf(sv[0][k] - smax);
        const float inv = 1.0f / den;
        int pos = 0;
        {
            int n = 0;
#pragma unroll
            for (int i = 0; i < 16; ++i)
#pragma unroll
                for (int j = 0; j < 16; ++j) if ((i + 1) * (j + 1) <= 16) {
                    if (cv[n] >= thr && pos < 16) {
                        u32x2 ent; ent[0] = ((__float_as_uint(V0[i]) & 127u) << 7) | (__float_as_uint(V1[j]) & 127u); ent[1] = __float_as_uint(__expf(cv[n] - smax) * inv);
                        *(u32x2*)(ldsw + pos * 512 + lane * 8) = ent; ++pos;
                    }
                    ++n;
                }
        }
        unsigned short* rep = re + (size_t)token * 128 + head * 16; float* rgp = rg + (size_t)token * 128 + head * 16;
        unsigned ev[8];
#pragma unroll
        for (int k4 = 0; k4 < 4; ++k4) {
            f32x4 gv; unsigned e4[4];
#pragma unroll
            for (int q = 0; q < 4; ++q) { const u32x2 ent = *(const u32x2*)(ldsw + (k4 * 4 + q) * 512 + lane * 8); e4[q] = ent[0]; gv[q] = __uint_as_float(ent[1]); }
            ev[2 * k4] = e4[0] | (e4[1] << 16); ev[2 * k4 + 1] = e4[2] | (e4[3] << 16);
            *(f32x4*)(rgp + 4 * k4) = gv;
        }
        *(u32x4*)rep = (u32x4){ev[0], ev[1], ev[2], ev[3]}; *(u32x4*)(rep + 8) = (u32x4){ev[4], ev[5], ev[6], ev[7]};
    }
    __syncthreads();
}

DI void fp8x16_to_f32(const u32x4 d, float (&f)[16]) {
#pragma unroll
    for (int q = 0; q < 4; ++q) {
        const f32x2 lo = __builtin_amdgcn_cvt_pk_f32_fp8((int)d[q], false), hi = __builtin_amdgcn_cvt_pk_f32_fp8((int)d[q], true);
        f[4 * q] = lo[0]; f[4 * q + 1] = lo[1]; f[4 * q + 2] = hi[0]; f[4 * q + 3] = hi[1];
    }
}
DI void ld_ids(const unsigned short* re, int t, int g, int (&ids)[16]) {
    const u32x4 a = *(const u32x4*)(re + (size_t)t * 128 + g * 16), b = *(const u32x4*)(re + (size_t)t * 128 + g * 16 + 8);
#pragma unroll
    for (int q = 0; q < 4; ++q) { ids[2 * q] = (int)(a[q] & 0xffffu); ids[2 * q + 1] = (int)(a[q] >> 16); ids[8 + 2 * q] = (int)(b[q] & 0xffffu); ids[8 + 2 * q + 1] = (int)(b[q] >> 16); }
}
DI void ld_rows(const unsigned char* tab, unsigned laneoff, const int (&ids)[16], u32x4 (&data)[16]) {
#pragma unroll
    for (int i = 0; i < 16; ++i) data[i] = *(const u32x4*)(tab + (size_t)((unsigned)ids[i] * 128u + laneoff));
}
DI void peer_u_loop(const bf16_t* h2, const unsigned char* U, const unsigned short* re, bf16_t* pd, int t0, int tstep, int slice, int lane) {
    const int g = lane >> 3, c = lane & 7;
    const unsigned laneoff = (unsigned)(slice * (NEXP * 128) + c * 16);
    const bf16_t* hb = h2 + slice * 128 + c * 16;
    if (t0 >= T_) return;
    int idsn[16]; u32x4 data[16]; u32x4 h0, h1;
    ld_ids(re, t0, g, idsn); ld_rows(U, laneoff, idsn, data);
    h0 = *(const u32x4*)(hb + (size_t)t0 * 1024); h1 = *(const u32x4*)(hb + (size_t)t0 * 1024 + 8);
    ld_ids(re, min(t0 + tstep, T_ - 1), g, idsn);
    const bool b2 = (c & 4) != 0, b1 = (c & 2) != 0, b0 = (c & 1) != 0;
#pragma unroll 1
    for (int t = t0; t < T_; t += tstep) {
        const int tnc = min(t + tstep, T_ - 1), tnn = min(t + 2 * tstep, T_ - 1);
        f32x2 hp[8];
#pragma unroll
        for (int q = 0; q < 4; ++q) { hp[q] = (f32x2){bf_lo(h0[q]), bf_hi(h0[q])}; hp[4 + q] = (f32x2){bf_lo(h1[q]), bf_hi(h1[q])}; }
        h0 = *(const u32x4*)(hb + (size_t)tnc * 1024); h1 = *(const u32x4*)(hb + (size_t)tnc * 1024 + 8);
        float part[16];
#pragma unroll
        for (int i = 0; i < 16; ++i) {
            const u32x4 d = data[i];
            data[i] = *(const u32x4*)(U + (size_t)((unsigned)idsn[i] * 128u + laneoff));
            f32x2 s2 = {0.f, 0.f};
#pragma unroll
            for (int q = 0; q < 4; ++q) {
                const f32x2 lo = __builtin_amdgcn_cvt_pk_f32_fp8((int)d[q], false), hi = __builtin_amdgcn_cvt_pk_f32_fp8((int)d[q], true);
                s2 = __builtin_elementwise_fma(lo, hp[2 * q], s2); s2 = __builtin_elementwise_fma(hi, hp[2 * q + 1], s2);
            }
            part[i] = s2[0] + s2[1];
        }
        ld_ids(re, tnn, g, idsn);
        float a8[8], a4[4], a2[2];
#pragma unroll
        for (int k = 0; k < 8; ++k) { const float keep = b2 ? part[8 + k] : part[k], send = b2 ? part[k] : part[8 + k]; a8[k] = keep + __shfl_xor(send, 4, 64); }
#pragma unroll
        for (int k = 0; k < 4; ++k) { const float keep = b1 ? a8[4 + k] : a8[k], send = b1 ? a8[k] : a8[4 + k]; a4[k] = keep + __shfl_xor(send, 2, 64); }
#pragma unroll
        for (int k = 0; k < 2; ++k) { const float keep = b0 ? a4[2 + k] : a4[k], send = b0 ? a4[k] : a4[2 + k]; a2[k] = keep + __shfl_xor(send, 1, 64); }
        *(unsigned*)(pd + (size_t)t * 1024 + slice * 128 + 2 * lane) = pk_bf16(a2[0], a2[1]);
    }
}
DI void peer_combine(const bf16_t* pd, float* wg, const float* ps, int tb, int lane) {
    const int t = tb + (lane >> 4), p0 = (lane & 15) * 8;
    const f32x4 q0 = *(const f32x4*)(ps + (size_t)t * 16), q1 = *(const f32x4*)(ps + (size_t)t * 16 + 4), q2 = *(const f32x4*)(ps + (size_t)t * 16 + 8), q3 = *(const f32x4*)(ps + (size_t)t * 16 + 12);
    const float sq = (((q0[0] + q0[1]) + (q0[2] + q0[3])) + ((q1[0] + q1[1]) + (q1[2] + q1[3]))) + (((q2[0] + q2[1]) + (q2[2] + q2[3])) + ((q3[0] + q3[1]) + (q3[2] + q3[3])));
    const float rs = (1.0f / TAB_SCALE) / sqrtf(sq * (1.0f / 1024.0f) + 1e-6f);
    u32x4 v[8];
#pragma unroll
    for (int sl = 0; sl < 8; ++sl) v[sl] = *(const u32x4*)(pd + (size_t)t * 1024 + sl * 128 + p0);
    float* gp = wg + (size_t)t * 128 + p0;
    const f32x4 g0 = *(const f32x4*)gp, g1 = *(const f32x4*)(gp + 4);
    float d[8];
#pragma unroll
    for (int k = 0; k < 8; ++k) d[k] = 0.f;
#pragma unroll
    for (int sl = 0; sl < 8; ++sl)
#pragma unroll
        for (int q = 0; q < 4; ++q) { d[2 * q] += bf_lo(v[sl][q]); d[2 * q + 1] += bf_hi(v[sl][q]); }
    f32x4 o0, o1;
#pragma unroll
    for (int k = 0; k < 8; ++k) {
        const float cc = d[k] * rs;
        const float g = (k < 4) ? g0[k & 3] : g1[k & 3];
        const float r = g * 0.5f * cc * (1.0f + erff(cc * 0.70710678118654752f)) * (1.0f / TAB_SCALE);
        if (k < 4) o0[k & 3] = r; else o1[k & 3] = r;
    }
    *(f32x4*)gp = o0; *(f32x4*)(gp + 4) = o1;
}
DI void ld_w(const float* wg, int t, int g, float (&wv)[16]) {
#pragma unroll
    for (int q = 0; q < 4; ++q) { const f32x4 wq = *(const f32x4*)(wg + (size_t)t * 128 + g * 16 + q * 4); wv[4 * q] = wq[0]; wv[4 * q + 1] = wq[1]; wv[4 * q + 2] = wq[2]; wv[4 * q + 3] = wq[3]; }
}
DI void peer_v_loop(bf16_t* xb, float* psa, const unsigned char* V, const unsigned short* re, const float* wg, int t0, int tstep, int slice, int lane) {
    const int g = lane >> 3, c = lane & 7;
    const unsigned laneoff = (unsigned)(slice * (NEXP * 128) + c * 16);
    if (t0 >= T_) return;
    int idsn[16]; u32x4 data[16]; float wv[16], wn[16];
    ld_ids(re, t0, g, idsn); ld_rows(V, laneoff, idsn, data); ld_w(wg, t0, g, wv);
    { const int tc = min(t0 + tstep, T_ - 1); ld_ids(re, tc, g, idsn); ld_w(wg, tc, g, wn); }
    const bool b5 = (lane & 32) != 0, b4 = (lane & 16) != 0, b3 = (lane & 8) != 0;
#pragma unroll 1
    for (int t = t0; t < T_; t += tstep) {
        const int tnn = min(t + 2 * tstep, T_ - 1);
        const size_t o = (size_t)t * 1024 + slice * 128 + c * 16 + 2 * g;
        const unsigned xo = *(const unsigned*)(xb + o);
        f32x2 acc2[8];
#pragma unroll
        for (int k = 0; k < 8; ++k) acc2[k] = (f32x2){0.f, 0.f};
#pragma unroll
        for (int i = 0; i < 16; ++i) {
            const u32x4 d = data[i];
            data[i] = *(const u32x4*)(V + (size_t)((unsigned)idsn[i] * 128u + laneoff));
            const f32x2 w2 = {wv[i], wv[i]};
#pragma unroll
            for (int q = 0; q < 4; ++q) {
                const f32x2 lo = __builtin_amdgcn_cvt_pk_f32_fp8((int)d[q], false), hi = __builtin_amdgcn_cvt_pk_f32_fp8((int)d[q], true);
                acc2[2 * q] = __builtin_elementwise_fma(lo, w2, acc2[2 * q]); acc2[2 * q + 1] = __builtin_elementwise_fma(hi, w2, acc2[2 * q + 1]);
            }
        }
        float acc[16];
#pragma unroll
        for (int k = 0; k < 8; ++k) { acc[2 * k] = acc2[k][0]; acc[2 * k + 1] = acc2[k][1]; }
#pragma unroll
        for (int k = 0; k < 16; ++k) wv[k] = wn[k];
        ld_ids(re, tnn, g, idsn); ld_w(wg, tnn, g, wn);
        float a8[8], a4[4], a2[2];
#pragma unroll
        for (int k = 0; k < 8; ++k) { const float keep = b5 ? acc[8 + k] : acc[k], send = b5 ? acc[k] : acc[8 + k]; a8[k] = keep + __shfl_xor(send, 32, 64); }
#pragma unroll
        for (int k = 0; k < 4; ++k) { const float keep = b4 ? a8[4 + k] : a8[k], send = b4 ? a8[k] : a8[4 + k]; a4[k] = keep + __shfl_xor(send, 16, 64); }
#pragma unroll
        for (int k = 0; k < 2; ++k) { const float keep = b3 ? a4[2 + k] : a4[k], send = b3 ? a4[k] : a4[2 + k]; a2[k] = keep + __shfl_xor(send, 8, 64); }
        const float y0 = bf_lo(xo) + a2[0], y1 = bf_hi(xo) + a2[1];
        *(unsigned*)(xb + o) = pk_bf16(y0, y1);
        const float ss = wave_sum(y0 * y0 + y1 * y1);
        if (lane == 0) psa[(size_t)t * 8 + slice] = ss;
    }
}
}

constexpr int NPHASE = 1 + 12 * DEPTH_;

#ifndef MK_ONE_LAUNCH
#define MK_ONE_LAUNCH 1
#endif

__global__ void __launch_bounds__(NTHR, 2) k_main(Params p) {
    extern __shared__ __attribute__((aligned(16))) unsigned char lds[];
    unsigned char* const ws = p.ws;
    const int bid = blockIdx.x, nblk = gridDim.x;
    const bool fused = (p.ph_hi - p.ph_lo) > 1;
    XcdBarrier bar; bar.bar = (unsigned*)(ws + WS_BAR); bar.x = 0; bar.st = (volatile LAS unsigned*)(lds + LDS_BYTES - 16);
    if (fused) {
        if (threadIdx.x == 0) *(u32x4*)(lds + LDS_BYTES - 16) = (u32x4){0u, 0u, 0u, 0u};
        __syncthreads();
        bar = xcd_barrier_post((unsigned*)(ws + WS_BAR), (volatile LAS unsigned*)(lds + LDS_BYTES - 16));
    }
#define PH_BEGIN(k) if (p.ph_lo <= (k) && (k) < p.ph_hi) { int tv = threadIdx.x; asm volatile("" : "+v"(tv)); (void)tv;
#define PH_END(k) if ((k) + 1 < p.ph_hi) xcd_barrier(bar); }
#define REPN(bit) (((DBG_REP >> (bit)) & 1) ? 2 : 1)

    float* const PSA = (float*)(ws + WS_RSTD);
    bf16_t* const H = (bf16_t*)(ws + WS_H);
    bf16_t* const O = (bf16_t*)(ws + WS_O);
    const float* const c64 = (const float*)(ws + WS_COS64); const float* const s64 = (const float*)(ws + WS_SIN64);
    const float* const c32 = (const float*)(ws + WS_COS32); const float* const s32 = (const float*)(ws + WS_SIN32);

    PH_BEGIN(0)
        int toff = 0;
        for (int rep = 0; rep < REPN(14); ++rep) {
        for (int j = 0; j < 2; ++j) {
            prep_wt<1>(p.hyb_w_in + (size_t)j * 1024 * 2760, 1024, 2760, (bf16_t*)(ws + WS_WEIN + j * SZ_WEIN), NE_IN, p.attn_norm + (2 * j) * 1024, toff, bid, nblk, tv);
            prep_wt<2>(p.hyb_w_out + (size_t)j * 1024 * 1024, 1024, 1024, (bf16_t*)(ws + WS_WEOUT + j * SZ_WSQ), 1024, nullptr, toff, bid, nblk, tv);
            prep_wt<3>(p.mla_w_in + (size_t)j * 1024 * 1056, 1024, 1056, (bf16_t*)(ws + WS_WMIN + j * SZ_WMIN), NM_IN, p.attn_norm + (2 * j + 1) * 1024, toff, bid, nblk, tv);
            prep_wt<4>(p.mla_w_uq + (size_t)j * 768 * 1536, 768, 1536, (bf16_t*)(ws + WS_WUQ + j * SZ_WUQ), 1536, p.mla_q_norm + j * 768, toff, bid, nblk, tv);
            prep_wt<2>(p.mla_w_ukv + (size_t)j * 256 * 2048, 256, 2048, (bf16_t*)(ws + WS_WUKV + j * SZ_WUKV), 2048, p.mla_kv_norm + j * 256, toff, bid, nblk, tv);
            prep_wt<2>(p.mla_w_out + (size_t)j * 1024 * 1024, 1024, 1024, (bf16_t*)(ws + WS_WMOUT + j * SZ_WSQ), 1024, nullptr, toff, bid, nblk, tv);
        }
        for (int j = 0; j < 4; ++j) prep_wt<2>(p.peer_w_q + (size_t)j * 1024 * 2048, 1024, 2048, (bf16_t*)(ws + WS_WPQ + j * SZ_WPQ), 2048, p.ffn_norm + j * 1024, toff, bid, nblk, tv);
        cvt_bf16(p.peer_sub_keys, (bf16_t*)(ws + WS_SUBK), (size_t)4 * 16 * 128 * 128, bid, nblk, tv);
        cvt_fp8(p.peer_u, ws + WS_U16, (size_t)4 * NEXP * 1024, TAB_SCALE, p.ffn_norm, bid, nblk, tv);
        cvt_fp8(p.peer_v, ws + WS_V16, (size_t)4 * NEXP * 1024, TAB_SCALE, nullptr, bid, nblk, tv);
        rope_tables(p.pos, (float*)(ws + WS_COS64), (float*)(ws + WS_SIN64), (float*)(ws + WS_COS32), (float*)(ws + WS_SIN32), bid, nblk, tv);
        x_to_stream(p.x, H, PSA, bid, nblk, tv);
        }
    PH_END(0)

#pragma unroll 1
    for (int L = 0; L < DEPTH_; ++L) {
        const int base = 1 + 12 * L, j = L >> 1;
        if ((L & 1) == 0) {
            bf16_t* PROJ = (bf16_t*)(ws + WS_P); bf16_t* vaT = (bf16_t*)(ws + WS_VT); bf16_t* vbT = (bf16_t*)(ws + WS_VT + 4 * MiB);
            float* IW = (float*)(ws + WS_IW); unsigned* MASK = (unsigned*)(ws + WS_MASK);
            PH_BEGIN(base + 0)
                gm::EpiEvenIn e{PROJ, vaT, vbT, IW, c64, s64, PSA};
                for (int rep = 0; rep < REPN(0); ++rep)
                gm::gemm_phase(H, 1024, (const bf16_t*)(ws + WS_WEIN + j * SZ_WEIN), T_, NE_IN, 1024, e, lds, bid, nblk);
            PH_END(base + 0)
            PH_BEGIN(base + 1)
                const at::Args aB{PROJ, PROJ, nullptr, vbT, nullptr, O};
                for (int rep = 0; rep < REPN(1); ++rep) {
                int kbh = -1;
                for (int u = bid; u < 1024; u += nblk) {
                    int tw = threadIdx.x; asm volatile("" : "+v"(tw));
                    const int i = u >> 7, bh = u & 127;
                    const int qt = (0x32451067 >> (4 * i)) & 7;
                    if (bh != kbh) { ab::moba_kmean(bh >> 3, bh & 7, 7, PROJ + C_KB, (char*)lds, tw); kbh = bh; }
                    ab::attn_unit<8, 1>(bh >> 3, bh & 7, qt, PROJ + C_QB, PROJ + C_KB, PROJ + C_VB, O + 512, nullptr, (char*)lds, tw);
                }
                }
                for (int rep = 0; rep < REPN(2); ++rep)
                for (int u = bid; u < 2048; u += nblk) {
                    int tw = threadIdx.x; asm volatile("" : "+v"(tw));
                    const int b = u & 15, g = u >> 4, k = g >> 4, gl = g & 15;
                    const int qt16 = 16 * (7 - k) + ((k & 1) ? gl : 15 - gl);
                    ix::indexer_unit(PROJ, IW, MASK, b, qt16, lds, tw);
                }
            PH_END(base + 1)
            PH_BEGIN(base + 2)
                const at::Args aA{PROJ, PROJ, nullptr, vaT, MASK, O};
                for (int rep = 0; rep < REPN(3); ++rep)
                for (int u = bid; u < 1024; u += nblk) {
                    int tw = threadIdx.x; asm volatile("" : "+v"(tw));
                    const int k = u >> 8, c = u & 255, b = c >> 4, jj = c & 15;
                    const int qt = (k == 0) ? 63 - jj : (k == 1) ? 32 + jj : (k == 2) ? 31 - jj : jj;
                    ab::attn_unit<8, 2>(b, 0, qt, PROJ + C_QA, PROJ + C_KA, PROJ + C_VA, O, MASK, (char*)lds, tw);
                }
            PH_END(base + 2)
            PH_BEGIN(base + 4)
                {
                gm::EpiResid e{H, (float*)(ws + WS_PSF), nullptr};
                gm::gemm_phase(O, 1024, (const bf16_t*)(ws + WS_WEOUT + j * SZ_WSQ), T_, 1024, 1024, e, lds, bid, nblk); }
            PH_END(base + 4)
        } else {
            bf16_t* CIN = (bf16_t*)(ws + WS_P_CIN); bf16_t* QM = (bf16_t*)(ws + WS_P_QM); bf16_t* KN = (bf16_t*)(ws + WS_P_KN); bf16_t* vT = (bf16_t*)(ws + WS_VT);
            float* RSTD = (float*)(ws + WS_MASK);
            PH_BEGIN(base + 0)
                gm::EpiMlaIn e{CIN, c32, s32, RSTD, PSA};
                for (int rep = 0; rep < REPN(0); ++rep)
                gm::gemm_phase(H, 1024, (const bf16_t*)(ws + WS_WMIN + j * SZ_WMIN), T_, 1024, 1024, e, lds, bid, nblk);
            PH_END(base + 0)
            PH_BEGIN(base + 2)
                for (int rep = 0; rep < REPN(5); ++rep) {
                mla_krope_units(H, (const bf16_t*)(ws + WS_WMIN + j * SZ_WMIN) + (size_t)1024 * 1024, PSA, c32, s32, CIN, bid, nblk, tv);
                { gm::EpiQup e{QM, RSTD, c32, s32, RSTD};
                  gm::gemm_phase(CIN, NM_IN, (const bf16_t*)(ws + WS_WUQ + j * SZ_WUQ), T_, 1536, 768, e, lds, bid, nblk); }
                { gm::EpiKVup e{KN, vT, RSTD, RSTD};
                  gm::gemm_phase(CIN + 768, NM_IN, (const bf16_t*)(ws + WS_WUKV + j * SZ_WUKV), T_, 2048, 256, e, lds, bid, nblk); } }
            PH_END(base + 2)
            PH_BEGIN(base + 3)
                const at::Args aC{QM, KN, CIN, vT, nullptr, O};
                for (int rep = 0; rep < REPN(6); ++rep)
                for (int u = bid; u < 2048; u += nblk) {
                    int tw = threadIdx.x; asm volatile("" : "+v"(tw));
                    const int i = u >> 8, bh = u & 255;
                    am::attn_unit<8>(bh >> 4, bh & 15, 7 - i, QM, KN, CIN, vT, O, (char*)lds, tw);
                }
            PH_END(base + 3)
            PH_BEGIN(base + 4)
                {
                gm::EpiResid e{H, (float*)(ws + WS_PSF), nullptr};
                gm::gemm_phase(O, 1024, (const bf16_t*)(ws + WS_WMOUT + j * SZ_WSQ), T_, 1024, 1024, e, lds, bid, nblk); }
            PH_END(base + 4)
        }
        bf16_t* QP = (bf16_t*)(ws + WS_P);
        unsigned short* RE = (unsigned short*)(ws + WS_RE); float* RG = (float*)(ws + WS_RG);
        PH_BEGIN(base + 6)
            gm::EpiBf16 e{QP, 2048, (const float*)(ws + WS_PSF)};
            for (int rep = 0; rep < REPN(9); ++rep)
            gm::gemm_phase(H, 1024, (const bf16_t*)(ws + WS_WPQ + L * SZ_WPQ), T_, 2048, 1024, e, lds, bid, nblk);
        PH_END(base + 6)
        PH_BEGIN(base + 7)
            const int w = tv >> 6;
            for (int rep = 0; rep < REPN(10); ++rep)
            for (int u = bid; u < T_ / 128; u += nblk) { int tw = threadIdx.x; asm volatile("" : "+v"(tw)); pr::route_block(QP, (const bf16_t*)(ws + WS_SUBK + L * SZ_SUBK), RE, RG, u, lds, tw); }
        PH_END(base + 7)
        bf16_t* PD = (bf16_t*)(ws + WS_P);
        PH_BEGIN(base + 8)
            const int w = tv >> 6, ngrp = nblk >> 3, slice = bid & 7, rank = bid >> 3;
            if (rank < ngrp)
            for (int rep = 0; rep < REPN(11); ++rep)
            pr::peer_u_loop(H, ws + WS_U16 + L * SZ_TAB, RE, PD, rank * 8 + w, ngrp * 8, slice, tv & 63);
        PH_END(base + 8)
        PH_BEGIN(base + 9)
            const int w = tv >> 6;
            for (int t = (bid * 8 + w) * 4; t < T_; t += nblk * 32) pr::peer_combine(PD, RG, (const float*)(ws + WS_PSF), t, tv & 63);
        PH_END(base + 9)
        PH_BEGIN(base + 10)
            const int w = tv >> 6, ngrp = nblk >> 3, slice = bid & 7, rank = bid >> 3;
            if (rank < ngrp)
            pr::peer_v_loop(H, PSA, ws + WS_V16 + L * SZ_TAB, RE, RG, rank * 8 + w, ngrp * 8, slice, tv & 63);
        PH_END(base + 10)
        if (L + 1 == DEPTH_) {
        PH_BEGIN(base + 11)
            final_norm_rows(H, p.final_norm, p.out, bid, nblk, tv);
        PH_END(base + 11)
        }
    }
#undef PH_BEGIN
#undef PH_END
}

extern "C" void kernel_launch(void* const* d_in, const int* in_sizes, int n_in, void* d_out, int out_size, void* d_ws, size_t ws_size, hipStream_t stream) {
    static int grid = 0;
    if (grid == 0) {
        if (n_in != 17 || out_size != T_ * D_ || ws_size < WS_END) { fprintf(stderr, "kernel_launch: unexpected shapes (n_in %d out %d ws %zu need %zu)\n", n_in, out_size, ws_size, (size_t)WS_END); grid = -1; return; }
        int dev = 0, cus = 0, per_cu = 0;
        if (hipGetDevice(&dev) != hipSuccess || hipDeviceGetAttribute(&cus, hipDeviceAttributeMultiprocessorCount, dev) != hipSuccess) { grid = -1; return; }
        if (hipFuncSetAttribute((const void*)k_main, hipFuncAttributeMaxDynamicSharedMemorySize, LDS_BYTES) != hipSuccess) { fprintf(stderr, "kernel_launch: hipFuncSetAttribute failed\n"); grid = -1; return; }
        if (hipOccupancyMaxActiveBlocksPerMultiprocessor(&per_cu, (const void*)k_main, NTHR, LDS_BYTES) != hipSuccess || per_cu < 1) { fprintf(stderr, "kernel_launch: occupancy query says %d\n", per_cu); per_cu = 1; }
        (void)hipGetLastError();
        grid = cus;
    }
    if (grid < 0) return;
    (void)hipMemsetAsync((char*)d_ws + WS_BAR, 0, XCD_BAR_WORDS * sizeof(unsigned), stream);
    Params p{};
    p.x = (const float*)d_in[0]; p.pos = (const int*)d_in[1]; p.attn_norm = (const float*)d_in[2]; p.ffn_norm = (const float*)d_in[3]; p.final_norm = (const float*)d_in[4];
    p.hyb_w_in = (const float*)d_in[5]; p.hyb_w_out = (const float*)d_in[6]; p.mla_w_in = (const float*)d_in[7]; p.mla_q_norm = (const float*)d_in[8]; p.mla_kv_norm = (const float*)d_in[9];
    p.mla_w_uq = (const float*)d_in[10]; p.mla_w_ukv = (const float*)d_in[11]; p.mla_w_out = (const float*)d_in[12]; p.peer_w_q = (const float*)d_in[13]; p.peer_sub_keys = (const float*)d_in[14];
    p.peer_u = (const float*)d_in[15]; p.peer_v = (const float*)d_in[16];
    p.out = (float*)d_out; p.ws = (unsigned char*)d_ws;
#if MK_ONE_LAUNCH
    p.ph_lo = 0; p.ph_hi = NPHASE;
    hipLaunchKernelGGL(k_main, dim3(grid), dim3(NTHR), LDS_BYTES, stream, p);
#else
    for (int ph = 0; ph < NPHASE; ++ph) {
        if (ph > 0) { const int L = (ph - 1) / 12, slot = (ph - 1) % 12; if ((slot == 3 && (L & 1) == 0) || (slot == 1 && (L & 1) == 1) || slot == 5 || (slot == 11 && L + 1 < DEPTH_)) continue; }
        p.ph_lo = ph; p.ph_hi = ph + 1;
        hipLaunchKernelGGL(k_main, dim3(grid), dim3(NTHR), LDS_BYTES, stream, p);
    }
#endif
}
```

```cpp
#include <hip/hip_runtime.h>
#include <stdint.h>
#include <stdio.h>
#include <cmath>

#define DI __device__ __forceinline__
#ifndef DBG_REP
#define DBG_REP 0
#endif
#ifndef DBG_SKIP
#define DBG_SKIP 0
#endif
#define LAS __attribute__((address_space(3)))
typedef unsigned short bf16_t;
typedef short bf16x8 __attribute__((ext_vector_type(8)));
typedef short s16x4 __attribute__((ext_vector_type(4)));
typedef float f32x2 __attribute__((ext_vector_type(2)));
typedef float f32x4 __attribute__((ext_vector_type(4)));
typedef float f32x16 __attribute__((ext_vector_type(16)));
typedef unsigned u32x2 __attribute__((ext_vector_type(2)));
typedef unsigned u32x4 __attribute__((ext_vector_type(4)));
typedef __bf16 bf2_t __attribute__((ext_vector_type(2)));

constexpr int T_ = 32768, D_ = 1024, S_ = 2048, NB_ = 16, DEPTH_ = 4;
constexpr int NE_IN = 2816;
constexpr int NM_IN = 1280;
constexpr int NEXP = 16384;
constexpr int NTHR = 512;
constexpr int LDS_BYTES = 163840;
constexpr float LOG2E = 1.4426950408889634f;
constexpr float NEG_INF = -__builtin_inff();
constexpr float TAB_SCALE = 64.0f;

constexpr int C_QA = 0, C_KA = 512, C_VA = 576, C_IQ = 640, C_IK = 1152, C_QB = 1216, C_KB = 1728, C_VB = 2240, C_IW = 2752;

constexpr size_t MiB = 1024 * 1024;
constexpr size_t WS_BAR = 0;
constexpr size_t WS_COS64 = 64 * 1024;
constexpr size_t WS_SIN64 = WS_COS64 + 4 * MiB;
constexpr size_t WS_COS32 = WS_SIN64 + 4 * MiB;
constexpr size_t WS_SIN32 = WS_COS32 + 2 * MiB;
constexpr size_t WS_WEIN = WS_SIN32 + 2 * MiB;
constexpr size_t SZ_WEIN = (size_t)NE_IN * 1024 * 2;
constexpr size_t WS_WEOUT = WS_WEIN + 2 * SZ_WEIN;
constexpr size_t SZ_WSQ = (size_t)1024 * 1024 * 2;
constexpr size_t WS_WMIN = WS_WEOUT + 2 * SZ_WSQ;
constexpr size_t SZ_WMIN = (size_t)NM_IN * 1024 * 2;
constexpr size_t WS_WUQ = WS_WMIN + 2 * SZ_WMIN;
constexpr size_t SZ_WUQ = (size_t)1536 * 768 * 2;
constexpr size_t WS_WUKV = WS_WUQ + 2 * SZ_WUQ;
constexpr size_t SZ_WUKV = (size_t)2048 * 256 * 2;
constexpr size_t WS_WMOUT = WS_WUKV + 2 * SZ_WUKV;
constexpr size_t WS_WPQ = WS_WMOUT + 2 * SZ_WSQ;
constexpr size_t SZ_WPQ = (size_t)2048 * 1024 * 2;
constexpr size_t WS_SUBK = WS_WPQ + 4 * SZ_WPQ;
constexpr size_t SZ_SUBK = (size_t)16 * 128 * 128 * 2;
constexpr size_t WS_U16 = WS_SUBK + 4 * SZ_SUBK;
constexpr size_t SZ_TAB = (size_t)NEXP * 1024;
constexpr size_t WS_V16 = WS_U16 + 4 * SZ_TAB;
constexpr size_t WS_X = WS_V16 + 4 * SZ_TAB;
constexpr size_t WS_H = WS_X + 128 * MiB;
constexpr size_t WS_O = WS_H + 64 * MiB;
constexpr size_t WS_P = WS_O + 64 * MiB;
constexpr size_t WS_P_CIN = WS_P;
constexpr size_t WS_P_QM = WS_P + 80 * MiB;
constexpr size_t WS_P_KN = WS_P + 176 * MiB;
constexpr size_t WS_VT = WS_P + 240 * MiB;
constexpr size_t WS_MASK = WS_VT + 64 * MiB;
constexpr size_t WS_IW = WS_MASK + 8 * MiB;
constexpr size_t WS_RSTD = WS_IW + 1 * MiB;
constexpr size_t WS_RE = WS_RSTD + 1 * MiB;
constexpr size_t WS_RG = WS_RE + 16 * MiB;
constexpr size_t WS_PSF = WS_RG + 16 * MiB;
constexpr size_t WS_END = WS_PSF + 2 * MiB;

struct Params {
    const float* x; const int* pos; const float* attn_norm; const float* ffn_norm; const float* final_norm;
    const float* hyb_w_in; const float* hyb_w_out; const float* mla_w_in; const float* mla_q_norm; const float* mla_kv_norm;
    const float* mla_w_uq; const float* mla_w_ukv; const float* mla_w_out; const float* peer_w_q; const float* peer_sub_keys;
    const float* peer_u; const float* peer_v;
    float* out; unsigned char* ws;
    int ph_lo, ph_hi;
};

DI unsigned pk_bf16(float lo, float hi) { f32x2 v = {lo, hi}; bf2_t b = __builtin_convertvector(v, bf2_t); return __builtin_bit_cast(unsigned, b); }
DI bf16_t f2bf(float x) { return (bf16_t)(pk_bf16(x, 0.f) & 0xffffu); }
DI float bf_lo(unsigned u) { return __uint_as_float(u << 16); }
DI float bf_hi(unsigned u) { return __uint_as_float(u & 0xffff0000u); }
DI float wave_sum(float v) {
#pragma unroll
    for (int o = 32; o > 0; o >>= 1) v += __shfl_xor(v, o, 64);
    return v;
}
DI float wave_sum_dpp(float v) {
    int x = __float_as_int(v);
#define WS_STEP(ctrl, rmask) x = __float_as_int(__int_as_float(x) + __int_as_float(__builtin_amdgcn_update_dpp(0, x, ctrl, rmask, 0xf, false)))
    WS_STEP(0x111, 0xf); WS_STEP(0x112, 0xf); WS_STEP(0x114, 0xf); WS_STEP(0x118, 0xf);
    WS_STEP(0x142, 0xa); WS_STEP(0x143, 0xc);
#undef WS_STEP
    return __int_as_float(__builtin_amdgcn_readlane(x, 63));
}
DI f32x16 mfma32(bf16x8 a, bf16x8 b, f32x16 c) { return __builtin_amdgcn_mfma_f32_32x32x16_bf16(a, b, c, 0, 0, 0); }
DI f32x16 zero16() { f32x16 z;
#pragma unroll
    for (int i = 0; i < 16; ++i) z[i] = 0.f; return z; }

#define XB_TMO      128
#define XB_XCNT(j)  (256  + 64 * (j))
#define XB_XSUB(j)  (1280 + 64 * (j))
#define XB_XGEN(j)  (2304 + 64 * (j))
#define XB_TOP      3328
#define XB_TOPGEN   3392
#define XCD_BAR_WORDS 3456
#define XB_SPIN_CAP (1u << 25)

DI unsigned xb_ld(unsigned* p)              { return __hip_atomic_load(p, __ATOMIC_RELAXED, __HIP_MEMORY_SCOPE_AGENT); }
DI unsigned xb_add(unsigned* p, unsigned v) { return __hip_atomic_fetch_add(p, v, __ATOMIC_RELAXED, __HIP_MEMORY_SCOPE_AGENT); }
DI unsigned xb_xcc_id() { return (unsigned)__builtin_amdgcn_s_getreg((3 << 11) | 20) & 0xFu; }
#define XB_SPIN(cond, bar) do { unsigned _sp = 0; while (cond) { __builtin_amdgcn_s_sleep(1); \
    if ((++_sp & 255u) == 0u) { if (xb_ld(&(bar)[XB_TMO])) break; if (_sp > XB_SPIN_CAP) { atomicAdd(&(bar)[XB_TMO], 1u); break; } } } } while (0)

struct XcdBarrier { unsigned* bar; unsigned x; volatile LAS unsigned* st; };

DI XcdBarrier xcd_barrier_post(unsigned* bar, volatile LAS unsigned* st) {
    XcdBarrier b; b.bar = bar; b.x = xb_xcc_id(); b.st = st;
    if (threadIdx.x == 0) (void)xb_add(&bar[XB_XCNT(b.x)], 1u);
    return b;
}
DI void xcd_barrier_complete(unsigned* bar, unsigned x, unsigned& nloc, unsigned& nx) {
    const unsigned G = gridDim.x * gridDim.y * gridDim.z;
    unsigned sum, cnt, mine, sp = 0u;
    for (;;) {
        sum = 0u; cnt = 0u; mine = 0u;
#pragma unroll
        for (unsigned j = 0; j < 16; ++j) { const unsigned c = xb_ld(&bar[XB_XCNT(j)]); sum += c; cnt += (c > 0u) ? 1u : 0u; mine = (j == x) ? c : mine; }
        if (sum == G) break;
        __builtin_amdgcn_s_sleep(1);
        if ((++sp & 255u) == 0u) { if (xb_ld(&bar[XB_TMO])) break; if (sp > XB_SPIN_CAP) { atomicAdd(&bar[XB_TMO], 1u); break; } }
    }
    nloc = mine > 0u ? mine : 1u; nx = cnt > 0u ? cnt : 1u;
}
DI void xcd_barrier(const XcdBarrier& b) {
    asm volatile("s_waitcnt vmcnt(0)" ::: "memory");
    __syncthreads();
    if (threadIdx.x == 0) {
        unsigned* bar = b.bar;
        __builtin_amdgcn_s_waitcnt(0);
        unsigned nloc = b.st[0], nx = b.st[1];
        if (nloc == 0u) { xcd_barrier_complete(bar, b.x, nloc, nx); b.st[0] = nloc; b.st[1] = nx; }
        const unsigned old = xb_add(&bar[XB_XSUB(b.x)], 1u);
        const unsigned gen = old / nloc;
        if (old + 1u == (gen + 1u) * nloc) {
            __builtin_amdgcn_fence(__ATOMIC_RELEASE, "agent");
            asm volatile("s_waitcnt vmcnt(0)" ::: "memory");
            const unsigned og = xb_add(&bar[XB_TOP], 1u);
            const unsigned tg = og / nx;
            if (og + 1u == (tg + 1u) * nx) xb_add(&bar[XB_TOPGEN], 1u);
            else XB_SPIN(xb_ld(&bar[XB_TOPGEN]) == tg, bar);
            __builtin_amdgcn_fence(__ATOMIC_ACQUIRE, "agent");
            xb_add(&bar[XB_XGEN(b.x)], 1u);
            asm volatile("s_waitcnt vmcnt(0)" ::: "memory");
        } else {
            XB_SPIN(xb_ld(&bar[XB_XGEN(b.x)]) == gen, bar);
            __builtin_amdgcn_fence(__ATOMIC_ACQUIRE, "agent");
            asm volatile("s_waitcnt vmcnt(0)" ::: "memory");
        }
    }
    __syncthreads();
}

DI int perm32(int rho) { return 8 * ((rho & 15) >> 2) + 4 * (rho >> 4) + (rho & 3); }
template <int MODE> DI int src_col(int np, int N) {
    if (MODE == 0) return np < N ? np : -1;
    if (MODE == 2) { const int c = (np & ~31) + perm32(np & 31); return c < N ? c : -1; }
    if (MODE == 3) { const int c = (np < 1024) ? (np & ~31) + perm32(np & 31) : np; return c < N ? c : -1; }
    if (MODE == 4) { const int c = (((np >> 5) % 3) == 2) ? np : (np & ~31) + perm32(np & 31); return c < N ? c : -1; }
    if (MODE == 5) { const int c = ((np >> 6) & 1) ? np : (np & ~31) + perm32(np & 31); return c < N ? c : -1; }
    const int tile = np >> 8, loc = np & 255, bj = loc >> 7, wc = (loc >> 5) & 3, n = (loc >> 4) & 1, ip = loc & 15;
    const int nat = tile * 256 + wc * 64 + bj * 32 + 8 * (ip >> 2) + 4 * n + (ip & 3);
    if (nat < 1216) return nat;
    if (nat < 2752) return nat + 8;
    if (nat < 2760) return nat - 2752 + 1216;
    return -1;
}
template <int MODE> DI void prep_wt(const float* W, int K, int N, bf16_t* WT, int Npad, const float* kscale, int& toff, int bid, int nblk, int tid) {
    const int tx = tid & 63, w = __builtin_amdgcn_readfirstlane(tid >> 6);
    const int ntn = Npad / 256, ntk = K / 16, nw = nblk * 8;
    int t = (bid * 8 + w - toff) % nw; if (t < 0) t += nw;
    toff = (toff + ntn * ntk) % nw;
    for (; t < ntn * ntk; t += nw) {
        const int n0 = (t % ntn) * 256 + 4 * tx, k0 = (t / ntn) * 16;
        const int sn = src_col<MODE>(n0, N);
        const float keep = (sn >= 0) ? 1.f : 0.f;
        const float* src = W + (size_t)k0 * N + (sn >= 0 ? sn : 0);
        f32x4 v[16];
#pragma unroll
        for (int kk = 0; kk < 16; ++kk) v[kk] = *(const f32x4*)(src + (size_t)kk * N);
#pragma unroll
        for (int kk = 0; kk < 16; ++kk) v[kk] *= (kscale ? kscale[k0 + kk] : 1.f) * keep;
#pragma unroll
        for (int r = 0; r < 4; ++r) {
            bf16_t* dst = WT + (size_t)(n0 + r) * K + k0;
#pragma unroll
            for (int h = 0; h < 2; ++h) {
                u32x4 o;
#pragma unroll
                for (int q = 0; q < 4; ++q) o[q] = pk_bf16(v[8 * h + 2 * q][r], v[8 * h + 2 * q + 1][r]);
                *(u32x4*)(dst + 8 * h) = o;
            }
        }
    }
}
DI void cvt_bf16(const float* src, bf16_t* dst, size_t n, int bid, int nblk, int tid) {
    const size_t n8 = n / 8;
    for (size_t i = (size_t)bid * NTHR + tid; i < n8; i += (size_t)nblk * NTHR) {
        const f32x4 a = *(const f32x4*)(src + i * 8), b = *(const f32x4*)(src + i * 8 + 4);
        u32x4 o; o[0] = pk_bf16(a[0], a[1]); o[1] = pk_bf16(a[2], a[3]); o[2] = pk_bf16(b[0], b[1]); o[3] = pk_bf16(b[2], b[3]);
        *(u32x4*)(dst + i * 8) = o;
    }
}
DI void cvt_fp8(const float* src, unsigned char* dst, size_t n, float scale, const float* colscale  , int bid, int nblk, int tid) {
    const size_t n16 = n / 16;
    for (size_t i = (size_t)bid * NTHR + tid; i < n16; i += (size_t)nblk * NTHR) {
        u32x4 o;
#pragma unroll
        for (int q = 0; q < 4; ++q) {
            f32x4 a = *(const f32x4*)(src + i * 16 + q * 4) * scale;
            if (colscale) a *= *(const f32x4*)(colscale + (i / ((size_t)NEXP * 64)) * 1024 + (i & 63) * 16 + q * 4);
            int w = 0;
            w = __builtin_amdgcn_cvt_pk_fp8_f32(a[0], a[1], w, false);
            w = __builtin_amdgcn_cvt_pk_fp8_f32(a[2], a[3], w, true);
            o[q] = (unsigned)w;
        }
        const size_t lay = i / ((size_t)NEXP * 64), rem = i % ((size_t)NEXP * 64), e = rem >> 6, ch = rem & 63;
        *(u32x4*)(dst + lay * ((size_t)NEXP * 1024) + (ch >> 3) * ((size_t)NEXP * 128) + e * 128 + (ch & 7) * 16) = o;
    }
}
DI void rope_tables(const int* pos, float* c64, float* s64, float* c32, float* s32, int bid, int nblk, int tid) {
    for (int i = bid * NTHR + tid; i < T_ * 48; i += nblk * NTHR) {
        const int t = i / 48, j = i % 48;
        const float p = (float)pos[t];
        const int k = (j < 32) ? j : j - 32;
        const float inv = exp2f(-(float)(2 * k) * ((j < 32) ? (13.287712379549449f / 64.0f) : (13.287712379549449f / 32.0f)));
        float sv, cv; sincosf(p * inv, &sv, &cv);
        if (j < 32) { c64[t * 32 + k] = cv; s64[t * 32 + k] = sv; } else { c32[t * 16 + k] = cv; s32[t * 16 + k] = sv; }
    }
}

DI void rmsnorm_rows(const float* x, const float* g, bf16_t* outb, float* outf, int bid, int nblk, int tid) {
    const int lane = tid & 63, w = tid >> 6;
    f32x4 gv[4];
#pragma unroll
    for (int i = 0; i < 4; ++i) gv[i] = *(const f32x4*)(g + i * 256 + lane * 4);
    for (int row = bid * 8 + w; row < T_; row += nblk * 8) {
        const float* xr = x + (size_t)row * 1024;
        f32x4 v[4]; float ss = 0.f;
#pragma unroll
        for (int i = 0; i < 4; ++i) { v[i] = *(const f32x4*)(xr + i * 256 + lane * 4); ss += v[i][0] * v[i][0] + v[i][1] * v[i][1] + v[i][2] * v[i][2] + v[i][3] * v[i][3]; }
        ss = wave_sum(ss);
        const float rs = 1.0f / sqrtf(ss * (1.0f / 1024.0f) + 1e-6f);
#pragma unroll
        for (int i = 0; i < 4; ++i) {
            const f32x4 y = v[i] * rs * gv[i];
            if (outb) { u32x2 o; o[0] = pk_bf16(y[0], y[1]); o[1] = pk_bf16(y[2], y[3]); *(u32x2*)(outb + (size_t)row * 1024 + i * 256 + lane * 4) = o; }
            else *(f32x4*)(outf + (size_t)row * 1024 + i * 256 + lane * 4) = y;
        }
    }
}
DI void x_to_stream(const float* x, bf16_t* xb, float* psa, int bid, int nblk, int tid) {
    const int lane = tid & 63, w = tid >> 6;
    for (int row = bid * 8 + w; row < T_; row += nblk * 8) {
        const float* xr = x + (size_t)row * 1024 + lane * 16;
        f32x4 v[4]; float ss = 0.f;
#pragma unroll
        for (int i = 0; i < 4; ++i) { v[i] = *(const f32x4*)(xr + i * 4); ss += (v[i][0] * v[i][0] + v[i][1] * v[i][1]) + (v[i][2] * v[i][2] + v[i][3] * v[i][3]); }
        ss += __shfl_xor(ss, 1, 64); ss += __shfl_xor(ss, 2, 64); ss += __shfl_xor(ss, 4, 64);
        u32x4 o0, o1;
        o0[0] = pk_bf16(v[0][0], v[0][1]); o0[1] = pk_bf16(v[0][2], v[0][3]); o0[2] = pk_bf16(v[1][0], v[1][1]); o0[3] = pk_bf16(v[1][2], v[1][3]);
        o1[0] = pk_bf16(v[2][0], v[2][1]); o1[1] = pk_bf16(v[2][2], v[2][3]); o1[2] = pk_bf16(v[3][0], v[3][1]); o1[3] = pk_bf16(v[3][2], v[3][3]);
        bf16_t* dst = xb + (size_t)row * 1024 + lane * 16;
        *(u32x4*)dst = o0; *(u32x4*)(dst + 8) = o1;
        if ((lane & 7) == 0) psa[(size_t)row * 8 + (lane >> 3)] = ss;
    }
}
DI void final_norm_rows(const bf16_t* xb, const float* g, float* out, int bid, int nblk, int tid) {
    const int lane = tid & 63, w = tid >> 6;
    f32x4 gv[4];
#pragma unroll
    for (int i = 0; i < 4; ++i) gv[i] = *(const f32x4*)(g + lane * 16 + i * 4);
    for (int row = bid * 8 + w; row < T_; row += nblk * 8) {
        const bf16_t* xr = xb + (size_t)row * 1024 + lane * 16;
        const u32x4 a = *(const u32x4*)xr, b = *(const u32x4*)(xr + 8);
        f32x4 v[4];
#pragma unroll
        for (int q = 0; q < 2; ++q) { v[0][2 * q] = bf_lo(a[q]); v[0][2 * q + 1] = bf_hi(a[q]); v[1][2 * q] = bf_lo(a[2 + q]); v[1][2 * q + 1] = bf_hi(a[2 + q]);
                                      v[2][2 * q] = bf_lo(b[q]); v[2][2 * q + 1] = bf_hi(b[q]); v[3][2 * q] = bf_lo(b[2 + q]); v[3][2 * q + 1] = bf_hi(b[2 + q]); }
        float ss = 0.f;
#pragma unroll
        for (int i = 0; i < 4; ++i) ss += (v[i][0] * v[i][0] + v[i][1] * v[i][1]) + (v[i][2] * v[i][2] + v[i][3] * v[i][3]);
        ss = wave_sum(ss);
        const float rs = 1.0f / sqrtf(ss * (1.0f / 1024.0f) + 1e-6f);
#pragma unroll
        for (int i = 0; i < 4; ++i) *(f32x4*)(out + (size_t)row * 1024 + lane * 16 + i * 4) = v[i] * rs * gv[i];
    }
}
DI void mla_stats(const bf16_t* cin, float* rstd, int bid, int nblk, int tid) {
    const int lane = tid & 63, w = tid >> 6;
    for (int row = bid * 8 + w; row < T_; row += nblk * 8) {
        const bf16_t* r = cin + (size_t)row * NM_IN;
        const u32x4 a = *(const u32x4*)(r + lane * 8), b = *(const u32x4*)(r + 512 + lane * 8);
        float sa = 0.f, sb = 0.f;
#pragma unroll
        for (int i = 0; i < 4; ++i) { float lo = bf_lo(a[i]), hi = bf_hi(a[i]); sa += lo * lo + hi * hi; lo = bf_lo(b[i]); hi = bf_hi(b[i]); sb += lo * lo + hi * hi; }
        float sq = sa + (lane < 32 ? sb : 0.f), skv = (lane < 32 ? 0.f : sb);
        sq = wave_sum(sq); skv = wave_sum(skv);
        if (lane == 0) { rstd[row * 2] = 1.0f / sqrtf(sq * (1.0f / 768.0f) + 1e-6f); rstd[row * 2 + 1] = 1.0f / sqrtf(skv * (1.0f / 256.0f) + 1e-6f); }
    }
}

DI void gm_st_bf4(bf16_t* p, f32x4 v) { u32x2 o; o[0] = pk_bf16(v[0], v[1]); o[1] = pk_bf16(v[2], v[3]); *(u32x2*)p = o; }
DI void mla_krope_units(const bf16_t* xb, const bf16_t* wkr  , const float* psa, const float* c32, const float* s32, bf16_t* cin, int bid, int nblk, int tid) {
    const int w = __builtin_amdgcn_readfirstlane(tid >> 6), lane = tid & 63, r = lane & 31, hf = lane >> 5;
    for (int u = bid + w * nblk; u < T_ / 32; u += 8 * nblk) {
        const int t = u * 32 + r;
        const bf16_t* xp = xb + (size_t)t * 1024 + hf * 8;
        const bf16_t* wp = wkr + (size_t)r * 1024 + hf * 8;
        f32x16 acc = zero16(), acc2 = zero16();
#pragma unroll 1
        for (int k8 = 0; k8 < 8; ++k8) {
            bf16x8 xa[8], wa[8];
#pragma unroll
            for (int ks = 0; ks < 8; ++ks) { xa[ks] = *(const bf16x8*)(xp + (k8 * 8 + ks) * 16); wa[ks] = *(const bf16x8*)(wp + (k8 * 8 + ks) * 16); }
#pragma unroll
            for (int ks = 0; ks < 8; ++ks) { if (ks & 1) acc2 = mfma32(wa[ks], xa[ks], acc2); else acc = mfma32(wa[ks], xa[ks], acc); }
        }
        const f32x4 p0 = *(const f32x4*)(psa + (size_t)t * 8), p1 = *(const f32x4*)(psa + (size_t)t * 8 + 4);
        const float rs = 1.0f / sqrtf((((p0[0] + p0[1]) + (p0[2] + p0[3])) + ((p1[0] + p1[1]) + (p1[2] + p1[3]))) * (1.0f / 1024.0f) + 1e-6f);
#pragma unroll
        for (int q = 0; q < 2; ++q) {
            const int c0 = 8 * q + 4 * hf;
            const f32x4 cs = *(const f32x4*)(c32 + (size_t)t * 16 + c0), sn = *(const f32x4*)(s32 + (size_t)t * 16 + c0);
            f32x4 a, b;
#pragma unroll
            for (int jj = 0; jj < 4; ++jj) { a[jj] = (acc[4 * q + jj] + acc2[4 * q + jj]) * rs; b[jj] = (acc[8 + 4 * q + jj] + acc2[8 + 4 * q + jj]) * rs; }
            bf16_t* dst = cin + (size_t)t * NM_IN + 1024 + c0;
            gm_st_bf4(dst, a * cs - b * sn); gm_st_bf4(dst + 16, a * sn + b * cs);
        }
    }
}

namespace gm {
constexpr int BM = 256, BK = 64, HALF = 128, NXCD = 8, WGM = 8, HT = HALF * BK;
DI int lds_byte(int r, int c) { int st = (r >> 4) * 2 + (c >> 5), rr = r & 15, cc = c & 31, ob = rr * 64 + cc * 2; return st * 1024 + (ob ^ (((ob >> 9) & 1) << 5)); }
DI void stage_rc(int b, int& R, int& C) { int st = b / 1024, sb = b % 1024, swz = sb ^ (((sb >> 9) & 1) << 5); R = (st >> 1) * 16 + swz / 64; C = (st & 1) * 32 + (swz % 64) / 2; }

template <class Epi>
DI void gemm_phase(const bf16_t* A, int lda, const bf16_t* Bt, int M, int N, int K, const Epi& epi, unsigned char* ldsraw, int bid, int nblk) {
    bf16_t* shm = (bf16_t*)ldsraw;
#define SA(b, h) (shm + ((b) * 2 + (h)) * HT)
#define SB(b, h) (shm + (4 + (b) * 2 + (h)) * HT)
#define STAGE_X(T, P, BASE, LD, br, kt) do { long _g = (long)(br) * (LD) + (long)(kt) * BK; \
    for (int _i = 0; _i < 2; ++_i) { int _b = (T) * 16 + _i * 8192; int _r, _c; stage_rc(_b, _r, _c); \
      __builtin_amdgcn_global_load_lds((const unsigned*)((BASE) + _g + (long)_r * (LD) + _c), \
        (unsigned*)((char*)(P) + _b), 16, 0, 0); } } while (0)
#define STAGE_A(P, br, kt) STAGE_X(tv, P, A, lda, br, kt)
#define STAGE_B(P, br, kt) STAGE_X(tv, P, Bt, K, br, kt)
#define LDA(dst, b, h) for (int m = 0; m < 4; ++m) for (int k = 0; k < 2; ++k) \
    dst[m][k] = *reinterpret_cast<const bf16x8*>((char*)SA(b, h) + lds_byte(wr * 64 + m * 16 + fr, k * 32 + fq * 8))
#define LDB(dst, b, h) for (int n = 0; n < 2; ++n) for (int k = 0; k < 2; ++k) \
    dst[n][k] = *reinterpret_cast<const bf16x8*>((char*)SB(b, h) + lds_byte(wc * 32 + n * 16 + fr, k * 32 + fq * 8))
#define MMA(ai, bj, At_, Bt_) do { __builtin_amdgcn_s_setprio(1); \
    for (int m = 0; m < 4; ++m) for (int n = 0; n < 2; ++n) for (int k = 0; k < 2; ++k) \
      acc[ai][bj][m][n] = __builtin_amdgcn_mfma_f32_16x16x32_bf16(Bt_[n][k], At_[m][k], acc[ai][bj][m][n], 0, 0, 0); \
    __builtin_amdgcn_s_setprio(0); } while (0)
#define WAIT_V(n) asm volatile("s_waitcnt vmcnt(" #n ")" ::: "memory")
#define WAIT_L(n) asm volatile("s_waitcnt lgkmcnt(" #n ")" ::: "memory")
#define BAR __builtin_amdgcn_s_barrier()
#define SCHED __builtin_amdgcn_sched_barrier(0)
    const int nM = M / BM, nN = N / BM, nwg = nM * nN, nt = K / BK;
    for (int it = 0;; ++it) {
        const long L = (long)it * nblk + bid;
        if (L >= nwg) break;
        int wgid = (int)L;
        { int q = nwg / NXCD, r = nwg % NXCD, xcd = wgid % NXCD, off = wgid / NXCD; wgid = (xcd < r ? xcd * (q + 1) : r * (q + 1) + (xcd - r) * q) + off; }
        const int nig = WGM * nN, gid = wgid / nig, fm = gid * WGM, gsz = min(nM - fm, WGM);
        const int pm = fm + ((wgid % nig) % gsz), pn = (wgid % nig) / gsz, brow = pm * BM, bcol = pn * BM;
        int tv = threadIdx.x; asm volatile("" : "+v"(tv));
        int wid = tv >> 6, lane = tv & 63, wr = wid >> 2, wc = wid & 3, fr = lane & 15, fq = lane >> 4;
        f32x4 acc[2][2][4][2] = {};
        bf16x8 At[4][2], B0[2][2], B1[2][2];
        f32x4 q0 = {0.f, 0.f, 0.f, 0.f}, q1 = {0.f, 0.f, 0.f, 0.f};
        if (epi.psa && tv < 256) {
            const float* pp = epi.psa + ((size_t)brow + tv) * Epi::PS_STRIDE + Epi::PS_FIRST;
            q0 = *(const f32x4*)pp;
            if (Epi::PS_COUNT >= 8) q1 = *(const f32x4*)(pp + 4);
            if (Epi::PS_COUNT >= 12) q0 += *(const f32x4*)(pp + 8);
            if (Epi::PS_COUNT >= 16) q1 += *(const f32x4*)(pp + 12);
        }
        STAGE_B(SB(0, 0), bcol, 0); STAGE_A(SA(0, 0), brow, 0);
        STAGE_B(SB(0, 1), bcol + HALF, 0); STAGE_A(SA(0, 1), brow + HALF, 0);
        if (wr == 1) BAR;
        WAIT_V(4); BAR;
        STAGE_B(SB(1, 0), bcol, 1); STAGE_A(SA(1, 0), brow, 1); STAGE_B(SB(1, 1), bcol + HALF, 1);
        WAIT_V(6); BAR;
        if (epi.psa && tv < 256)
            *(LAS float*)((LAS unsigned char*)ldsraw + 131072 + (it & 1) * 1024 + tv * 4) = 1.0f / sqrtf((((q0[0] + q0[1]) + (q0[2] + q0[3])) + ((q1[0] + q1[1]) + (q1[2] + q1[3]))) * (1.0f / (float)Epi::PS_DIV) + 1e-6f);
        for (int t = 0; t < nt - 2; t += 2) {
            LDB(B0, 0, 0); SCHED; LDA(At, 0, 0); STAGE_A(SA(1, 1), brow + HALF, t + 1);
            WAIT_L(8); BAR; WAIT_L(0); MMA(0, 0, At, B0); BAR; SCHED;
            LDB(B1, 0, 1); STAGE_B(SB(0, 0), bcol, t + 2);
            BAR; WAIT_L(0); MMA(0, 1, At, B1); BAR;
            LDA(At, 0, 1); STAGE_A(SA(0, 0), brow, t + 2);
            BAR; WAIT_L(0); MMA(1, 0, At, B0); BAR; SCHED;
            STAGE_B(SB(0, 1), bcol + HALF, t + 2);
            WAIT_V(6); BAR; MMA(1, 1, At, B1); BAR;
            LDB(B0, 1, 0); SCHED; LDA(At, 1, 0); STAGE_A(SA(0, 1), brow + HALF, t + 2);
            WAIT_L(8); BAR; WAIT_L(0); MMA(0, 0, At, B0); BAR; SCHED;
            LDB(B1, 1, 1); STAGE_B(SB(1, 0), bcol, t + 3);
            BAR; WAIT_L(0); MMA(0, 1, At, B1); BAR;
            LDA(At, 1, 1); STAGE_A(SA(1, 0), brow, t + 3);
            BAR; WAIT_L(0); MMA(1, 0, At, B0); BAR; SCHED;
            STAGE_B(SB(1, 1), bcol + HALF, t + 3);
            WAIT_V(6); BAR; MMA(1, 1, At, B1); BAR;
        }
        int tz = threadIdx.x; asm volatile("" : "+v"(tz)); wid = tz >> 6; lane = tz & 63; wr = wid >> 2; wc = wid & 3; fr = lane & 15; fq = lane >> 4;
        { LDB(B0, 0, 0); WAIT_V(0); LDA(At, 0, 0); STAGE_X(tz, SA(1, 1), A, lda, brow + HALF, nt - 1);
          BAR; WAIT_L(0); MMA(0, 0, At, B0); BAR;
          LDB(B1, 0, 1); BAR; WAIT_L(0); MMA(0, 1, At, B1); BAR;
          LDA(At, 0, 1); WAIT_V(4); BAR; WAIT_L(0); MMA(1, 0, At, B0); MMA(1, 1, At, B1); BAR; }
        { LDB(B0, 1, 0); LDA(At, 1, 0); WAIT_V(2); BAR; WAIT_L(0); MMA(0, 0, At, B0); BAR;
          LDB(B1, 1, 1); WAIT_V(0); BAR; WAIT_L(0); MMA(0, 1, At, B1); BAR;
          LDA(At, 1, 1); BAR; WAIT_L(0); MMA(1, 0, At, B0); MMA(1, 1, At, B1); BAR; }
        if (wr == 0) BAR;
        { int ty = threadIdx.x; asm volatile("" : "+v"(ty)); const int wid2 = ty >> 6, lane2 = ty & 63;
          if (epi.psa) {
#pragma unroll
              for (int ai = 0; ai < 2; ++ai)
#pragma unroll
                  for (int m = 0; m < 4; ++m) {
                      const float rs = *(const LAS float*)((LAS unsigned char*)ldsraw + 131072 + (it & 1) * 1024 + (ai * 128 + (wid2 >> 2) * 64 + m * 16 + (lane2 & 15)) * 4);
#pragma unroll
                      for (int bj = 0; bj < 2; ++bj)
#pragma unroll
                          for (int n = 0; n < 2; ++n) acc[ai][bj][m][n] *= rs;
                  }
          }
          epi(acc, pm, pn, wid2 >> 2, wid2 & 3, lane2 & 15, lane2 >> 4); }
    }
#undef SA
#undef SB
#undef STAGE_X
#undef STAGE_A
#undef STAGE_B
#undef LDA
#undef LDB
#undef MMA
#undef WAIT_V
#undef WAIT_L
#undef BAR
#undef SCHED
}

DI void st_bf4(bf16_t* p, f32x4 v) { u32x2 o; o[0] = pk_bf16(v[0], v[1]); o[1] = pk_bf16(v[2], v[3]); *(u32x2*)p = o; }
DI void st_bf8(bf16_t* p, f32x4 a, f32x4 b) { u32x4 o; o[0] = pk_bf16(a[0], a[1]); o[1] = pk_bf16(a[2], a[3]); o[2] = pk_bf16(b[0], b[1]); o[3] = pk_bf16(b[2], b[3]); *(u32x4*)p = o; }

struct EpiEvenIn {
    static constexpr int PS_STRIDE = 8, PS_FIRST = 0, PS_COUNT = 8, PS_DIV = 1024;
    bf16_t* proj; bf16_t* vaT; bf16_t* vbT; float* iw; const float* c64; const float* s64; const float* psa;
    DI void operator()(const f32x4 (&acc)[2][2][4][2], int pm, int pn, int wr, int wc, int fr, int fq) const {
        const float qscale = 0.125f * LOG2E;
        const int g = pn * 4 + wc, d0 = 8 * fq;
        const int kind = (g < 8 || (g >= 19 && g < 27)) ? 0 : (g == 9) ? 2 : (g >= 35 && g < 43) ? 3 : (g == 43) ? 4 : (g > 43) ? 5 : 1;
#pragma unroll
        for (int ai = 0; ai < 2; ++ai)
#pragma unroll
            for (int m = 0; m < 4; ++m) {
                const int t = pm * 256 + ai * 128 + wr * 64 + m * 16 + fr;
                if (kind <= 1) {
                    f32x4 y0[2], y1[2];
#pragma unroll
                    for (int n = 0; n < 2; ++n) {
                        const f32x4 c = *(const f32x4*)(c64 + (size_t)t * 32 + d0 + 4 * n), sn = *(const f32x4*)(s64 + (size_t)t * 32 + d0 + 4 * n);
                        const f32x4 v0 = acc[ai][0][m][n], v1 = acc[ai][1][m][n];
                        y0[n] = v0 * c - v1 * sn; y1[n] = v0 * sn + v1 * c;
                        if (kind == 0) { y0[n] *= qscale; y1[n] *= qscale; }
                    }
                    bf16_t* dst = proj + (size_t)t * NE_IN + g * 64 + d0;
                    st_bf8(dst, y0[0], y0[1]); st_bf8(dst + 32, y1[0], y1[1]);
                } else if (kind == 2 || kind == 3) {
                    bf16_t* dst = proj + (size_t)t * NE_IN + g * 64 + d0;
                    st_bf8(dst, acc[ai][0][m][0], acc[ai][0][m][1]); st_bf8(dst + 32, acc[ai][1][m][0], acc[ai][1][m][1]);
                } else if (kind == 4) {
                    if (fq == 0) { *(f32x4*)(iw + (size_t)t * 8) = acc[ai][0][m][0]; *(f32x4*)(iw + (size_t)t * 8 + 4) = acc[ai][0][m][1]; }
                }
            }
    }
};
struct EpiMlaIn {
    static constexpr int PS_STRIDE = 8, PS_FIRST = 0, PS_COUNT = 8, PS_DIV = 1024;
    bf16_t* cin; const float* c32; const float* s32; float* ps; const float* psa;
    DI void operator()(const f32x4 (&acc)[2][2][4][2], int pm, int pn, int wr, int wc, int fr, int fq) const {
        if (pn < 4) {
#pragma unroll
            for (int ai = 0; ai < 2; ++ai)
#pragma unroll
                for (int m = 0; m < 4; ++m) {
                    float ss = 0.f;
#pragma unroll
                    for (int bj = 0; bj < 2; ++bj)
#pragma unroll
                        for (int n = 0; n < 2; ++n) { const f32x4 a = acc[ai][bj][m][n]; ss += a[0] * a[0] + a[1] * a[1] + a[2] * a[2] + a[3] * a[3]; }
                    ss += __shfl_xor(ss, 16, 64); ss += __shfl_xor(ss, 32, 64);
                    const int t = pm * 256 + ai * 128 + wr * 64 + m * 16 + fr;
                    if (fq == 0) ps[(size_t)t * 16 + pn * 4 + wc] = ss;
                }
        }
#pragma unroll
        for (int bj = 0; bj < 2; ++bj) {
            const int colbase = pn * 256 + bj * 128 + wc * 32;
            if (colbase > 1024) continue;
#pragma unroll
            for (int ai = 0; ai < 2; ++ai)
#pragma unroll
                for (int m = 0; m < 4; ++m) {
                    const int t = pm * 256 + ai * 128 + wr * 64 + m * 16 + fr;
                    if (colbase == 1024) {
                        const f32x4 c = *(const f32x4*)(c32 + (size_t)t * 16 + 4 * fq), sn = *(const f32x4*)(s32 + (size_t)t * 16 + 4 * fq);
                        const f32x4 a = acc[ai][bj][m][0], b = acc[ai][bj][m][1];
                        bf16_t* dst = cin + (size_t)t * NM_IN + colbase + 4 * fq;
                        st_bf4(dst, a * c - b * sn); st_bf4(dst + 16, a * sn + b * c);
                    } else st_bf8(cin + (size_t)t * NM_IN + colbase + 8 * fq, acc[ai][bj][m][0], acc[ai][bj][m][1]);
                }
        }
    }
};
struct EpiQup {
    static constexpr int PS_STRIDE = 16, PS_FIRST = 0, PS_COUNT = 12, PS_DIV = 768;
    bf16_t* qm; const float* rstd; const float* c32; const float* s32; const float* psa;
    DI void operator()(const f32x4 (&acc)[2][2][4][2], int pm, int pn, int wr, int wc, int fr, int fq) const {
        const float qscale = 0.10206207261596575f * LOG2E;
#pragma unroll
        for (int bj = 0; bj < 2; ++bj) {
            const int colbase = pn * 256 + bj * 128 + wc * 32;
            const bool rope = ((colbase >> 5) % 3) == 2;
#pragma unroll
            for (int ai = 0; ai < 2; ++ai)
#pragma unroll
                for (int m = 0; m < 4; ++m) {
                    const int t = pm * 256 + ai * 128 + wr * 64 + m * 16 + fr;
                    const float rs = qscale;
                    const f32x4 a = acc[ai][bj][m][0] * rs, b = acc[ai][bj][m][1] * rs;
                    if (rope) {
                        const f32x4 c = *(const f32x4*)(c32 + (size_t)t * 16 + 4 * fq), sn = *(const f32x4*)(s32 + (size_t)t * 16 + 4 * fq);
                        bf16_t* dst = qm + (size_t)t * 1536 + colbase + 4 * fq;
                        st_bf4(dst, a * c - b * sn); st_bf4(dst + 16, a * sn + b * c);
                    } else st_bf8(qm + (size_t)t * 1536 + colbase + 8 * fq, a, b);
                }
        }
    }
};
struct EpiKVup {
    static constexpr int PS_STRIDE = 16, PS_FIRST = 12, PS_COUNT = 4, PS_DIV = 256;
    bf16_t* kn; bf16_t* vn; const float* rstd; const float* psa;
    DI void operator()(const f32x4 (&acc)[2][2][4][2], int pm, int pn, int wr, int wc, int fr, int fq) const {
#pragma unroll
        for (int bj = 0; bj < 2; ++bj) {
            const int colbase = pn * 256 + bj * 128 + wc * 32;
            const int g = colbase >> 6, h = g >> 1, within = colbase & 63;
            const long dv = vn - kn;
            bf16_t* const dstb = kn + ((g & 1) ? dv : 0L) + h * 64 + within + 8 * fq;
#pragma unroll
            for (int ai = 0; ai < 2; ++ai)
#pragma unroll
                for (int m = 0; m < 4; ++m) {
                    const int t = pm * 256 + ai * 128 + wr * 64 + m * 16 + fr;
                    st_bf8(dstb + (size_t)t * 1024, acc[ai][bj][m][0], acc[ai][bj][m][1]);
                }
        }
    }
};
struct EpiResid {
    static constexpr int PS_STRIDE = 8, PS_FIRST = 0, PS_COUNT = 8, PS_DIV = 1024;
    bf16_t* xb; float* ps; const float* psa;
    DI void operator()(const f32x4 (&acc)[2][2][4][2], int pm, int pn, int wr, int wc, int fr, int fq) const {
#pragma unroll
        for (int ai = 0; ai < 2; ++ai)
#pragma unroll
            for (int m = 0; m < 4; ++m) {
                const size_t t = pm * 256 + ai * 128 + wr * 64 + m * 16 + fr;
                float ss = 0.f;
#pragma unroll
                for (int bj = 0; bj < 2; ++bj) {
                    bf16_t* px = xb + t * 1024 + pn * 256 + bj * 128 + wc * 32 + 8 * fq;
                    const u32x4 xo = *(const u32x4*)px;
                    const f32x4 a0 = acc[ai][bj][m][0], a1 = acc[ai][bj][m][1];
                    const f32x4 y0 = {bf_lo(xo[0]) + a0[0], bf_hi(xo[0]) + a0[1], bf_lo(xo[1]) + a0[2], bf_hi(xo[1]) + a0[3]};
                    const f32x4 y1 = {bf_lo(xo[2]) + a1[0], bf_hi(xo[2]) + a1[1], bf_lo(xo[3]) + a1[2], bf_hi(xo[3]) + a1[3]};
                    st_bf8(px, y0, y1);
                    ss += (y0[0] * y0[0] + y0[1] * y0[1]) + (y0[2] * y0[2] + y0[3] * y0[3]) + (y1[0] * y1[0] + y1[1] * y1[1]) + (y1[2] * y1[2] + y1[3] * y1[3]);
                }
                ss += __shfl_xor(ss, 16, 64); ss += __shfl_xor(ss, 32, 64);
                if (fq == 0) ps[t * 16 + pn * 4 + wc] = ss;
            }
    }
};
struct EpiBf16 {
    static constexpr int PS_STRIDE = 16, PS_FIRST = 0, PS_COUNT = 16, PS_DIV = 1024;
    bf16_t* out; int ld; const float* psa;
    DI void operator()(const f32x4 (&acc)[2][2][4][2], int pm, int pn, int wr, int wc, int fr, int fq) const {
#pragma unroll
        for (int ai = 0; ai < 2; ++ai)
#pragma unroll
            for (int m = 0; m < 4; ++m) {
                const size_t t = pm * 256 + ai * 128 + wr * 64 + m * 16 + fr;
#pragma unroll
                for (int bj = 0; bj < 2; ++bj) st_bf8(out + t * ld + pn * 256 + bj * 128 + wc * 32 + 8 * fq, acc[ai][bj][m][0], acc[ai][bj][m][1]);
            }
    }
};
}

namespace at {
constexpr int KT = 128, VROW = KT * 2 + 16;
template <int MODE> struct Cfg { static constexpr int DQK = (MODE == 0) ? 96 : 64, NKS = DQK / 16, KROW = DQK * 2 + 16, NCH = DQK / 8, NKL = KT * NCH / 512, KBYTES = KT * KROW, BUFSZ = KBYTES + 64 * VROW; };
struct Args { const bf16_t* q; const bf16_t* k; const bf16_t* k2; const bf16_t* vT; const unsigned* mask; bf16_t* o; };

template <int MODE>
DI void attn_unit(const Args& a, int b, int h, int qt, unsigned char* lds, int tid) {
    constexpr int DQK = Cfg<MODE>::DQK, NKS = Cfg<MODE>::NKS, KROW = Cfg<MODE>::KROW, NCH = Cfg<MODE>::NCH, NKL = Cfg<MODE>::NKL, KBYTES = Cfg<MODE>::KBYTES, BUFSZ = Cfg<MODE>::BUFSZ;
    const int w = __builtin_amdgcn_readfirstlane(tid >> 6), lane = tid & 63, r = lane & 31, hf = lane >> 5;
    int tq, qpos, wmin, wlast, nt;
    const bf16_t* qptr; bf16_t* optr;
    if (MODE == 2) {
        const int qloc = w * 4 + (r >> 3), head = r & 7;
        qpos = qt * 32 + qloc; tq = b * S_ + qpos; wmin = qt * 32 + w * 4; wlast = (qt * 32 + w * 4 + 3) >> 7; nt = ((qt * 32 + 31) >> 7) + 1;
        qptr = a.q + (size_t)tq * NE_IN + C_QA + head * 64; optr = a.o + (size_t)tq * 1024 + head * 64;
    } else {
        qpos = qt * 256 + w * 32 + r; tq = b * S_ + qpos; wmin = qt * 256 + w * 32; wlast = 2 * qt + (w >> 2); nt = 2 * (qt + 1);
        if (MODE == 0) { qptr = a.q + (size_t)tq * 1536 + h * 96; optr = a.o + (size_t)tq * 1024 + h * 64; }
        else { qptr = a.q + (size_t)tq * NE_IN + C_QB + h * 64; optr = a.o + (size_t)tq * 1024 + 512 + h * 64; }
    }
    bf16x8 qf[NKS];
#pragma unroll
    for (int ks = 0; ks < NKS; ++ks) qf[ks] = *(const bf16x8*)(qptr + ks * 16 + hf * 8);

    const bf16_t* kp[NKL]; size_t kstep[NKL]; int kdst[NKL];
#pragma unroll
    for (int j = 0; j < NKL; ++j) {
        const int idx = tid + 512 * j, kr = idx / NCH, kc = idx % NCH;
        kdst[j] = kr * KROW + kc * 16;
        if (MODE == 0) {
            if (kc < 8) { kp[j] = a.k + (size_t)(b * S_ + kr) * 1024 + h * 64 + kc * 8; kstep[j] = (size_t)KT * 1024; }
            else { kp[j] = a.k2 + (size_t)(b * S_ + kr) * NM_IN + 1024 + (kc - 8) * 8; kstep[j] = (size_t)KT * NM_IN; }
        } else { kp[j] = a.k + (size_t)(b * S_ + kr) * NE_IN + (MODE == 1 ? C_KB + h * 64 : C_KA) + kc * 8; kstep[j] = (size_t)KT * NE_IN; }
    }
    const bf16_t* vp[2]; int vdst[2];
#pragma unroll
    for (int j = 0; j < 2; ++j) {
        const int idx = tid + 512 * j, vd = idx >> 4, vc = idx & 15;
        vp[j] = a.vT + ((size_t)((MODE == 0) ? (b * 16 + h) : (MODE == 1) ? (b * 8 + h) : b) * 64 + vd) * S_ + vc * 8;
        vdst[j] = KBYTES + vd * VROW + (vc >> 1) * 32 + (vc & 1) * 8;
    }
    const unsigned* mp = (MODE == 2) ? a.mask + (size_t)tq * 64 : nullptr;

    unsigned blkmask = 0xffu;
    if (MODE == 1) {
        const int own = qt;
        float* kmw = (float*)(lds + 2 * BUFSZ); float* km = kmw + 7 * 8 * 64;
        {
            const int kc = lane & 7, kg = tid >> 3;
            const bf16_t* kb = a.k + (size_t)(b * S_ + kg * 4) * NE_IN + C_KB + h * 64 + kc * 8;
            u32x4 kv[7][4];
#pragma unroll
            for (int n = 0; n < 7; ++n) if (n < own) {
#pragma unroll
                for (int kk = 0; kk < 4; ++kk) kv[n][kk] = *(const u32x4*)(kb + (size_t)(n * 256 + kk) * NE_IN);
            }
#pragma unroll
            for (int n = 0; n < 7; ++n) if (n < own) {
                float sa[8];
#pragma unroll
                for (int e = 0; e < 8; ++e) sa[e] = 0.f;
#pragma unroll
                for (int kk = 0; kk < 4; ++kk)
#pragma unroll
                    for (int q = 0; q < 4; ++q) { sa[2 * q] += bf_lo(kv[n][kk][q]); sa[2 * q + 1] += bf_hi(kv[n][kk][q]); }
#pragma unroll
                for (int e = 0; e < 8; ++e) { sa[e] += __shfl_xor(sa[e], 8, 64); sa[e] += __shfl_xor(sa[e], 16, 64); sa[e] += __shfl_xor(sa[e], 32, 64); }
                if (lane < 8) { float* dst = kmw + (n * 8 + w) * 64 + kc * 8; *(f32x4*)dst = (f32x4){sa[0], sa[1], sa[2], sa[3]}; *(f32x4*)(dst + 4) = (f32x4){sa[4], sa[5], sa[6], sa[7]}; }
            }
        }
        __syncthreads();
        if (tid < own * 64) { const int n = tid >> 6, d = tid & 63; float sacc = 0.f;
#pragma unroll
            for (int ww = 0; ww < 8; ++ww) sacc += kmw[(n * 8 + ww) * 64 + d];
            km[n * 64 + d] = sacc * (1.0f / 256.0f); }
        __syncthreads();
        float gt[7];
#pragma unroll
        for (int n = 0; n < 7; ++n) {
            float g = 0.f;
            if (n < own) {
#pragma unroll
                for (int ks = 0; ks < NKS; ++ks)
#pragma unroll
                    for (int j = 0; j < 8; ++j) g += __uint_as_float((unsigned)(unsigned short)qf[ks][j] << 16) * km[n * 64 + ks * 16 + hf * 8 + j];
                g += __shfl_xor(g, 32, 64);
            }
            gt[n] = g;
        }
        blkmask = 1u << own;
#pragma unroll
        for (int n = 0; n < 7; ++n) {
            int rank = 0;
#pragma unroll
            for (int n2 = 0; n2 < 7; ++n2) if (n2 != n) rank += (n2 < own && (gt[n2] > gt[n] || (gt[n2] == gt[n] && n2 < n))) ? 1 : 0;
            if (n < own && rank < 3) blkmask |= 1u << n;
        }
    }

    u32x4 kreg[NKL], vreg[2]; u32x4 mw = {0u, 0u, 0u, 0u}, mwn = {0u, 0u, 0u, 0u};
#pragma unroll
    for (int j = 0; j < NKL; ++j) kreg[j] = *(const u32x4*)kp[j];
#pragma unroll
    for (int j = 0; j < 2; ++j) vreg[j] = *(const u32x4*)vp[j];
    if (MODE == 2) mw = *(const u32x4*)mp;
#pragma unroll
    for (int j = 0; j < NKL; ++j) *(u32x4*)(lds + kdst[j]) = kreg[j];
#pragma unroll
    for (int j = 0; j < 2; ++j) { *(u32x2*)(lds + vdst[j]) = (u32x2){vreg[j][0], vreg[j][1]}; *(u32x2*)(lds + vdst[j] + 16) = (u32x2){vreg[j][2], vreg[j][3]}; }
    __syncthreads();

    float m = NEG_INF, lsum = 0.f;
    f32x16 o0 = zero16(), o1 = zero16();
    if (w >= 4) __builtin_amdgcn_s_setprio(1);
    for (int i = 0; i < nt; ++i) {
        const bool more = (i + 1 < nt);
        if (more) {
#pragma unroll
            for (int j = 0; j < NKL; ++j) { kp[j] += kstep[j]; kreg[j] = *(const u32x4*)kp[j]; }
#pragma unroll
            for (int j = 0; j < 2; ++j) { vp[j] += KT; vreg[j] = *(const u32x4*)vp[j]; }
            if (MODE == 2) mwn = *(const u32x4*)(mp + 4 * (i + 1));
        }
        const unsigned char* Kb = lds + (i & 1) * BUFSZ; const unsigned char* Vb = Kb + KBYTES;
        bool active = (i <= wlast);
        if (MODE == 1) active = active && (__ballot((blkmask >> (i >> 1)) & 1u) != 0ull);
        if (active) {
            f32x16 s[4];
#pragma unroll
            for (int mt = 0; mt < 4; ++mt) {
                s[mt] = zero16();
#pragma unroll
                for (int ks = 0; ks < NKS; ++ks) s[mt] = mfma32(*(const bf16x8*)(Kb + (mt * 32 + r) * KROW + ks * 32 + hf * 16), qf[ks], s[mt]);
            }
            if (MODE == 2) {
#pragma unroll
                for (int mt = 0; mt < 4; ++mt) { const unsigned wd = mw[mt] >> (4 * hf);
#pragma unroll
                    for (int e = 0; e < 16; ++e) { const int bit = (e & 3) + 8 * (e >> 2); s[mt][e] = ((wd >> bit) & 1u) ? s[mt][e] : NEG_INF; } }
            } else {
                if (MODE == 1) { const bool allowed = (blkmask >> (i >> 1)) & 1u;
                    if (!allowed) {
#pragma unroll
                        for (int mt = 0; mt < 4; ++mt)
#pragma unroll
                            for (int e = 0; e < 16; ++e) s[mt][e] = NEG_INF; } }
                if (i * KT + KT - 1 > wmin) {
#pragma unroll
                    for (int mt = 0; mt < 4; ++mt) { const int kb0 = i * KT + mt * 32 + 4 * hf;
#pragma unroll
                        for (int e = 0; e < 16; ++e) { const int key = kb0 + (e & 3) + 8 * (e >> 2); s[mt][e] = (key <= qpos) ? s[mt][e] : NEG_INF; } }
                }
            }
            float mx4[4];
#pragma unroll
            for (int mt = 0; mt < 4; ++mt) { mx4[mt] = s[mt][0];
#pragma unroll
                for (int e = 1; e < 16; ++e) mx4[mt] = fmaxf(mx4[mt], s[mt][e]); }
            float mx = fmaxf(fmaxf(mx4[0], mx4[1]), fmaxf(mx4[2], mx4[3]));
            mx = fmaxf(mx, __shfl_xor(mx, 32, 64));
            const float mnew = fmaxf(m, mx), muse = (mnew == NEG_INF) ? 0.f : mnew;
            const float alpha = __builtin_amdgcn_exp2f(m - muse);
            float rs4[4];
#pragma unroll
            for (int mt = 0; mt < 4; ++mt) { rs4[mt] = 0.f;
#pragma unroll
                for (int e = 0; e < 16; ++e) { s[mt][e] = __builtin_amdgcn_exp2f(s[mt][e] - muse); rs4[mt] += s[mt][e]; } }
            lsum = lsum * alpha + ((rs4[0] + rs4[1]) + (rs4[2] + rs4[3])); m = mnew;
#pragma unroll
            for (int e = 0; e < 16; ++e) { o0[e] *= alpha; o1[e] *= alpha; }
#pragma unroll
            for (int mt = 0; mt < 4; ++mt)
#pragma unroll
                for (int sp = 0; sp < 2; ++sp) {
                    u32x4 pp;
#pragma unroll
                    for (int j = 0; j < 4; ++j) pp[j] = pk_bf16(s[mt][8 * sp + 2 * j], s[mt][8 * sp + 2 * j + 1]);
                    const bf16x8 pb = __builtin_bit_cast(bf16x8, pp);
                    const int koff = (mt * 32 + 16 * sp) * 2 + hf * 16;
                    o0 = mfma32(*(const bf16x8*)(Vb + r * VROW + koff), pb, o0);
                    o1 = mfma32(*(const bf16x8*)(Vb + (32 + r) * VROW + koff), pb, o1);
                }
        }
        if (more) {
            unsigned char* Nb = lds + ((i + 1) & 1) * BUFSZ;
#pragma unroll
            for (int j = 0; j < NKL; ++j) *(u32x4*)(Nb + kdst[j]) = kreg[j];
#pragma unroll
            for (int j = 0; j < 2; ++j) { *(u32x2*)(Nb + vdst[j]) = (u32x2){vreg[j][0], vreg[j][1]}; *(u32x2*)(Nb + vdst[j] + 16) = (u32x2){vreg[j][2], vreg[j][3]}; }
            if (MODE == 2) mw = mwn;
        }
        __syncthreads();
    }
    __builtin_amdgcn_s_setprio(0);
    const float ltot = lsum + __shfl_xor(lsum, 32, 64);
    float inv = 1.0f / ltot;
    if ((DBG_SKIP >> (MODE == 2 ? 1 : MODE == 1 ? 2 : 3)) & 1) inv = 0.f;
#pragma unroll
    for (int g4 = 0; g4 < 4; ++g4) {
        f32x4 v0 = {o0[4 * g4] * inv, o0[4 * g4 + 1] * inv, o0[4 * g4 + 2] * inv, o0[4 * g4 + 3] * inv};
        f32x4 v1 = {o1[4 * g4] * inv, o1[4 * g4 + 1] * inv, o1[4 * g4 + 2] * inv, o1[4 * g4 + 3] * inv};
        gm::st_bf4(optr + 8 * g4 + 4 * hf, v0); gm::st_bf4(optr + 32 + 8 * g4 + 4 * hf, v1);
    }
}
}

namespace ab {
typedef bf16_t bf16;
constexpr int SEQ=S_,D=64,DM=NE_IN,OM=1024;
constexpr int NW=8,QBLK=32,QB=QBLK*NW,KVBLK=64;
__device__ __forceinline__ int crow(int r,int hi){return (r&3)+8*(r>>2)+4*hi;}
#define SBAR() __builtin_amdgcn_sched_barrier(0)
__device__ __forceinline__ void cmask(f32x16&p0,f32x16&p1,int jb,int qrel,int hi){
  const float NEG=-INFINITY; int kb=64*jb+4*hi;
  #pragma unroll
  for(int r=0;r<16;++r){int kv=kb+(r&3)+8*(r>>2); if(kv>qrel)p0[r]=NEG; if(kv+32>qrel)p1[r]=NEG;}
}

constexpr int NSLOT=3, SLOTB=8192;
constexpr int LDS_K=0, LDS_V=NSLOT*SLOTB, LDS_WS=2*NSLOT*SLOTB, LDS_OST=LDS_WS+NW*64*4, LDS_BYTES=LDS_OST+NW*4096;
constexpr float C2=0.125f*1.4426950408889634f;
__device__ __forceinline__ void glds16(const void*gsrc,unsigned lds_dst){unsigned keep;
  asm volatile("s_mov_b32 %0, m0\n\ts_mov_b32 m0, %2\n\ts_nop 0\n\tglobal_load_lds_dwordx4 %1, off\n\ts_mov_b32 m0, %0":"=&s"(keep):"v"(gsrc),"s"(lds_dst):"memory");}
__device__ __forceinline__ float max3f(float a,float b,float c){float r;asm("v_max3_f32 %0, %1, %2, %3":"=v"(r):"v"(a),"v"(b),"v"(c));return r;}
__device__ __forceinline__ float max2f(float a,float b){float r;asm("v_max_f32_e32 %0, %1, %2":"=v"(r):"v"(a),"v"(b));return r;}
__device__ __forceinline__ float fadd_s(float a,float b){float r;asm("v_add_f32_e32 %0, %1, %2":"=v"(r):"v"(a),"v"(b));return r;}
__device__ __forceinline__ float fsub_s(float a,float b){float r;asm("v_sub_f32_e32 %0, %1, %2":"=v"(r):"v"(a),"v"(b));return r;}
typedef float f32x2_t __attribute__((ext_vector_type(2))); typedef __bf16 bf16x2_t __attribute__((ext_vector_type(2)));
__device__ __forceinline__ unsigned cvtpk_s(float lo,float hi){f32x2_t v={lo,hi};bf16x2_t b=__builtin_convertvector(v,bf16x2_t);return __builtin_bit_cast(unsigned,b);}
#define WAIT_BAR(N) asm volatile("s_waitcnt vmcnt(" #N ") lgkmcnt(0)\n\ts_barrier":::"memory")

__device__ __forceinline__ void qkt(f32x16&p0,f32x16&p1,const char*Kslot,const bf16x8*qr,const f32x16&negm,int r32,int hi){
  const char*kb=Kslot+hi*1024+r32*16;
  #pragma unroll
  for(int d0=0;d0<4;++d0){
    const bf16x8 b0=*reinterpret_cast<const bf16x8*>(kb+d0*2048);
    const bf16x8 b1=*reinterpret_cast<const bf16x8*>(kb+d0*2048+512);
    if(d0==0){p0=__builtin_amdgcn_mfma_f32_32x32x16_bf16(b0,qr[0],negm,0,0,0);p1=__builtin_amdgcn_mfma_f32_32x32x16_bf16(b1,qr[0],negm,0,0,0);}
    else{p0=__builtin_amdgcn_mfma_f32_32x32x16_bf16(b0,qr[d0],p0,0,0,0);p1=__builtin_amdgcn_mfma_f32_32x32x16_bf16(b1,qr[d0],p1,0,0,0);}}
}
typedef __attribute__((address_space(3))) const char* lds_cptr;
typedef short v4i16_t __attribute__((ext_vector_type(4)));
__device__ __forceinline__ void kload8(bf16x8*kf,lds_cptr kp){
  kf[0]=*(const __attribute__((address_space(3))) bf16x8*)(kp);      kf[1]=*(const __attribute__((address_space(3))) bf16x8*)(kp+512);
  kf[2]=*(const __attribute__((address_space(3))) bf16x8*)(kp+2048); kf[3]=*(const __attribute__((address_space(3))) bf16x8*)(kp+2560);
  kf[4]=*(const __attribute__((address_space(3))) bf16x8*)(kp+4096); kf[5]=*(const __attribute__((address_space(3))) bf16x8*)(kp+4608);
  kf[6]=*(const __attribute__((address_space(3))) bf16x8*)(kp+6144); kf[7]=*(const __attribute__((address_space(3))) bf16x8*)(kp+6656);
}
__device__ __forceinline__ void kload2(bf16x8*kf,lds_cptr kp,int j){ kf[2*j]=*(const __attribute__((address_space(3))) bf16x8*)(kp+j*2048); kf[2*j+1]=*(const __attribute__((address_space(3))) bf16x8*)(kp+j*2048+512); }
__device__ __forceinline__ s16x4 vtr(lds_cptr p){ return __builtin_bit_cast(s16x4,__builtin_amdgcn_ds_read_tr16_b64_v4i16((__attribute__((address_space(3))) v4i16_t*)p)); }
__device__ __forceinline__ float rowmax(const f32x16&p0,const f32x16&p1){
  float a=max3f(p0[0],p0[1],p1[0]),b=max3f(p0[2],p0[3],p1[1]);a=max3f(a,p1[2],p1[3]);
  #pragma unroll
  for(int r=4;r<16;r+=4){a=max3f(a,p0[r],p0[r+1]);b=max3f(b,p0[r+2],p0[r+3]);a=max3f(a,p1[r],p1[r+1]);b=max3f(b,p1[r+2],p1[r+3]);}
  const float m=max2f(a,b);
  auto rr=__builtin_amdgcn_permlane32_swap(__float_as_uint(m),__float_as_uint(m),false,false);
  return max2f(__uint_as_float(rr[0]),__uint_as_float(rr[1]));
}
__device__ __forceinline__ void pv(f32x16*o,int vb,bf16x8 pa0,bf16x8 pa1,bf16x8 pa2,bf16x8 pa3){
  #pragma unroll
  for(int d0=0;d0<2;++d0){s16x4 lo[4],hi[4];
    #pragma unroll
    for(int ks=0;ks<4;++ks){
      asm volatile("ds_read_b64_tr_b16 %0,%1 offset:%c2":"=&v"(lo[ks]):"v"(vb),"i"(d0*4096+ks*1024):"memory");
      asm volatile("ds_read_b64_tr_b16 %0,%1 offset:%c2":"=&v"(hi[ks]):"v"(vb),"i"(d0*4096+ks*1024+512):"memory");}
    asm volatile("s_waitcnt lgkmcnt(0)":::"memory");SBAR();
    #define PK(k) (bf16x8){lo[k][0],lo[k][1],lo[k][2],lo[k][3],hi[k][0],hi[k][1],hi[k][2],hi[k][3]}
    o[d0]=__builtin_amdgcn_mfma_f32_32x32x16_bf16(pa0,PK(0),o[d0],0,0,0);
    o[d0]=__builtin_amdgcn_mfma_f32_32x32x16_bf16(pa1,PK(1),o[d0],0,0,0);
    o[d0]=__builtin_amdgcn_mfma_f32_32x32x16_bf16(pa2,PK(2),o[d0],0,0,0);
    o[d0]=__builtin_amdgcn_mfma_f32_32x32x16_bf16(pa3,PK(3),o[d0],0,0,0);
    #undef PK
  }
}

constexpr int LDS_KM=LDS_BYTES;
__device__ __forceinline__ void moba_kmean(int b,int h,int nmax,const bf16*__restrict__ K,char*shm,int tid){
  const int lane=tid&63,wid=__builtin_amdgcn_readfirstlane(tid>>6);
  float*km=(float*)(shm+LDS_KM); float*kmw=km+7*64;
  const bf16*Kh=K+(long)b*SEQ*DM+h*D;
  { const int kc=lane&7,kg=tid>>3;
    const bf16*kb=Kh+(long)(kg*4)*DM+kc*8;
    u32x4 kv[7][4];
    #pragma unroll
    for(int n=0;n<7;++n) if(n<nmax){
      #pragma unroll
      for(int kk=0;kk<4;++kk)kv[n][kk]=*(const u32x4*)(kb+(long)(n*256+kk)*DM); }
    #pragma unroll
    for(int n=0;n<7;++n) if(n<nmax){ float sa[8];
      #pragma unroll
      for(int e=0;e<8;++e)sa[e]=0.f;
      #pragma unroll
      for(int kk=0;kk<4;++kk)
        #pragma unroll
        for(int q=0;q<4;++q){sa[2*q]+=bf_lo(kv[n][kk][q]);sa[2*q+1]+=bf_hi(kv[n][kk][q]);}
      #pragma unroll
      for(int e=0;e<8;++e){sa[e]+=__shfl_xor(sa[e],8,64);sa[e]+=__shfl_xor(sa[e],16,64);sa[e]+=__shfl_xor(sa[e],32,64);}
      if(lane<8){float*dst=kmw+(n*8+wid)*64+kc*8;*(f32x4*)dst=(f32x4){sa[0],sa[1],sa[2],sa[3]};*(f32x4*)(dst+4)=(f32x4){sa[4],sa[5],sa[6],sa[7]};} } }
  __syncthreads();
  if(tid<nmax*64){const int n=tid>>6,d=tid&63;float sacc=0.f;
    #pragma unroll
    for(int ww=0;ww<8;++ww)sacc+=kmw[(n*8+ww)*64+d];
    km[n*64+d]=sacc*(1.0f/256.0f);}
  __syncthreads();
}
#ifndef ATTN_STORE16
#define ATTN_STORE16(p,v) (*(u32x4*)(p)=(v))
#endif
template<int THRL,int MODE> __device__ __forceinline__ void attn_unit(int b,int h,int qb,const bf16*Q,const bf16*__restrict__ K,const bf16*__restrict__ V,bf16*O,const unsigned*msk,char*shm,int tid){
  const int lane=tid&63,r32=lane&31,hi=lane>>5; const int wid=__builtin_amdgcn_readfirstlane(tid>>6);
  const long rowbase=(long)b*SEQ; const int q0=(MODE==2)?qb*32:qb*QB;
  const bf16*Qrow=(MODE==2)?Q+(rowbase+q0+wid*4+(r32>>3))*DM+(r32&7)*D:Q+(rowbase+q0+wid*QBLK+r32)*DM+h*D;
  const bf16*Kh=K+rowbase*DM+((MODE==2)?0:h*D),*Vh=V+rowbase*DM+((MODE==2)?0:h*D);
  const unsigned lds0=(unsigned)(uintptr_t)shm;
  float*wsf=(float*)(shm+LDS_WS)+wid*64;
  const bf16*ksrc=Kh+(long)lane*DM+wid*8;
  const bf16*vsrc=Vh+(long)(16*(wid&3)+(lane>>2))*DM+(wid>>2)*32+(lane&3)*8;
  const unsigned kdst=lds0+LDS_K+wid*1024, vdst=lds0+LDS_V+wid*1024;
  #define DMA_K(t,slot) glds16(ksrc+(long)(t)*KVBLK*DM,(unsigned)__builtin_amdgcn_readfirstlane(kdst+(slot)))
  #define DMA_V(t,slot) glds16(vsrc+(long)(t)*KVBLK*DM,(unsigned)__builtin_amdgcn_readfirstlane(vdst+(slot)))
  const int vb0=(int)(lds0+LDS_V)+((lane>>4)&1)*32+(lane&3)*8+(4*hi+((lane&15)>>2))*64;
  const char*Kbase=shm+LDS_K; bf16x8 kf[8];
  const lds_cptr shm3=(lds_cptr)shm; const lds_cptr kp0=shm3+LDS_K+hi*1024+r32*16; const lds_cptr vp0=shm3+LDS_V+((lane>>4)&1)*32+(lane&3)*8+(4*hi+((lane&15)>>2))*64;
  const int NTr=(MODE==2)?((q0+31)>>6)+1:(q0+QB)/KVBLK; const int NT=(MODE==2)?((NTr<4)?4:((NTr+1)&~1)):NTr;
  bf16x8 qr[4];
  #pragma unroll
  for(int d0=0;d0<4;++d0)qr[d0]=*reinterpret_cast<const bf16x8*>(&Qrow[d0*16+hi*8]);
  unsigned blkmask=0xffffffffu;
  if(MODE==2){
    const u32x4 mv=*(const u32x4*)(msk+(size_t)(rowbase+q0+(tid>>4))*64+(tid&15)*4);
    *(u32x4*)(shm+LDS_OST+tid*16)=mv;
    __syncthreads();
  }
  if(MODE==1){
    const int own=qb;
    const float*km=(const float*)(shm+LDS_KM);
    float gt[7];
    #pragma unroll
    for(int n=0;n<7;++n){float g=0.f;
      if(n<own){
        #pragma unroll
        for(int ks=0;ks<4;++ks)
          #pragma unroll
          for(int j=0;j<8;++j)g+=__uint_as_float((unsigned)(unsigned short)qr[ks][j]<<16)*km[n*64+ks*16+hi*8+j];
        g+=__shfl_xor(g,32,64);}
      gt[n]=g;}
    blkmask=1u<<own;
    #pragma unroll
    for(int n=0;n<7;++n){int rank=0;
      #pragma unroll
      for(int n2=0;n2<7;++n2)if(n2!=n)rank+=(n2<own&&(gt[n2]>gt[n]||(gt[n2]==gt[n]&&n2<n)))?1:0;
      if(n<own&&rank<3)blkmask|=1u<<n;}
  }
  DMA_K(0,0);DMA_V(0,0);DMA_K(1,SLOTB);
  float mhat=0.f,l_reg=0.f;f32x16 o[2];o[0]=f32x16{};o[1]=f32x16{};f32x16 negm=f32x16{};asm volatile("":"+v"(negm));
  const int qrel=wid*QBLK+r32;
  const unsigned*mrow=(const unsigned*)(shm+LDS_OST)+(wid*4+(r32>>3))*64;
  #define BMASK(P0,P1,t) do{ const u32x2 mw_=*(const u32x2*)(mrow+2*(t)); const unsigned w0_=mw_[0]>>(4*hi),w1_=mw_[1]>>(4*hi); \
      _Pragma("unroll") for(int r_=0;r_<16;++r_){ const int bit_=(r_&3)+8*(r_>>2); P0[r_]=((w0_>>bit_)&1u)?P0[r_]:-INFINITY; P1[r_]=((w1_>>bit_)&1u)?P1[r_]:-INFINITY; } }while(0)
  #define GMASK(P0,P1,t) do{ if(MODE==2){BMASK(P0,P1,t);} else if(!((blkmask>>((t)>>2))&1u)){ _Pragma("unroll") for(int r_=0;r_<16;++r_){P0[r_]=-INFINITY;P1[r_]=-INFINITY;} } }while(0)
  #define CMASK(P0,P1,t) do{int jb_=(t)-(NT-4); if(MODE==1&&jb_>=0)cmask(P0,P1,jb_,qrel,hi); GMASK(P0,P1,t);}while(0)
  bool resc=false;
  #define START(P0,P1) do{ const float rm=rowmax(P0,P1); resc=false; \
    { const float dl=(rm==-INFINITY)?0.f:rm; mhat=fadd_s(mhat,dl); \
      _Pragma("unroll") for(int r=0;r<16;++r){P0[r]=fsub_s(P0[r],dl);P1[r]=fsub_s(P1[r],dl);} \
      _Pragma("unroll") for(int r=0;r<16;++r)negm[r]=-mhat; asm volatile("":"+v"(negm)); } \
    _Pragma("unroll") for(int r=0;r<16;++r)P0[r]=__builtin_amdgcn_exp2f(P0[r]); }while(0)
  #define RESC() do{ if(resc){ asm volatile("s_waitcnt lgkmcnt(0)":::"memory"); \
      _Pragma("unroll") for(int d_=0;d_<2;++d_) _Pragma("unroll") for(int r=0;r<16;++r)o[d_][r]*=wsf[crow(r,hi)]; } }while(0)
  f32x16 pA0,pA1,pB0,pB1;
  int sl_prev=0,sl_cur=0,sl_next=SLOTB;
  #define ROT() do{sl_prev=sl_cur;sl_cur=sl_next;sl_next=(sl_next==(NSLOT-1)*SLOTB)?0:sl_next+SLOTB;}while(0)
  DMA_K(2,2*SLOTB);
  WAIT_BAR(3);
  qkt(pA0,pA1,Kbase,qr,negm,r32,hi);asm volatile("s_nop 15\n\ts_nop 7":"+v"(pA0),"+v"(pA1));CMASK(pA0,pA1,0);
  START(pA0,pA1);
  _Pragma("unroll") for(int r=0;r<16;++r)pA1[r]=__builtin_amdgcn_exp2f(pA1[r]);
  WAIT_BAR(0);
  DMA_K(3,0);DMA_V(1,SLOTB);
  ROT();
  kload8(kf,kp0+sl_cur);
  WAIT_BAR(2);
  s16x4 vlo[8],vhi[8]; u32x4 pw0,pw1,pw2,pw3;
  #define PKW(P,B) cvtpk_s(P[B],P[B+1])
  #define PAF(k) __builtin_bit_cast(bf16x8,pw##k)
  #define VFR(i) (bf16x8){vlo[i][0],vlo[i][1],vlo[i][2],vlo[i][3],vhi[i][0],vhi[i][1],vhi[i][2],vhi[i][3]}
  #define PIN(x) asm volatile("":"+v"(x))
  #define MX3(a,b,c) __builtin_fmaxf(__builtin_fmaxf((a),(b)),(c))
  #define GAPA(MF,A0,A1,A2,A3,W0,W1,PW) do{ MF; sacc+=A0; sacc+=A1; sacc+=A2; sacc+=A3; PIN(sacc); W0; W1; PIN(PW); SBAR(); }while(0)
  #define EX(v) __builtin_amdgcn_exp2f(v)
  #define GAPB(MF,X,B) do{ MF; X[B]=EX(X[B]); X[B+1]=EX(X[B+1]); X[B+2]=EX(X[B+2]); X[B+3]=EX(X[B+3]); PIN(X); SBAR(); }while(0)
  #define VRD(i) do{ vlo[i]=vtr(vp_+(((i)>>2)*4096+((i)&3)*1024)); vhi[i]=vtr(vp_+(((i)>>2)*4096+((i)&3)*1024+512)); }while(0)
  #define KRD(G,j) do{ if(G){ kload2(kf,kp0+sl_next,j); SBAR(); } }while(0)
  #define STEP(C0,C1,P0,P1,t,GK,GV,GL) do{ SBAR(); \
    const lds_cptr vp_=vp0+sl_prev; \
    VRD(0); SBAR(); float sacc=(P0[0]+P0[1]); \
    GAPA(C0=__builtin_amdgcn_mfma_f32_32x32x16_bf16(kf[0],qr[0],negm,0,0,0), P0[2],P0[3],P0[4],P0[5],     pw0[0]=PKW(P0,0), pw0[1]=PKW(P0,2), pw0); \
    VRD(4); SBAR(); GAPA(C1=__builtin_amdgcn_mfma_f32_32x32x16_bf16(kf[1],qr[0],negm,0,0,0), P0[6],P0[7],P0[8],P0[9],     pw0[2]=PKW(P0,4), pw0[3]=PKW(P0,6), pw0); \
    VRD(1); SBAR(); GAPA(C0=__builtin_amdgcn_mfma_f32_32x32x16_bf16(kf[2],qr[1],C0,0,0,0),   P0[10],P0[11],P0[12],P0[13], pw1[0]=PKW(P0,8), pw1[1]=PKW(P0,10), pw1); \
    VRD(5); SBAR(); GAPA(C1=__builtin_amdgcn_mfma_f32_32x32x16_bf16(kf[3],qr[1],C1,0,0,0),   P0[14],P0[15],P1[0],P1[1],   pw1[2]=PKW(P0,12),pw1[3]=PKW(P0,14), pw1); \
    VRD(2); SBAR(); GAPA(C0=__builtin_amdgcn_mfma_f32_32x32x16_bf16(kf[4],qr[2],C0,0,0,0),   P1[2],P1[3],P1[4],P1[5],     pw2[0]=PKW(P1,0), pw2[1]=PKW(P1,2), pw2); \
    VRD(6); SBAR(); GAPA(C1=__builtin_amdgcn_mfma_f32_32x32x16_bf16(kf[5],qr[2],C1,0,0,0),   P1[6],P1[7],P1[8],P1[9],     pw2[2]=PKW(P1,4), pw2[3]=PKW(P1,6), pw2); \
    VRD(3); SBAR(); GAPA(C0=__builtin_amdgcn_mfma_f32_32x32x16_bf16(kf[6],qr[3],C0,0,0,0),   P1[10],P1[11],P1[12],P1[13], pw3[0]=PKW(P1,8), pw3[1]=PKW(P1,10), pw3); \
    VRD(7); SBAR(); GAPA(C1=__builtin_amdgcn_mfma_f32_32x32x16_bf16(kf[7],qr[3],C1,0,0,0),   P1[14],P1[15],0.f,0.f,       pw3[2]=PKW(P1,12),pw3[3]=PKW(P1,14), pw3); \
    l_reg+=sacc; \
    if(GK){DMA_K((t)+3,sl_cur);} if(GV){DMA_V((t)+1,sl_next);} \
    CMASK(C0,C1,t); \
    { float a=MX3(C0[0],C0[1],C1[0]),b=MX3(C0[2],C0[3],C1[1]); a=MX3(a,C1[2],C1[3]); \
      _Pragma("unroll") for(int r=4;r<16;r+=4){a=MX3(a,C0[r],C0[r+1]);b=MX3(b,C0[r+2],C0[r+3]);a=MX3(a,C1[r],C1[r+1]);b=MX3(b,C1[r+2],C1[r+3]);} \
      float rm=__builtin_fmaxf(a,b); { auto rr=__builtin_amdgcn_permlane32_swap(__float_as_uint(rm),__float_as_uint(rm),false,false); rm=__builtin_fmaxf(__uint_as_float(rr[0]),__uint_as_float(rr[1])); } \
      resc=false; \
      if(__builtin_expect(__any(rm>(float)THRL),0)){ const float dl=__builtin_fmaxf(rm,0.f); mhat+=dl; \
        _Pragma("unroll") for(int r=0;r<16;++r){C0[r]-=dl;C1[r]-=dl;} \
        _Pragma("unroll") for(int r=0;r<16;++r)negm[r]=-mhat; asm volatile("":"+v"(negm)); \
        const float f=__builtin_amdgcn_exp2f(-dl); l_reg*=f; if(hi==0)wsf[r32]=f; resc=true; } } \
    SBAR(); \
    GAPB(o[0]=__builtin_amdgcn_mfma_f32_32x32x16_bf16(PAF(0),VFR(0),o[0],0,0,0), C0,0); \
    GAPB(o[1]=__builtin_amdgcn_mfma_f32_32x32x16_bf16(PAF(0),VFR(4),o[1],0,0,0), C0,4); \
    KRD(GL,0); GAPB(o[0]=__builtin_amdgcn_mfma_f32_32x32x16_bf16(PAF(1),VFR(1),o[0],0,0,0), C0,8); \
    KRD(GL,1); GAPB(o[1]=__builtin_amdgcn_mfma_f32_32x32x16_bf16(PAF(1),VFR(5),o[1],0,0,0), C0,12); \
    KRD(GL,2); GAPB(o[0]=__builtin_amdgcn_mfma_f32_32x32x16_bf16(PAF(2),VFR(2),o[0],0,0,0), C1,0); \
    KRD(GL,3); GAPB(o[1]=__builtin_amdgcn_mfma_f32_32x32x16_bf16(PAF(2),VFR(6),o[1],0,0,0), C1,4); \
    GAPB(o[0]=__builtin_amdgcn_mfma_f32_32x32x16_bf16(PAF(3),VFR(3),o[0],0,0,0), C1,8); \
    GAPB(o[1]=__builtin_amdgcn_mfma_f32_32x32x16_bf16(PAF(3),VFR(7),o[1],0,0,0), C1,12); \
    }while(0)
  int t=1;
  #undef CMASK
  #define CMASK(P0,P1,t) GMASK(P0,P1,t)
  for(;t+5<NT;t+=2){
    STEP(pB0,pB1,pA0,pA1,t,true,true,true);     WAIT_BAR(2); RESC(); ROT();
    STEP(pA0,pA1,pB0,pB1,t+1,true,true,true);   WAIT_BAR(2); RESC(); ROT();
  }
  #undef CMASK
  #define CMASK(P0,P1,t) do{int jb_=(t)-(NT-4); if(MODE==1&&jb_>=0)cmask(P0,P1,jb_,qrel,hi); GMASK(P0,P1,t);}while(0)
  #define ENDW(tt) do{ if((tt)+3<NT){WAIT_BAR(2);} else if((tt)+2<NT){WAIT_BAR(1);} else {WAIT_BAR(0);} }while(0)
  for(;t+1<NT;t+=2){
    STEP(pB0,pB1,pA0,pA1,t,(t+3<NT),(t+1<NT),(t+1<NT));       ENDW(t);   RESC(); ROT();
    STEP(pA0,pA1,pB0,pB1,t+1,(t+4<NT),(t+2<NT),(t+2<NT));     ENDW(t+1); RESC(); ROT();
  }
  STEP(pB0,pB1,pA0,pA1,NT-1,false,false,false); RESC();
  { float sacc=pB0[0]+pB0[1]; _Pragma("unroll") for(int r=2;r<16;++r)sacc+=pB0[r]; _Pragma("unroll") for(int r=0;r<16;++r)sacc+=pB1[r]; l_reg+=sacc;
    pw0=(u32x4){PKW(pB0,0),PKW(pB0,2),PKW(pB0,4),PKW(pB0,6)};pw1=(u32x4){PKW(pB0,8),PKW(pB0,10),PKW(pB0,12),PKW(pB0,14)};pw2=(u32x4){PKW(pB1,0),PKW(pB1,2),PKW(pB1,4),PKW(pB1,6)};pw3=(u32x4){PKW(pB1,8),PKW(pB1,10),PKW(pB1,12),PKW(pB1,14)};
    SBAR(); pv(o,vb0+sl_cur,PAF(0),PAF(1),PAF(2),PAF(3)); }
  #undef PKW
  #undef PAF
  #undef VFR
  #undef PIN
  #undef MX3
  #undef GAPA
  #undef GAPB
  #undef EX
  #undef VRD
  #undef KRD
  #undef STEP
  #undef ENDW
  {auto rr=__builtin_amdgcn_permlane32_swap(__float_as_uint(l_reg),__float_as_uint(l_reg),false,false);l_reg=__uint_as_float(rr[0])+__uint_as_float(rr[1]);}
  if(hi==0)wsf[32+r32]=l_reg;asm volatile("s_waitcnt lgkmcnt(0)":::"memory");
  float rli[16];
  #pragma unroll
  for(int r=0;r<16;++r)rli[r]=__builtin_amdgcn_rcpf(wsf[32+crow(r,hi)]);
  if(MODE==2){ asm volatile("s_waitcnt lgkmcnt(0)\n\ts_barrier":::"memory"); }
  { bf16*stg=(bf16*)(shm+LDS_OST)+wid*2048;
    #pragma unroll
    for(int r=0;r<16;++r){const int orow=crow(r,hi);
      #pragma unroll
      for(int d0=0;d0<2;++d0)stg[orow*64+d0*32+r32]=f2bf(o[d0][r]*rli[r]);}
    asm volatile("s_waitcnt lgkmcnt(0)":::"memory");
    #pragma unroll
    for(int i=0;i<4;++i){const int row=i*8+(lane>>3),ch=lane&7; const u32x4 v=*(const u32x4*)(stg+row*64+ch*8);
      bf16*op=(MODE==2)?O+(rowbase+q0+wid*4+(row>>3))*OM+(row&7)*D+ch*8:O+(rowbase+q0+wid*QBLK+row)*OM+h*D+ch*8; ATTN_STORE16(op,v);} }
  asm volatile("s_waitcnt lgkmcnt(0)\n\ts_barrier":::"memory");
  #undef DMA_K
  #undef DMA_V
  #undef CMASK
  #undef GMASK
  #undef BMASK
  #undef START
  #undef RESC
  #undef ROT
}
constexpr int ATTN_LDS_BYTES=LDS_BYTES;
#undef SBAR
#undef WAIT_BAR
}

namespace am {
typedef bf16_t bf16;
constexpr int SEQ=S_,D=64;
constexpr int NW=8,QBLK=32,QB=QBLK*NW,KVBLK=64;
__device__ __forceinline__ int crow(int r,int hi){return (r&3)+8*(r>>2)+4*hi;}
#define SBAR() __builtin_amdgcn_sched_barrier(0)
__device__ __forceinline__ void cmask(f32x16&p0,f32x16&p1,int jb,int qrel,int hi){
  const float NEG=-INFINITY; int kb=64*jb+4*hi;
  #pragma unroll
  for(int r=0;r<16;++r){int kv=kb+(r&3)+8*(r>>2); if(kv>qrel)p0[r]=NEG; if(kv+32>qrel)p1[r]=NEG;}
}

constexpr int NSLOT=3, SLOTB=12288;
constexpr int LDS_K=0, LDS_V=NSLOT*SLOTB, LDS_WS=2*NSLOT*SLOTB, LDS_OST=LDS_WS+NW*64*4, LDS_DUMP=LDS_OST+NW*4096, LDS_BYTES=LDS_DUMP+4096;
constexpr float C2=0.10206207261596575f*1.4426950408889634f;
__device__ __forceinline__ void glds16(const void*gsrc,unsigned lds_dst){unsigned keep;
  asm volatile("s_mov_b32 %0, m0\n\ts_mov_b32 m0, %2\n\ts_nop 0\n\tglobal_load_lds_dwordx4 %1, off\n\ts_mov_b32 m0, %0":"=&s"(keep):"v"(gsrc),"s"(lds_dst):"memory");}
__device__ __forceinline__ float max3f(float a,float b,float c){float r;asm("v_max3_f32 %0, %1, %2, %3":"=v"(r):"v"(a),"v"(b),"v"(c));return r;}
__device__ __forceinline__ float max2f(float a,float b){float r;asm("v_max_f32_e32 %0, %1, %2":"=v"(r):"v"(a),"v"(b));return r;}
__device__ __forceinline__ float fadd_s(float a,float b){float r;asm("v_add_f32_e32 %0, %1, %2":"=v"(r):"v"(a),"v"(b));return r;}
__device__ __forceinline__ float fsub_s(float a,float b){float r;asm("v_sub_f32_e32 %0, %1, %2":"=v"(r):"v"(a),"v"(b));return r;}
typedef float f32x2_t __attribute__((ext_vector_type(2))); typedef __bf16 bf16x2_t __attribute__((ext_vector_type(2)));
__device__ __forceinline__ unsigned cvtpk_s(float lo,float hi){f32x2_t v={lo,hi};bf16x2_t b=__builtin_convertvector(v,bf16x2_t);return __builtin_bit_cast(unsigned,b);}
#define WAIT_BAR(N) asm volatile("s_waitcnt vmcnt(" #N ") lgkmcnt(0)\n\ts_barrier":::"memory")

__device__ __forceinline__ void qkt(f32x16&p0,f32x16&p1,const char*Kslot,const bf16x8*qr,const f32x16&negm,int r32,int hi){
  const char*kb=Kslot+hi*1024+r32*16;
  #pragma unroll
  for(int d0=0;d0<6;++d0){
    const bf16x8 b0=*reinterpret_cast<const bf16x8*>(kb+d0*2048);
    const bf16x8 b1=*reinterpret_cast<const bf16x8*>(kb+d0*2048+512);
    if(d0==0){p0=__builtin_amdgcn_mfma_f32_32x32x16_bf16(b0,qr[0],negm,0,0,0);p1=__builtin_amdgcn_mfma_f32_32x32x16_bf16(b1,qr[0],negm,0,0,0);}
    else{p0=__builtin_amdgcn_mfma_f32_32x32x16_bf16(b0,qr[d0],p0,0,0,0);p1=__builtin_amdgcn_mfma_f32_32x32x16_bf16(b1,qr[d0],p1,0,0,0);}}
}
typedef __attribute__((address_space(3))) const char* lds_cptr;
typedef short v4i16_t __attribute__((ext_vector_type(4)));
__device__ __forceinline__ void kload8(bf16x8*kf,lds_cptr kp){
  kf[0]=*(const __attribute__((address_space(3))) bf16x8*)(kp);      kf[1]=*(const __attribute__((address_space(3))) bf16x8*)(kp+512);
  kf[2]=*(const __attribute__((address_space(3))) bf16x8*)(kp+2048); kf[3]=*(const __attribute__((address_space(3))) bf16x8*)(kp+2560);
  kf[4]=*(const __attribute__((address_space(3))) bf16x8*)(kp+4096); kf[5]=*(const __attribute__((address_space(3))) bf16x8*)(kp+4608);
  kf[6]=*(const __attribute__((address_space(3))) bf16x8*)(kp+6144); kf[7]=*(const __attribute__((address_space(3))) bf16x8*)(kp+6656);
  kf[8]=*(const __attribute__((address_space(3))) bf16x8*)(kp+8192); kf[9]=*(const __attribute__((address_space(3))) bf16x8*)(kp+8704);
  kf[10]=*(const __attribute__((address_space(3))) bf16x8*)(kp+10240); kf[11]=*(const __attribute__((address_space(3))) bf16x8*)(kp+10752);
}
__device__ __forceinline__ void kload2(bf16x8*kf,lds_cptr kp,int j){ kf[2*j]=*(const __attribute__((address_space(3))) bf16x8*)(kp+j*2048); kf[2*j+1]=*(const __attribute__((address_space(3))) bf16x8*)(kp+j*2048+512); }
__device__ __forceinline__ s16x4 vtr(lds_cptr p){ return __builtin_bit_cast(s16x4,__builtin_amdgcn_ds_read_tr16_b64_v4i16((__attribute__((address_space(3))) v4i16_t*)p)); }
__device__ __forceinline__ float rowmax(const f32x16&p0,const f32x16&p1){
  float a=max3f(p0[0],p0[1],p1[0]),b=max3f(p0[2],p0[3],p1[1]);a=max3f(a,p1[2],p1[3]);
  #pragma unroll
  for(int r=4;r<16;r+=4){a=max3f(a,p0[r],p0[r+1]);b=max3f(b,p0[r+2],p0[r+3]);a=max3f(a,p1[r],p1[r+1]);b=max3f(b,p1[r+2],p1[r+3]);}
  const float m=max2f(a,b);
  auto rr=__builtin_amdgcn_permlane32_swap(__float_as_uint(m),__float_as_uint(m),false,false);
  return max2f(__uint_as_float(rr[0]),__uint_as_float(rr[1]));
}
__device__ __forceinline__ void pv(f32x16*o,int vb,bf16x8 pa0,bf16x8 pa1,bf16x8 pa2,bf16x8 pa3){
  #pragma unroll
  for(int d0=0;d0<2;++d0){s16x4 lo[4],hi[4];
    #pragma unroll
    for(int ks=0;ks<4;++ks){
      asm volatile("ds_read_b64_tr_b16 %0,%1 offset:%c2":"=&v"(lo[ks]):"v"(vb),"i"(d0*4096+ks*1024):"memory");
      asm volatile("ds_read_b64_tr_b16 %0,%1 offset:%c2":"=&v"(hi[ks]):"v"(vb),"i"(d0*4096+ks*1024+512):"memory");}
    asm volatile("s_waitcnt lgkmcnt(0)":::"memory");SBAR();
    #define PK(k) (bf16x8){lo[k][0],lo[k][1],lo[k][2],lo[k][3],hi[k][0],hi[k][1],hi[k][2],hi[k][3]}
    o[d0]=__builtin_amdgcn_mfma_f32_32x32x16_bf16(pa0,PK(0),o[d0],0,0,0);
    o[d0]=__builtin_amdgcn_mfma_f32_32x32x16_bf16(pa1,PK(1),o[d0],0,0,0);
    o[d0]=__builtin_amdgcn_mfma_f32_32x32x16_bf16(pa2,PK(2),o[d0],0,0,0);
    o[d0]=__builtin_amdgcn_mfma_f32_32x32x16_bf16(pa3,PK(3),o[d0],0,0,0);
    #undef PK
  }
}

#ifndef ATTN_STORE16
#define ATTN_STORE16(p,v) (*(u32x4*)(p)=(v))
#endif
template<int THRL> __device__ __forceinline__ void attn_unit(int b,int h,int qb,const bf16*Q,const bf16*__restrict__ KN,const bf16*__restrict__ KR,const bf16*__restrict__ V,bf16*O,char*shm,int tid){
  const int lane=tid&63,r32=lane&31,hi=lane>>5; const int wid=__builtin_amdgcn_readfirstlane(tid>>6);
  const long rowbase=(long)b*SEQ; const int q0=qb*QB;
  const bf16*Qrow=Q+(rowbase+q0+wid*QBLK+r32)*1536+h*96;
  const unsigned lds0=(unsigned)(uintptr_t)shm;
  float*wsf=(float*)(shm+LDS_WS)+wid*64;
  const bf16*ksrcA=KN+(rowbase+lane)*1024+h*64+wid*8;
  const long dKR=KR-KN;
  const bf16*ksrcB=KN+((wid<4)?dKR+(rowbase+lane)*1280+1024+wid*8:(rowbase+lane)*1024+h*64+wid*8);
  const long kstepB=(wid<4)?(long)KVBLK*1280:(long)KVBLK*1024;
  const bf16*vsrc=V+(rowbase+16*(wid&3)+(lane>>2))*1024+h*64+(wid>>2)*32+(lane&3)*8;
  const unsigned kdstA=lds0+LDS_K+wid*1024, kdstB=(wid<4)?lds0+LDS_K+(8+wid)*1024:lds0+LDS_DUMP+(wid-4)*1024, vdst=lds0+LDS_V+wid*1024;
  #define DMA_K(t,slot) do{ glds16(ksrcA+(long)(t)*KVBLK*1024,(unsigned)__builtin_amdgcn_readfirstlane(kdstA+(slot))); \
      glds16(ksrcB+(long)(t)*kstepB,(unsigned)__builtin_amdgcn_readfirstlane((wid<4)?kdstB+(slot):kdstB)); }while(0)
  #define DMA_V(t,slot) glds16(vsrc+(long)(t)*KVBLK*1024,(unsigned)__builtin_amdgcn_readfirstlane(vdst+(slot)))
  const int vb0=(int)(lds0+LDS_V)+((lane>>4)&1)*32+(lane&3)*8+(4*hi+((lane&15)>>2))*64;
  const char*Kbase=shm+LDS_K; bf16x8 kf[12];
  const lds_cptr shm3=(lds_cptr)shm; const lds_cptr kp0=shm3+LDS_K+hi*1024+r32*16; const lds_cptr vp0=shm3+LDS_V+((lane>>4)&1)*32+(lane&3)*8+(4*hi+((lane&15)>>2))*64;
  const int NT=(q0+QB)/KVBLK;
  DMA_K(0,0);DMA_V(0,0);DMA_K(1,SLOTB);
  bf16x8 qr[6];
  #pragma unroll
  for(int d0=0;d0<6;++d0)qr[d0]=*reinterpret_cast<const bf16x8*>(&Qrow[d0*16+hi*8]);
  float mhat=0.f,l_reg=0.f;f32x16 o[2];o[0]=f32x16{};o[1]=f32x16{};f32x16 negm=f32x16{};asm volatile("":"+v"(negm));
  const int qrel=wid*QBLK+r32;
  #define CMASK(P0,P1,t) do{int jb_=(t)-(NT-4); if(jb_>=0)cmask(P0,P1,jb_,qrel,hi);}while(0)
  bool resc=false;
  #define START(P0,P1) do{ const float rm=rowmax(P0,P1); resc=false; \
    { const float dl=rm; mhat=fadd_s(mhat,dl); \
      _Pragma("unroll") for(int r=0;r<16;++r){P0[r]=fsub_s(P0[r],dl);P1[r]=fsub_s(P1[r],dl);} \
      _Pragma("unroll") for(int r=0;r<16;++r)negm[r]=-mhat; asm volatile("":"+v"(negm)); } \
    _Pragma("unroll") for(int r=0;r<16;++r)P0[r]=__builtin_amdgcn_exp2f(P0[r]); }while(0)
  #define RESC() do{ if(resc){ asm volatile("s_waitcnt lgkmcnt(0)":::"memory"); \
      _Pragma("unroll") for(int d_=0;d_<2;++d_) _Pragma("unroll") for(int r=0;r<16;++r)o[d_][r]*=wsf[crow(r,hi)]; } }while(0)
  f32x16 pA0,pA1,pB0,pB1;
  int sl_prev=0,sl_cur=0,sl_next=SLOTB;
  #define ROT() do{sl_prev=sl_cur;sl_cur=sl_next;sl_next=(sl_next==(NSLOT-1)*SLOTB)?0:sl_next+SLOTB;}while(0)
  DMA_K(2,2*SLOTB);
  WAIT_BAR(5);
  qkt(pA0,pA1,Kbase,qr,negm,r32,hi);asm volatile("s_nop 15\n\ts_nop 7":"+v"(pA0),"+v"(pA1));CMASK(pA0,pA1,0);
  START(pA0,pA1);
  _Pragma("unroll") for(int r=0;r<16;++r)pA1[r]=__builtin_amdgcn_exp2f(pA1[r]);
  WAIT_BAR(0);
  DMA_K(3,0);DMA_V(1,SLOTB);
  ROT();
  kload8(kf,kp0+sl_cur);
  WAIT_BAR(3);
  s16x4 vlo[8],vhi[8]; u32x4 pw0,pw1,pw2,pw3;
  #define PKW(P,B) cvtpk_s(P[B],P[B+1])
  #define PAF(k) __builtin_bit_cast(bf16x8,pw##k)
  #define VFR(i) (bf16x8){vlo[i][0],vlo[i][1],vlo[i][2],vlo[i][3],vhi[i][0],vhi[i][1],vhi[i][2],vhi[i][3]}
  #define PIN(x) asm volatile("":"+v"(x))
  #define MX3(a,b,c) __builtin_fmaxf(__builtin_fmaxf((a),(b)),(c))
  #define GAPA(MF,A0,A1,A2,A3,W0,W1,PW) do{ MF; sacc+=A0; sacc+=A1; sacc+=A2; sacc+=A3; PIN(sacc); W0; W1; PIN(PW); SBAR(); }while(0)
  #define EX(v) __builtin_amdgcn_exp2f(v)
  #define GAPB(MF,X,B) do{ MF; X[B]=EX(X[B]); X[B+1]=EX(X[B+1]); X[B+2]=EX(X[B+2]); X[B+3]=EX(X[B+3]); PIN(X); SBAR(); }while(0)
  #define VRD(i) do{ vlo[i]=vtr(vp_+(((i)>>2)*4096+((i)&3)*1024)); vhi[i]=vtr(vp_+(((i)>>2)*4096+((i)&3)*1024+512)); }while(0)
  #define KRD(G,j) do{ if(G){ kload2(kf,kp0+sl_next,j); SBAR(); } }while(0)
  #define STEP(C0,C1,P0,P1,t,GK,GV,GL) do{ SBAR(); \
    const lds_cptr vp_=vp0+sl_prev; \
    VRD(0); SBAR(); float sacc=(P0[0]+P0[1]); \
    GAPA(C0=__builtin_amdgcn_mfma_f32_32x32x16_bf16(kf[0],qr[0],negm,0,0,0), P0[2],P0[3],P0[4],P0[5],     pw0[0]=PKW(P0,0), pw0[1]=PKW(P0,2), pw0); \
    VRD(4); SBAR(); GAPA(C1=__builtin_amdgcn_mfma_f32_32x32x16_bf16(kf[1],qr[0],negm,0,0,0), P0[6],P0[7],P0[8],P0[9],     pw0[2]=PKW(P0,4), pw0[3]=PKW(P0,6), pw0); \
    VRD(1); SBAR(); GAPA(C0=__builtin_amdgcn_mfma_f32_32x32x16_bf16(kf[2],qr[1],C0,0,0,0),   P0[10],P0[11],P0[12],P0[13], pw1[0]=PKW(P0,8), pw1[1]=PKW(P0,10), pw1); \
    VRD(5); SBAR(); GAPA(C1=__builtin_amdgcn_mfma_f32_32x32x16_bf16(kf[3],qr[1],C1,0,0,0),   P0[14],P0[15],P1[0],P1[1],   pw1[2]=PKW(P0,12),pw1[3]=PKW(P0,14), pw1); \
    VRD(2); SBAR(); GAPA(C0=__builtin_amdgcn_mfma_f32_32x32x16_bf16(kf[4],qr[2],C0,0,0,0),   P1[2],P1[3],P1[4],P1[5],     pw2[0]=PKW(P1,0), pw2[1]=PKW(P1,2), pw2); \
    VRD(6); SBAR(); GAPA(C1=__builtin_amdgcn_mfma_f32_32x32x16_bf16(kf[5],qr[2],C1,0,0,0),   P1[6],P1[7],P1[8],P1[9],     pw2[2]=PKW(P1,4), pw2[3]=PKW(P1,6), pw2); \
    VRD(3); SBAR(); GAPA(C0=__builtin_amdgcn_mfma_f32_32x32x16_bf16(kf[6],qr[3],C0,0,0,0),   P1[10],P1[11],P1[12],P1[13], pw3[0]=PKW(P1,8), pw3[1]=PKW(P1,10), pw3); \
    VRD(7); SBAR(); GAPA(C1=__builtin_amdgcn_mfma_f32_32x32x16_bf16(kf[7],qr[3],C1,0,0,0),   P1[14],P1[15],0.f,0.f,       pw3[2]=PKW(P1,12),pw3[3]=PKW(P1,14), pw3); \
    C0=__builtin_amdgcn_mfma_f32_32x32x16_bf16(kf[8],qr[4],C0,0,0,0); C1=__builtin_amdgcn_mfma_f32_32x32x16_bf16(kf[9],qr[4],C1,0,0,0); SBAR(); \
    C0=__builtin_amdgcn_mfma_f32_32x32x16_bf16(kf[10],qr[5],C0,0,0,0); C1=__builtin_amdgcn_mfma_f32_32x32x16_bf16(kf[11],qr[5],C1,0,0,0); SBAR(); \
    l_reg+=sacc; \
    if(GK){DMA_K((t)+3,sl_cur);} if(GV){DMA_V((t)+1,sl_next);} \
    CMASK(C0,C1,t); \
    { float a=MX3(C0[0],C0[1],C1[0]),b=MX3(C0[2],C0[3],C1[1]); a=MX3(a,C1[2],C1[3]); \
      _Pragma("unroll") for(int r=4;r<16;r+=4){a=MX3(a,C0[r],C0[r+1]);b=MX3(b,C0[r+2],C0[r+3]);a=MX3(a,C1[r],C1[r+1]);b=MX3(b,C1[r+2],C1[r+3]);} \
      float rm=__builtin_fmaxf(a,b); { auto rr=__builtin_amdgcn_permlane32_swap(__float_as_uint(rm),__float_as_uint(rm),false,false); rm=__builtin_fmaxf(__uint_as_float(rr[0]),__uint_as_float(rr[1])); } \
      resc=false; \
      if(__builtin_expect(__any(rm>(float)THRL),0)){ const float dl=__builtin_fmaxf(rm,0.f); mhat+=dl; \
        _Pragma("unroll") for(int r=0;r<16;++r){C0[r]-=dl;C1[r]-=dl;} \
        _Pragma("unroll") for(int r=0;r<16;++r)negm[r]=-mhat; asm volatile("":"+v"(negm)); \
        const float f=__builtin_amdgcn_exp2f(-dl); l_reg*=f; if(hi==0)wsf[r32]=f; resc=true; } } \
    SBAR(); \
    GAPB(o[0]=__builtin_amdgcn_mfma_f32_32x32x16_bf16(PAF(0),VFR(0),o[0],0,0,0), C0,0); \
    GAPB(o[1]=__builtin_amdgcn_mfma_f32_32x32x16_bf16(PAF(0),VFR(4),o[1],0,0,0), C0,4); \
    KRD(GL,0); GAPB(o[0]=__builtin_amdgcn_mfma_f32_32x32x16_bf16(PAF(1),VFR(1),o[0],0,0,0), C0,8); \
    KRD(GL,1); GAPB(o[1]=__builtin_amdgcn_mfma_f32_32x32x16_bf16(PAF(1),VFR(5),o[1],0,0,0), C0,12); \
    KRD(GL,2); GAPB(o[0]=__builtin_amdgcn_mfma_f32_32x32x16_bf16(PAF(2),VFR(2),o[0],0,0,0), C1,0); \
    KRD(GL,3); GAPB(o[1]=__builtin_amdgcn_mfma_f32_32x32x16_bf16(PAF(2),VFR(6),o[1],0,0,0), C1,4); \
    KRD(GL,4); GAPB(o[0]=__builtin_amdgcn_mfma_f32_32x32x16_bf16(PAF(3),VFR(3),o[0],0,0,0), C1,8); \
    KRD(GL,5); GAPB(o[1]=__builtin_amdgcn_mfma_f32_32x32x16_bf16(PAF(3),VFR(7),o[1],0,0,0), C1,12); \
    }while(0)
  int t=1;
  #undef CMASK
  #define CMASK(P0,P1,t) do{}while(0)
  for(;t+5<NT;t+=2){
    STEP(pB0,pB1,pA0,pA1,t,true,true,true);     WAIT_BAR(3); RESC(); ROT();
    STEP(pA0,pA1,pB0,pB1,t+1,true,true,true);   WAIT_BAR(3); RESC(); ROT();
  }
  #undef CMASK
  #define CMASK(P0,P1,t) do{int jb_=(t)-(NT-4); if(jb_>=0)cmask(P0,P1,jb_,qrel,hi);}while(0)
  #define ENDW(tt) do{ if((tt)+3<NT){WAIT_BAR(3);} else if((tt)+2<NT){WAIT_BAR(1);} else {WAIT_BAR(0);} }while(0)
  for(;t+1<NT;t+=2){
    STEP(pB0,pB1,pA0,pA1,t,(t+3<NT),(t+1<NT),(t+1<NT));       ENDW(t);   RESC(); ROT();
    STEP(pA0,pA1,pB0,pB1,t+1,(t+4<NT),(t+2<NT),(t+2<NT));     ENDW(t+1); RESC(); ROT();
  }
  STEP(pB0,pB1,pA0,pA1,NT-1,false,false,false); RESC();
  { float sacc=pB0[0]+pB0[1]; _Pragma("unroll") for(int r=2;r<16;++r)sacc+=pB0[r]; _Pragma("unroll") for(int r=0;r<16;++r)sacc+=pB1[r]; l_reg+=sacc;
    pw0=(u32x4){PKW(pB0,0),PKW(pB0,2),PKW(pB0,4),PKW(pB0,6)};pw1=(u32x4){PKW(pB0,8),PKW(pB0,10),PKW(pB0,12),PKW(pB0,14)};pw2=(u32x4){PKW(pB1,0),PKW(pB1,2),PKW(pB1,4),PKW(pB1,6)};pw3=(u32x4){PKW(pB1,8),PKW(pB1,10),PKW(pB1,12),PKW(pB1,14)};
    SBAR(); pv(o,vb0+sl_cur,PAF(0),PAF(1),PAF(2),PAF(3)); }
  #undef PKW
  #undef PAF
  #undef VFR
  #undef PIN
  #undef MX3
  #undef GAPA
  #undef GAPB
  #undef EX
  #undef VRD
  #undef KRD
  #undef STEP
  #undef ENDW
  {auto rr=__builtin_amdgcn_permlane32_swap(__float_as_uint(l_reg),__float_as_uint(l_reg),false,false);l_reg=__uint_as_float(rr[0])+__uint_as_float(rr[1]);}
  if(hi==0)wsf[32+r32]=l_reg;asm volatile("s_waitcnt lgkmcnt(0)":::"memory");
  float rli[16];
  #pragma unroll
  for(int r=0;r<16;++r)rli[r]=__builtin_amdgcn_rcpf(wsf[32+crow(r,hi)]);
  bf16*Ow=O+(rowbase+q0+wid*QBLK)*1024+h*D;
  { bf16*stg=(bf16*)(shm+LDS_OST)+wid*2048;
    #pragma unroll
    for(int r=0;r<16;++r){const int orow=crow(r,hi);
      #pragma unroll
      for(int d0=0;d0<2;++d0)stg[orow*64+d0*32+r32]=f2bf(o[d0][r]*rli[r]);}
    asm volatile("s_waitcnt lgkmcnt(0)":::"memory");
    #pragma unroll
    for(int i=0;i<4;++i){const int row=i*8+(lane>>3),ch=lane&7; const u32x4 v=*(const u32x4*)(stg+row*64+ch*8); ATTN_STORE16(Ow+(long)row*1024+ch*8,v);} }
  asm volatile("s_waitcnt lgkmcnt(0)\n\ts_barrier":::"memory");
  #undef DMA_K
  #undef DMA_V
  #undef CMASK
  #undef START
  #undef RESC
  #undef ROT
}
constexpr int ATTN_LDS_BYTES=LDS_BYTES;
#undef SBAR
#undef WAIT_BAR
}

namespace ix {
constexpr int IKROW = 144;
DI unsigned sortable(float f) { const unsigned u = __float_as_uint(f); return (u & 0x80000000u) ? ~u : (u | 0x80000000u); }

DI void indexer_unit(const bf16_t* proj, const float* iw, unsigned* mask, int b, int qt16, unsigned char* lds, int tid) {
    float* SC = (float*)lds;
    unsigned char* IK = lds + 131072;
    const int w = __builtin_amdgcn_readfirstlane(tid >> 6), lane = tid & 63, r = lane & 31, hf = lane >> 5;
    const int mtile = w & 3, par = w >> 2;
    const int q0 = qt16 * 16, nch = (q0 + 16 + 127) >> 7;
    const int qq = ((r >> 4) & 1) + 2 * ((r >> 2) & 1), hh = (r & 3) + 4 * ((r >> 3) & 1);
    const bf16_t* ap = proj + (size_t)(b * S_ + q0 + 4 * mtile + qq) * NE_IN + C_IQ + hh * 64 + hf * 8;
    bf16x8 af[4];
#pragma unroll
    for (int ks = 0; ks < 4; ++ks) af[ks] = *(const bf16x8*)(ap + ks * 16);
    const int qA = 4 * mtile + 2 * hf;
    const float* iwp = iw + (size_t)(b * S_ + q0 + qA) * 8;
    const f32x4 iwA0 = *(const f32x4*)(iwp), iwA1 = *(const f32x4*)(iwp + 4), iwB0 = *(const f32x4*)(iwp + 8), iwB1 = *(const f32x4*)(iwp + 12);
    const int kr0 = tid >> 3, kc = tid & 7;
    const bf16_t* kp = proj + (size_t)(b * S_ + kr0) * NE_IN + C_IK + kc * 8;
    u32x4 g0 = *(const u32x4*)kp, g1 = *(const u32x4*)(kp + (size_t)64 * NE_IN);
    for (int c = 0; c < nch; ++c) {
        __syncthreads();
        *(u32x4*)(IK + kr0 * IKROW + kc * 16) = g0; *(u32x4*)(IK + (kr0 + 64) * IKROW + kc * 16) = g1;
        __syncthreads();
        if (c + 1 < nch) { kp += (size_t)128 * NE_IN; g0 = *(const u32x4*)kp; g1 = *(const u32x4*)(kp + (size_t)64 * NE_IN); }
#pragma unroll
        for (int t2 = 0; t2 < 2; ++t2) {
            const int ntile = par * 2 + t2;
            f32x16 acc = zero16();
#pragma unroll
            for (int ks = 0; ks < 4; ++ks) { const bf16x8 bfr = *(const bf16x8*)(IK + (ntile * 32 + r) * IKROW + ks * 32 + hf * 16); acc = mfma32(af[ks], bfr, acc); }
            float sA = 0.f, sB = 0.f;
#pragma unroll
            for (int e = 0; e < 4; ++e) { sA += fmaxf(acc[e], 0.f) * iwA0[e] + fmaxf(acc[4 + e], 0.f) * iwA1[e]; sB += fmaxf(acc[8 + e], 0.f) * iwB0[e] + fmaxf(acc[12 + e], 0.f) * iwB1[e]; }
            const int key = c * 128 + ntile * 32 + r, qposA = q0 + qA;
            SC[qA * 2048 + key] = (key <= qposA) ? sA : NEG_INF;
            SC[(qA + 1) * 2048 + key] = (key <= qposA + 1) ? sB : NEG_INF;
        }
    }
    __syncthreads();
    const int nI = nch * 2;
    LAS unsigned* hist = (LAS unsigned*)(lds + 153600 + w * 1024);
#pragma unroll 1
    for (int qsel = 0; qsel < 2; ++qsel) {
        const int qi = 2 * w + qsel, qpos = q0 + qi;
        unsigned u[32];
#pragma unroll
        for (int i = 0; i < 32; ++i) u[i] = (i < nI) ? sortable(SC[qi * 2048 + i * 64 + lane]) : 0u;
        unsigned long long mymask = 0ull;
        if (qpos < 256) {
#pragma unroll
            for (int i = 0; i < 32; ++i) { const unsigned long long bal = __ballot((i * 64 + lane) <= qpos); if (lane == i) mymask = bal; }
        } else {
            unsigned prefix = 0u; int need = 256, shift = 24; bool whole = false;
#pragma unroll 1
            for (int pass = 0; pass < 4; ++pass) {
                shift = 24 - 8 * pass;
                { unsigned zz = 0u; asm volatile("" : "+v"(zz)); *(u32x4*)(hist + lane * 4) = (u32x4){zz, zz, zz, zz}; }
#pragma unroll
                for (int i = 0; i < 32; ++i) if (i < nI) {
                    const bool in = (pass == 0) ? (u[i] > 0x007fffffu) : ((u[i] >> (shift + 8)) == prefix);
                    if (in) __hip_atomic_fetch_add(hist + ((u[i] >> shift) & 255u), 1u, __ATOMIC_RELAXED, __HIP_MEMORY_SCOPE_WAVEFRONT);
                }
                const u32x4 hv = *(const u32x4*)(hist + (63 - lane) * 4);
                const int sl = (int)(hv[0] + hv[1] + hv[2] + hv[3]);
                int pre = sl;
                pre += __builtin_amdgcn_update_dpp(0, pre, 0x111, 0xf, 0xf, false);
                pre += __builtin_amdgcn_update_dpp(0, pre, 0x112, 0xf, 0xf, false);
                pre += __builtin_amdgcn_update_dpp(0, pre, 0x114, 0xf, 0xf, false);
                pre += __builtin_amdgcn_update_dpp(0, pre, 0x118, 0xf, 0xf, false);
                pre += __builtin_amdgcn_update_dpp(0, pre, 0x142, 0xa, 0xf, false);
                pre += __builtin_amdgcn_update_dpp(0, pre, 0x143, 0xc, 0xf, false);
                const unsigned long long mk = __ballot(pre >= need);
                const int Lsel = __builtin_ctzll(mk);
                int above = pre - sl, bin = 4 * (63 - lane), nn = need, cnt = 0;
                if (above + (int)hv[3] >= need) { bin += 3; nn = need - above; cnt = (int)hv[3]; }
                else { above += (int)hv[3];
                    if (above + (int)hv[2] >= need) { bin += 2; nn = need - above; cnt = (int)hv[2]; }
                    else { above += (int)hv[2];
                        if (above + (int)hv[1] >= need) { bin += 1; nn = need - above; cnt = (int)hv[1]; }
                        else { above += (int)hv[1]; nn = need - above; cnt = (int)hv[0]; } } }
                bin = __builtin_amdgcn_readlane(bin, Lsel); need = __builtin_amdgcn_readlane(nn, Lsel); cnt = __builtin_amdgcn_readlane(cnt, Lsel);
                prefix = (prefix << 8) | (unsigned)bin;
                if (cnt == need) { whole = true; break; }
            }
            const unsigned T = whole ? (prefix << shift) : prefix;
            int tc = 0;
#pragma unroll
            for (int i = 0; i < 32; ++i) if (i < nI) {
                bool sel;
                if (whole) sel = (u[i] >= T);
                else {
                    const unsigned long long eq = __ballot(u[i] == T);
                    const int myrank = tc + (int)__builtin_amdgcn_mbcnt_hi((unsigned)(eq >> 32), __builtin_amdgcn_mbcnt_lo((unsigned)eq, 0u));
                    sel = (u[i] > T) || (u[i] == T && myrank < need);
                    tc += __popcll(eq);
                }
                const unsigned long long bal = __ballot(sel);
                if (lane == i) mymask = bal;
            }
        }
        if (lane < 32) { u32x2 o; o[0] = (unsigned)mymask; o[1] = (unsigned)(mymask >> 32); *(u32x2*)(mask + (size_t)(b * S_ + qpos) * 64 + 2 * lane) = o; }
    }
    __syncthreads();
}
}

namespace pr {
DI void ce_desc(float& x, float& y) { const float hi = fmaxf(x, y), lo = fminf(x, y); x = hi; y = lo; }
DI void sort16_desc(float (&a)[16]) {
    ce_desc(a[0], a[13]); ce_desc(a[1], a[12]); ce_desc(a[2], a[15]); ce_desc(a[3], a[14]); ce_desc(a[4], a[8]); ce_desc(a[5], a[6]); ce_desc(a[7], a[11]); ce_desc(a[9], a[10]);
    ce_desc(a[0], a[5]); ce_desc(a[1], a[7]); ce_desc(a[2], a[9]); ce_desc(a[3], a[4]); ce_desc(a[6], a[13]); ce_desc(a[8], a[14]); ce_desc(a[10], a[15]); ce_desc(a[11], a[12]);
    ce_desc(a[0], a[1]); ce_desc(a[2], a[3]); ce_desc(a[4], a[5]); ce_desc(a[6], a[8]); ce_desc(a[7], a[9]); ce_desc(a[10], a[11]); ce_desc(a[12], a[13]); ce_desc(a[14], a[15]);
    ce_desc(a[0], a[2]); ce_desc(a[1], a[3]); ce_desc(a[4], a[10]); ce_desc(a[5], a[11]); ce_desc(a[6], a[7]); ce_desc(a[8], a[9]); ce_desc(a[12], a[14]); ce_desc(a[13], a[15]);
    ce_desc(a[1], a[2]); ce_desc(a[3], a[12]); ce_desc(a[4], a[6]); ce_desc(a[5], a[7]); ce_desc(a[8], a[10]); ce_desc(a[9], a[11]); ce_desc(a[13], a[14]);
    ce_desc(a[1], a[4]); ce_desc(a[2], a[6]); ce_desc(a[5], a[8]); ce_desc(a[7], a[10]); ce_desc(a[9], a[13]); ce_desc(a[11], a[14]);
    ce_desc(a[2], a[4]); ce_desc(a[3], a[6]); ce_desc(a[9], a[12]); ce_desc(a[11], a[13]);
    ce_desc(a[3], a[5]); ce_desc(a[6], a[8]); ce_desc(a[7], a[9]); ce_desc(a[10], a[12]);
    ce_desc(a[3], a[4]); ce_desc(a[5], a[6]); ce_desc(a[7], a[8]); ce_desc(a[9], a[10]); ce_desc(a[11], a[12]);
    ce_desc(a[6], a[7]); ce_desc(a[8], a[9]);
}
DI void merge_top16(float (&a)[16], const float (&b)[16]) {
#pragma unroll
    for (int i = 0; i < 16; ++i) a[i] = fmaxf(a[i], b[15 - i]);
#pragma unroll
    for (int j = 8; j > 0; j >>= 1)
#pragma unroll
        for (int i = 0; i < 16; ++i) if ((i & j) == 0) ce_desc(a[i], a[i + j]);
}
constexpr int SUBK_MAT = 128 * 256;
constexpr int ROUTE_SCR = 2 * SUBK_MAT;
DI void stage_subk(const bf16_t* subk, int hp0, int hp1, unsigned char* lds, int tid) {
#pragma unroll
    for (int i = 0; i < 8; ++i) {
        const int piece = i * 512 + tid, slot = piece >> 11, pp = piece & 2047, row = pp >> 4, ch = pp & 15;
        const bf16_t* src = subk + (size_t)((slot ? hp1 : hp0) * 128 + row) * 128 + ((ch ^ (row & 15)) * 8);
        __builtin_amdgcn_global_load_lds((const unsigned*)src, (unsigned*)(lds + slot * SUBK_MAT + pp * 16), 16, 0, 0);
    }
}
DI void subkey_scores(const bf16x8 (&qf)[8], const unsigned char* mat, int r, int hf, float (&c)[4][16]) {
#pragma unroll
    for (int mt = 0; mt < 4; ++mt) {
        f32x16 acc = zero16();
        const int row = mt * 32 + r;
        const unsigned char* rp = mat + row * 256;
#pragma unroll
        for (int ks = 0; ks < 8; ++ks) acc = mfma32(*(const bf16x8*)(rp + (((2 * ks + hf) ^ (row & 15)) * 16)), qf[ks], acc);
#pragma unroll
        for (int e = 0; e < 16; ++e) {
            const unsigned key = (unsigned)(mt * 32 + (e & 3) + 8 * (e >> 2)) + 4u * (unsigned)hf;
            c[mt][e] = __uint_as_float((__float_as_uint(acc[e]) & ~127u) | key);
        }
    }
}
DI void sort_top16(float (&c)[4][16], float (&V)[16]) {
#pragma unroll
    for (int mt = 0; mt < 4; ++mt) sort16_desc(c[mt]);
    merge_top16(c[0], c[1]); merge_top16(c[2], c[3]); merge_top16(c[0], c[2]);
    float pb[16];
#pragma unroll
    for (int k = 0; k < 16; ++k) pb[k] = __shfl_xor(c[0][k], 32, 64);
    merge_top16(c[0], pb);
#pragma unroll
    for (int k = 0; k < 16; ++k) V[k] = c[0][k];
}
DI void route_block(const bf16_t* qp, const bf16_t* subk, unsigned short* re, float* rg, int unit, unsigned char* lds, int tid) {
    const int w = __builtin_amdgcn_readfirstlane(tid >> 6), lane = tid & 63, r = lane & 31, hf = lane >> 5;
    const int tg = w & 3, hh = w >> 2, token = unit * 128 + tg * 32 + r;
    unsigned char* ldsw = lds + ROUTE_SCR + w * 8192;
    const unsigned char* mat = lds + hh * SUBK_MAT;
    stage_subk(subk, 0, 8, lds, tid);
    bf16x8 qn[8];
    {
        const bf16_t* qptr = qp + (size_t)token * 2048 + (hh * 8) * 128 + hf * 8;
#pragma unroll
        for (int ks = 0; ks < 8; ++ks) qn[ks] = *(const bf16x8*)(qptr + ks * 16);
    }
#pragma unroll 1
    for (int hpair = 0; hpair < 2; ++hpair) {
        const int hA = hh * 4 + hpair * 2;
        float V0[16], V1[16];
#pragma unroll
        for (int k = 0; k < 16; ++k) { V0[k] = 0.f; V1[k] = 0.f; }
#pragma unroll 1
        for (int st = 0; st < 4; ++st) {
            const int s = hpair * 4 + st;
            bf16x8 qf[8];
#pragma unroll
            for (int ks = 0; ks < 8; ++ks) qf[ks] = qn[ks];
            asm volatile("s_waitcnt vmcnt(0)" ::: "memory");
            __syncthreads();
            float c[4][16];
            subkey_scores(qf, mat, r, hf, c);
            __syncthreads();
            if (s + 1 < 8) {
                stage_subk(subk, s + 1, 8 + s + 1, lds, tid);
                const bf16_t* qptr = qp + (size_t)token * 2048 + (hh * 8 + s + 1) * 128 + hf * 8;
#pragma unroll
                for (int ks = 0; ks < 8; ++ks) qn[ks] = *(const bf16x8*)(qptr + ks * 16);
            }
            float Bt[16]; sort_top16(c, Bt);
            const bool to0 = (st == 0) || (st == 2 && hf), to1 = (st == 1) || (st == 3 && hf);
#pragma unroll
            for (int k = 0; k < 16; ++k) { V0[k] = to0 ? Bt[k] : V0[k]; V1[k] = to1 ? Bt[k] : V1[k]; }
        }
        const int head = hA + hf;
        float cv[64];
        {
            int n = 0;
#pragma unroll
            for (int i = 0; i < 16; ++i)
#pragma unroll
                for (int j = 0; j < 16; ++j) if ((i + 1) * (j + 1) <= 16) { cv[n] = V0[i] + V1[j]; ++n; }
#pragma unroll
            for (int k = 50; k < 64; ++k) cv[k] = NEG_INF;
        }
        float sv[4][16];
#pragma unroll
        for (int g = 0; g < 4; ++g) {
#pragma unroll
            for (int i = 0; i < 16; ++i) sv[g][i] = cv[g * 16 + i];
            sort16_desc(sv[g]);
        }
        merge_top16(sv[0], sv[1]); merge_top16(sv[2], sv[3]); merge_top16(sv[0], sv[2]);
        const float smax = sv[0][0], thr = sv[0][15];
        float den = 0.f;
#pragma unroll
        for (int k = 0; k < 16; ++k) den += __expf(sv[0][k] - smax);
        const float inv = 1.0f / den;
        int pos = 0;
        {
            int n = 0;
#pragma unroll
            for (int i = 0; i < 16; ++i)
#pragma unroll
                for (int j = 0; j < 16; ++j) if ((i + 1) * (j + 1) <= 16) {
                    if (cv[n] >= thr && pos < 16) {
                        u32x2 ent; ent[0] = ((__float_as_uint(V0[i]) & 127u) << 7) | (__float_as_uint(V1[j]) & 127u); ent[1] = __float_as_uint(__expf(cv[n] - smax) * inv);
                        *(u32x2*)(ldsw + pos * 512 + lane * 8) = ent; ++pos;
                    }
                    ++n;
                }
        }
        unsigned short* rep = re + (size_t)token * 128 + head * 16; float* rgp = rg + (size_t)token * 128 + head * 16;
        unsigned ev[8];
#pragma unroll
        for (int k4 = 0; k4 < 4; ++k4) {
            f32x4 gv; unsigned e4[4];
#pragma unroll
            for (int q = 0; q < 4; ++q) { const u32x2 ent = *(const u32x2*)(ldsw + (k4 * 4 + q) * 512 + lane * 8); e4[q] = ent[0]; gv[q] = __uint_as_float(ent[1]); }
            ev[2 * k4] = e4[0] | (e4[1] << 16); ev[2 * k4 + 1] = e4[2] | (e4[3] << 16);
            *(f32x4*)(rgp + 4 * k4) = gv;
        }
        *(u32x4*)rep = (u32x4){ev[0], ev[1], ev[2], ev[3]}; *(u32x4*)(rep + 8) = (u32x4){ev[4], ev[5], ev[6], ev[7]};
    }
    __syncthreads();
}

DI void fp8x16_to_f32(const u32x4 d, float (&f)[16]) {
#pragma unroll
    for (int q = 0; q < 4; ++q) {
        const f32x2 lo = __builtin_amdgcn_cvt_pk_f32_fp8((int)d[q], false), hi = __builtin_amdgcn_cvt_pk_f32_fp8((int)d[q], true);
        f[4 * q] = lo[0]; f[4 * q + 1] = lo[1]; f[4 * q + 2] = hi[0]; f[4 * q + 3] = hi[1];
    }
}
DI void ld_ids(const unsigned short* re, int t, int g, int (&ids)[16]) {
    const u32x4 a = *(const u32x4*)(re + (size_t)t * 128 + g * 16), b = *(const u32x4*)(re + (size_t)t * 128 + g * 16 + 8);
#pragma unroll
    for (int q = 0; q < 4; ++q) { ids[2 * q] = (int)(a[q] & 0xffffu); ids[2 * q + 1] = (int)(a[q] >> 16); ids[8 + 2 * q] = (int)(b[q] & 0xffffu); ids[8 + 2 * q + 1] = (int)(b[q] >> 16); }
}
DI void ld_rows(const unsigned char* tab, unsigned laneoff, const int (&ids)[16], u32x4 (&data)[16]) {
#pragma unroll
    for (int i = 0; i < 16; ++i) data[i] = *(const u32x4*)(tab + (size_t)((unsigned)ids[i] * 128u + laneoff));
}
DI void peer_u_loop(const bf16_t* h2, const unsigned char* U, const unsigned short* re, bf16_t* pd, int t0, int tstep, int slice, int lane) {
    const int g = lane >> 3, c = lane & 7;
    const unsigned laneoff = (unsigned)(slice * (NEXP * 128) + c * 16);
    const bf16_t* hb = h2 + slice * 128 + c * 16;
    if (t0 >= T_) return;
    int idsn[16]; u32x4 data[16]; u32x4 h0, h1;
    ld_ids(re, t0, g, idsn); ld_rows(U, laneoff, idsn, data);
    h0 = *(const u32x4*)(hb + (size_t)t0 * 1024); h1 = *(const u32x4*)(hb + (size_t)t0 * 1024 + 8);
    ld_ids(re, min(t0 + tstep, T_ - 1), g, idsn);
    const bool b2 = (c & 4) != 0, b1 = (c & 2) != 0, b0 = (c & 1) != 0;
#pragma unroll 1
    for (int t = t0; t < T_; t += tstep) {
        const int tnc = min(t + tstep, T_ - 1), tnn = min(t + 2 * tstep, T_ - 1);
        f32x2 hp[8];
#pragma unroll
        for (int q = 0; q < 4; ++q) { hp[q] = (f32x2){bf_lo(h0[q]), bf_hi(h0[q])}; hp[4 + q] = (f32x2){bf_lo(h1[q]), bf_hi(h1[q])}; }
        h0 = *(const u32x4*)(hb + (size_t)tnc * 1024); h1 = *(const u32x4*)(hb + (size_t)tnc * 1024 + 8);
        float part[16];
#pragma unroll
        for (int i = 0; i < 16; ++i) {
            const u32x4 d = data[i];
            data[i] = *(const u32x4*)(U + (size_t)((unsigned)idsn[i] * 128u + laneoff));
            f32x2 s2 = {0.f, 0.f};
#pragma unroll
            for (int q = 0; q < 4; ++q) {
                const f32x2 lo = __builtin_amdgcn_cvt_pk_f32_fp8((int)d[q], false), hi = __builtin_amdgcn_cvt_pk_f32_fp8((int)d[q], true);
                s2 = __builtin_elementwise_fma(lo, hp[2 * q], s2); s2 = __builtin_elementwise_fma(hi, hp[2 * q + 1], s2);
            }
            part[i] = s2[0] + s2[1];
        }
        ld_ids(re, tnn, g, idsn);
        float a8[8], a4[4], a2[2];
#pragma unroll
        for (int k = 0; k < 8; ++k) { const float keep = b2 ? part[8 + k] : part[k], send = b2 ? part[k] : part[8 + k]; a8[k] = keep + __shfl_xor(send, 4, 64); }
#pragma unroll
        for (int k = 0; k < 4; ++k) { const float keep = b1 ? a8[4 + k] : a8[k], send = b1 ? a8[k] : a8[4 + k]; a4[k] = keep + __shfl_xor(send, 2, 64); }
#pragma unroll
        for (int k = 0; k < 2; ++k) { const float keep = b0 ? a4[2 + k] : a4[k], send = b0 ? a4[k] : a4[2 + k]; a2[k] = keep + __shfl_xor(send, 1, 64); }
        *(unsigned*)(pd + (size_t)t * 1024 + slice * 128 + 2 * lane) = pk_bf16(a2[0], a2[1]);
    }
}
DI void peer_combine(const bf16_t* pd, float* wg, const float* ps, int tb, int lane) {
    const int t = tb + (lane >> 4), p0 = (lane & 15) * 8;
    const f32x4 q0 = *(const f32x4*)(ps + (size_t)t * 16), q1 = *(const f32x4*)(ps + (size_t)t * 16 + 4), q2 = *(const f32x4*)(ps + (size_t)t * 16 + 8), q3 = *(const f32x4*)(ps + (size_t)t * 16 + 12);
    const float sq = (((q0[0] + q0[1]) + (q0[2] + q0[3])) + ((q1[0] + q1[1]) + (q1[2] + q1[3]))) + (((q2[0] + q2[1]) + (q2[2] + q2[3])) + ((q3[0] + q3[1]) + (q3[2] + q3[3])));
    const float rs = (1.0f / TAB_SCALE) / sqrtf(sq * (1.0f / 1024.0f) + 1e-6f);
    u32x4 v[8];
#pragma unroll
    for (int sl = 0; sl < 8; ++sl) v[sl] = *(const u32x4*)(pd + (size_t)t * 1024 + sl * 128 + p0);
    float* gp = wg + (size_t)t * 128 + p0;
    const f32x4 g0 = *(const f32x4*)gp, g1 = *(const f32x4*)(gp + 4);
    float d[8];
#pragma unroll
    for (int k = 0; k < 8; ++k) d[k] = 0.f;
#pragma unroll
    for (int sl = 0; sl < 8; ++sl)
#pragma unroll
        for (int q = 0; q < 4; ++q) { d[2 * q] += bf_lo(v[sl][q]); d[2 * q + 1] += bf_hi(v[sl][q]); }
    f32x4 o0, o1;
#pragma unroll
    for (int k = 0; k < 8; ++k) {
        const float cc = d[k] * rs;
        const float g = (k < 4) ? g0[k & 3] : g1[k & 3];
        const float r = g * 0.5f * cc * (1.0f + erff(cc * 0.70710678118654752f)) * (1.0f / TAB_SCALE);
        if (k < 4) o0[k & 3] = r; else o1[k & 3] = r;
    }
    *(f32x4*)gp = o0; *(f32x4*)(gp + 4) = o1;
}
DI void ld_w(const float* wg, int t, int g, float (&wv)[16]) {
#pragma unroll
    for (int q = 0; q < 4; ++q) { const f32x4 wq = *(const f32x4*)(wg + (size_t)t * 128 + g * 16 + q * 4); wv[4 * q] = wq[0]; wv[4 * q + 1] = wq[1]; wv[4 * q + 2] = wq[2]; wv[4 * q + 3] = wq[3]; }
}
DI void peer_v_loop(bf16_t* xb, float* psa, const unsigned char* V, const unsigned short* re, const float* wg, int t0, int tstep, int slice, int lane) {
    const int g = lane >> 3, c = lane & 7;
    const unsigned laneoff = (unsigned)(slice * (NEXP * 128) + c * 16);
    if (t0 >= T_) return;
    int idsn[16]; u32x4 data[16]; float wv[16], wn[16];
    ld_ids(re, t0, g, idsn); ld_rows(V, laneoff, idsn, data); ld_w(wg, t0, g, wv);
    { const int tc = min(t0 + tstep, T_ - 1); ld_ids(re, tc, g, idsn); ld_w(wg, tc, g, wn); }
    const bool b5 = (lane & 32) != 0, b4 = (lane & 16) != 0, b3 = (lane & 8) != 0;
#pragma unroll 1
    for (int t = t0; t < T_; t += tstep) {
        const int tnn = min(t + 2 * tstep, T_ - 1);
        const size_t o = (size_t)t * 1024 + slice * 128 + c * 16 + 2 * g;
        const unsigned xo = *(const unsigned*)(xb + o);
        f32x2 acc2[8];
#pragma unroll
        for (int k = 0; k < 8; ++k) acc2[k] = (f32x2){0.f, 0.f};
#pragma unroll
        for (int i = 0; i < 16; ++i) {
            const u32x4 d = data[i];
            data[i] = *(const u32x4*)(V + (size_t)((unsigned)idsn[i] * 128u + laneoff));
            const f32x2 w2 = {wv[i], wv[i]};
#pragma unroll
            for (int q = 0; q < 4; ++q) {
                const f32x2 lo = __builtin_amdgcn_cvt_pk_f32_fp8((int)d[q], false), hi = __builtin_amdgcn_cvt_pk_f32_fp8((int)d[q], true);
                acc2[2 * q] = __builtin_elementwise_fma(lo, w2, acc2[2 * q]); acc2[2 * q + 1] = __builtin_elementwise_fma(hi, w2, acc2[2 * q + 1]);
            }
        }
        float acc[16];
#pragma unroll
        for (int k = 0; k < 8; ++k) { acc[2 * k] = acc2[k][0]; acc[2 * k + 1] = acc2[k][1]; }
#pragma unroll
        for (int k = 0; k < 16; ++k) wv[k] = wn[k];
        ld_ids(re, tnn, g, idsn); ld_w(wg, tnn, g, wn);
        float a8[8], a4[4], a2[2];
#pragma unroll
        for (int k = 0; k < 8; ++k) { const float keep = b5 ? acc[8 + k] : acc[k], send = b5 ? acc[k] : acc[8 + k]; a8[k] = keep + __shfl_xor(send, 32, 64); }
#pragma unroll
        for (int k = 0; k < 4; ++k) { const float keep = b4 ? a8[4 + k] : a8[k], send = b4 ? a8[k] : a8[4 + k]; a4[k] = keep + __shfl_xor(send, 16, 64); }
#pragma unroll
        for (int k = 0; k < 2; ++k) { const float keep = b3 ? a4[2 + k] : a4[k], send = b3 ? a4[k] : a4[2 + k]; a2[k] = keep + __shfl_xor(send, 8, 64); }
        const float y0 = bf_lo(xo) + a2[0], y1 = bf_hi(xo) + a2[1];
        *(unsigned*)(xb + o) = pk_bf16(y0, y1);
        const float ss = wave_sum_dpp(y0 * y0 + y1 * y1);
        if (lane == 0) psa[(size_t)t * 8 + slice] = ss;
    }
}
}

constexpr int NPHASE = 1 + 12 * DEPTH_;

#ifndef MK_ONE_LAUNCH
#define MK_ONE_LAUNCH 1
#endif

__global__ void __launch_bounds__(NTHR, 2) k_main(Params p) {
    extern __shared__ __attribute__((aligned(16))) unsigned char lds[];
    unsigned char* const ws = p.ws;
    const int bid = blockIdx.x, nblk = gridDim.x;
    const bool fused = (p.ph_hi - p.ph_lo) > 1;
    XcdBarrier bar; bar.bar = (unsigned*)(ws + WS_BAR); bar.x = 0; bar.st = (volatile LAS unsigned*)(lds + LDS_BYTES - 16);
    if (fused) {
        if (threadIdx.x == 0) *(u32x4*)(lds + LDS_BYTES - 16) = (u32x4){0u, 0u, 0u, 0u};
        __syncthreads();
        bar = xcd_barrier_post((unsigned*)(ws + WS_BAR), (volatile LAS unsigned*)(lds + LDS_BYTES - 16));
    }
#define PH_BEGIN(k) if (p.ph_lo <= (k) && (k) < p.ph_hi) { int tv = threadIdx.x; asm volatile("" : "+v"(tv)); (void)tv;
#define PH_END(k) if ((k) + 1 < p.ph_hi) xcd_barrier(bar); }
#define REPN(bit) (((DBG_REP >> (bit)) & 1) ? 2 : 1)

    float* const PSA = (float*)(ws + WS_RSTD);
    bf16_t* const H = (bf16_t*)(ws + WS_H);
    bf16_t* const O = (bf16_t*)(ws + WS_O);
    const float* const c64 = (const float*)(ws + WS_COS64); const float* const s64 = (const float*)(ws + WS_SIN64);
    const float* const c32 = (const float*)(ws + WS_COS32); const float* const s32 = (const float*)(ws + WS_SIN32);

    PH_BEGIN(0)
        int toff = 0;
        for (int rep = 0; rep < REPN(14); ++rep) {
        for (int j = 0; j < 2; ++j) {
            prep_wt<1>(p.hyb_w_in + (size_t)j * 1024 * 2760, 1024, 2760, (bf16_t*)(ws + WS_WEIN + j * SZ_WEIN), NE_IN, p.attn_norm + (2 * j) * 1024, toff, bid, nblk, tv);
            prep_wt<2>(p.hyb_w_out + (size_t)j * 1024 * 1024, 1024, 1024, (bf16_t*)(ws + WS_WEOUT + j * SZ_WSQ), 1024, nullptr, toff, bid, nblk, tv);
            prep_wt<3>(p.mla_w_in + (size_t)j * 1024 * 1056, 1024, 1056, (bf16_t*)(ws + WS_WMIN + j * SZ_WMIN), NM_IN, p.attn_norm + (2 * j + 1) * 1024, toff, bid, nblk, tv);
            prep_wt<4>(p.mla_w_uq + (size_t)j * 768 * 1536, 768, 1536, (bf16_t*)(ws + WS_WUQ + j * SZ_WUQ), 1536, p.mla_q_norm + j * 768, toff, bid, nblk, tv);
            prep_wt<2>(p.mla_w_ukv + (size_t)j * 256 * 2048, 256, 2048, (bf16_t*)(ws + WS_WUKV + j * SZ_WUKV), 2048, p.mla_kv_norm + j * 256, toff, bid, nblk, tv);
            prep_wt<2>(p.mla_w_out + (size_t)j * 1024 * 1024, 1024, 1024, (bf16_t*)(ws + WS_WMOUT + j * SZ_WSQ), 1024, nullptr, toff, bid, nblk, tv);
        }
        for (int j = 0; j < 4; ++j) prep_wt<2>(p.peer_w_q + (size_t)j * 1024 * 2048, 1024, 2048, (bf16_t*)(ws + WS_WPQ + j * SZ_WPQ), 2048, p.ffn_norm + j * 1024, toff, bid, nblk, tv);
        cvt_bf16(p.peer_sub_keys, (bf16_t*)(ws + WS_SUBK), (size_t)4 * 16 * 128 * 128, bid, nblk, tv);
        cvt_fp8(p.peer_u, ws + WS_U16, (size_t)4 * NEXP * 1024, TAB_SCALE, p.ffn_norm, bid, nblk, tv);
        cvt_fp8(p.peer_v, ws + WS_V16, (size_t)4 * NEXP * 1024, TAB_SCALE, nullptr, bid, nblk, tv);
        rope_tables(p.pos, (float*)(ws + WS_COS64), (float*)(ws + WS_SIN64), (float*)(ws + WS_COS32), (float*)(ws + WS_SIN32), bid, nblk, tv);
        x_to_stream(p.x, H, PSA, bid, nblk, tv);
        }
    PH_END(0)

#pragma unroll 1
    for (int L = 0; L < DEPTH_; ++L) {
        const int base = 1 + 12 * L, j = L >> 1;
        if ((L & 1) == 0) {
            bf16_t* PROJ = (bf16_t*)(ws + WS_P); bf16_t* vaT = (bf16_t*)(ws + WS_VT); bf16_t* vbT = (bf16_t*)(ws + WS_VT + 4 * MiB);
            float* IW = (float*)(ws + WS_IW); unsigned* MASK = (unsigned*)(ws + WS_MASK);
            PH_BEGIN(base + 0)
                gm::EpiEvenIn e{PROJ, vaT, vbT, IW, c64, s64, PSA};
                for (int rep = 0; rep < REPN(0); ++rep)
                gm::gemm_phase(H, 1024, (const bf16_t*)(ws + WS_WEIN + j * SZ_WEIN), T_, NE_IN, 1024, e, lds, bid, nblk);
            PH_END(base + 0)
            PH_BEGIN(base + 1)
                const at::Args aB{PROJ, PROJ, nullptr, vbT, nullptr, O};
                for (int rep = 0; rep < REPN(1); ++rep) {
                int kbh = -1;
                for (int u = bid; u < 1024; u += nblk) {
                    int tw = threadIdx.x; asm volatile("" : "+v"(tw));
                    const int i = u >> 7, bh = u & 127;
                    const int qt = (0x32451067 >> (4 * i)) & 7;
                    if (bh != kbh) { ab::moba_kmean(bh >> 3, bh & 7, 7, PROJ + C_KB, (char*)lds, tw); kbh = bh; }
                    ab::attn_unit<8, 1>(bh >> 3, bh & 7, qt, PROJ + C_QB, PROJ + C_KB, PROJ + C_VB, O + 512, nullptr, (char*)lds, tw);
                }
                }
                for (int rep = 0; rep < REPN(2); ++rep)
                for (int u = bid; u < 2048; u += nblk) {
                    int tw = threadIdx.x; asm volatile("" : "+v"(tw));
                    const int b = u & 15, g = u >> 4, k = g >> 4, gl = g & 15;
                    const int qt16 = 16 * (7 - k) + ((k & 1) ? gl : 15 - gl);
                    ix::indexer_unit(PROJ, IW, MASK, b, qt16, lds, tw);
                }
            PH_END(base + 1)
            PH_BEGIN(base + 2)
                const at::Args aA{PROJ, PROJ, nullptr, vaT, MASK, O};
                for (int rep = 0; rep < REPN(3); ++rep)
                for (int u = bid; u < 1024; u += nblk) {
                    int tw = threadIdx.x; asm volatile("" : "+v"(tw));
                    const int k = u >> 8, c = u & 255, b = c >> 4, jj = c & 15;
                    const int qt = (k == 0) ? 63 - jj : (k == 1) ? 32 + jj : (k == 2) ? 31 - jj : jj;
                    ab::attn_unit<8, 2>(b, 0, qt, PROJ + C_QA, PROJ + C_KA, PROJ + C_VA, O, MASK, (char*)lds, tw);
                }
            PH_END(base + 2)
            PH_BEGIN(base + 4)
                {
                gm::EpiResid e{H, (float*)(ws + WS_PSF), nullptr};
                gm::gemm_phase(O, 1024, (const bf16_t*)(ws + WS_WEOUT + j * SZ_WSQ), T_, 1024, 1024, e, lds, bid, nblk); }
            PH_END(base + 4)
        } else {
            bf16_t* CIN = (bf16_t*)(ws + WS_P_CIN); bf16_t* QM = (bf16_t*)(ws + WS_P_QM); bf16_t* KN = (bf16_t*)(ws + WS_P_KN); bf16_t* vT = (bf16_t*)(ws + WS_VT);
            float* RSTD = (float*)(ws + WS_MASK);
            PH_BEGIN(base + 0)
                gm::EpiMlaIn e{CIN, c32, s32, RSTD, PSA};
                for (int rep = 0; rep < REPN(0); ++rep)
                gm::gemm_phase(H, 1024, (const bf16_t*)(ws + WS_WMIN + j * SZ_WMIN), T_, 1024, 1024, e, lds, bid, nblk);
            PH_END(base + 0)
            PH_BEGIN(base + 2)
                for (int rep = 0; rep < REPN(5); ++rep) {
                mla_krope_units(H, (const bf16_t*)(ws + WS_WMIN + j * SZ_WMIN) + (size_t)1024 * 1024, PSA, c32, s32, CIN, bid, nblk, tv);
                { gm::EpiQup e{QM, RSTD, c32, s32, RSTD};
                  gm::gemm_phase(CIN, NM_IN, (const bf16_t*)(ws + WS_WUQ + j * SZ_WUQ), T_, 1536, 768, e, lds, bid, nblk); }
                { gm::EpiKVup e{KN, vT, RSTD, RSTD};
                  gm::gemm_phase(CIN + 768, NM_IN, (const bf16_t*)(ws + WS_WUKV + j * SZ_WUKV), T_, 2048, 256, e, lds, bid, nblk); } }
            PH_END(base + 2)
            PH_BEGIN(base + 3)
                const at::Args aC{QM, KN, CIN, vT, nullptr, O};
                for (int rep = 0; rep < REPN(6); ++rep)
                for (int u = bid; u < 2048; u += nblk) {
                    int tw = threadIdx.x; asm volatile("" : "+v"(tw));
                    const int i = u >> 8, bh = u & 255;
                    am::attn_unit<8>(bh >> 4, bh & 15, 7 - i, QM, KN, CIN, vT, O, (char*)lds, tw);
                }
            PH_END(base + 3)
            PH_BEGIN(base + 4)
                {
                gm::EpiResid e{H, (float*)(ws + WS_PSF), nullptr};
                gm::gemm_phase(O, 1024, (const bf16_t*)(ws + WS_WMOUT + j * SZ_WSQ), T_, 1024, 1024, e, lds, bid, nblk); }
            PH_END(base + 4)
        }
        bf16_t* QP = (bf16_t*)(ws + WS_P);
        unsigned short* RE = (unsigned short*)(ws + WS_RE); float* RG = (float*)(ws + WS_RG);
        PH_BEGIN(base + 6)
            gm::EpiBf16 e{QP, 2048, (const float*)(ws + WS_PSF)};
            for (int rep = 0; rep < REPN(9); ++rep)
            gm::gemm_phase(H, 1024, (const bf16_t*)(ws + WS_WPQ + L * SZ_WPQ), T_, 2048, 1024, e, lds, bid, nblk);
        PH_END(base + 6)
        PH_BEGIN(base + 7)
            const int w = tv >> 6;
            for (int rep = 0; rep < REPN(10); ++rep)
            for (int u = bid; u < T_ / 128; u += nblk) { int tw = threadIdx.x; asm volatile("" : "+v"(tw)); pr::route_block(QP, (const bf16_t*)(ws + WS_SUBK + L * SZ_SUBK), RE, RG, u, lds, tw); }
        PH_END(base + 7)
        bf16_t* PD = (bf16_t*)(ws + WS_P);
        PH_BEGIN(base + 8)
            const int w = tv >> 6, ngrp = nblk >> 3, slice = bid & 7, rank = bid >> 3;
            if (rank < ngrp)
            for (int rep = 0; rep < REPN(11); ++rep)
            pr::peer_u_loop(H, ws + WS_U16 + L * SZ_TAB, RE, PD, rank * 8 + w, ngrp * 8, slice, tv & 63);
        PH_END(base + 8)
        PH_BEGIN(base + 9)
            const int w = tv >> 6;
            for (int t = (bid * 8 + w) * 4; t < T_; t += nblk * 32) pr::peer_combine(PD, RG, (const float*)(ws + WS_PSF), t, tv & 63);
        PH_END(base + 9)
        PH_BEGIN(base + 10)
            const int w = tv >> 6, ngrp = nblk >> 3, slice = bid & 7, rank = bid >> 3;
            if (rank < ngrp)
            pr::peer_v_loop(H, PSA, ws + WS_V16 + L * SZ_TAB, RE, RG, rank * 8 + w, ngrp * 8, slice, tv & 63);
        PH_END(base + 10)
        if (L + 1 == DEPTH_) {
        PH_BEGIN(base + 11)
            final_norm_rows(H, p.final_norm, p.out, bid, nblk, tv);
        PH_END(base + 11)
        }
    }
#undef PH_BEGIN
#undef PH_END
}

extern "C" void kernel_launch(void* const* d_in, const int* in_sizes, int n_in, void* d_out, int out_size, void* d_ws, size_t ws_size, hipStream_t stream) {
    static int grid = 0;
    if (grid == 0) {
        if (n_in != 17 || out_size != T_ * D_ || ws_size < WS_END) { fprintf(stderr, "kernel_launch: unexpected shapes (n_in %d out %d ws %zu need %zu)\n", n_in, out_size, ws_size, (size_t)WS_END); grid = -1; return; }
        int dev = 0, cus = 0, per_cu = 0;
        if (hipGetDevice(&dev) != hipSuccess || hipDeviceGetAttribute(&cus, hipDeviceAttributeMultiprocessorCount, dev) != hipSuccess) { grid = -1; return; }
        if (hipFuncSetAttribute((const void*)k_main, hipFuncAttributeMaxDynamicSharedMemorySize, LDS_BYTES) != hipSuccess) { fprintf(stderr, "kernel_launch: hipFuncSetAttribute failed\n"); grid = -1; return; }
        if (hipOccupancyMaxActiveBlocksPerMultiprocessor(&per_cu, (const void*)k_main, NTHR, LDS_BYTES) != hipSuccess || per_cu < 1) { fprintf(stderr, "kernel_launch: occupancy query says %d\n", per_cu); per_cu = 1; }
        (void)hipGetLastError();
        grid = cus;
    }
    if (grid < 0) return;
    (void)hipMemsetAsync((char*)d_ws + WS_BAR, 0, XCD_BAR_WORDS * sizeof(unsigned), stream);
    Params p{};
    p.x = (const float*)d_in[0]; p.pos = (const int*)d_in[1]; p.attn_norm = (const float*)d_in[2]; p.ffn_norm = (const float*)d_in[3]; p.final_norm = (const float*)d_in[4];
    p.hyb_w_in = (const float*)d_in[5]; p.hyb_w_out = (const float*)d_in[6]; p.mla_w_in = (const float*)d_in[7]; p.mla_q_norm = (const float*)d_in[8]; p.mla_kv_norm = (const float*)d_in[9];
    p.mla_w_uq = (const float*)d_in[10]; p.mla_w_ukv = (const float*)d_in[11]; p.mla_w_out = (const float*)d_in[12]; p.peer_w_q = (const float*)d_in[13]; p.peer_sub_keys = (const float*)d_in[14];
    p.peer_u = (const float*)d_in[15]; p.peer_v = (const float*)d_in[16];
    p.out = (float*)d_out; p.ws = (unsigned char*)d_ws;
#if MK_ONE_LAUNCH
    p.ph_lo = 0; p.ph_hi = NPHASE;
    hipLaunchKernelGGL(k_main, dim3(grid), dim3(NTHR), LDS_BYTES, stream, p);
#else
    for (int ph = 0; ph < NPHASE; ++ph) {
        if (ph > 0) { const int L = (ph - 1) / 12, slot = (ph - 1) % 12; if ((slot == 3 && (L & 1) == 0) || (slot == 1 && (L & 1) == 1) || slot == 5 || (slot == 11 && L + 1 < DEPTH_)) continue; }
        p.ph_lo = ph; p.ph_hi = ph + 1;
        hipLaunchKernelGGL(k_main, dim3(grid), dim3(NTHR), LDS_BYTES, stream, p);
    }
#endif
}
```
